# Optimizing an MI355X kernel written in HIP

```python
import math
import jax, jax.numpy as jnp
from jax import lax
import numpy as np

D_MODEL = 1024
BATCH = 2
SEQ = 8192
DEPTH = 1

MEM_LEN = 256
RET_HEADS = 8
RET_DK = 64
RET_DV = 64
RET_CHUNK = 128
RET_WIDTH = RET_HEADS * RET_DV
RET_THETA_BASE = 10000.0
DIFF_HEADS = 4
DIFF_DQK = 64
DIFF_DV = 2 * DIFF_DQK
DIFF_WIDTH = DIFF_HEADS * DIFF_DV
Q_BLOCK = 128
MIX_WIDTH = RET_WIDTH + DIFF_WIDTH
RET_QK_COLS = RET_HEADS * RET_DK
DIFF_QK_COLS = DIFF_HEADS * 2 * DIFF_DQK
IN_SIZES = (RET_QK_COLS, RET_QK_COLS, RET_WIDTH, RET_WIDTH, DIFF_QK_COLS, DIFF_QK_COLS, DIFF_WIDTH)
IN_COLS = 2 * RET_QK_COLS + 2 * RET_WIDTH + 2 * DIFF_QK_COLS + DIFF_WIDTH
XATTN_HEADS = 4
XATTN_DH = D_MODEL // XATTN_HEADS
FFN_HIDDEN = -(-(8 * D_MODEL) // (3 * 256)) * 256
EPS = 1e-6

kernel_name = "hymba_retention_diffattn_memxattn_swiglu"


def rms_norm(x, gain=None):
    xf = x.astype(jnp.float32)
    y = xf * lax.rsqrt(jnp.mean(xf * xf, axis=-1, keepdims=True) + EPS)
    if gain is not None:
        y = y * gain.astype(jnp.float32)
    return y.astype(x.dtype)


def rotary(x, pos):
    half = x.shape[-1] // 2
    inv = 1.0 / (RET_THETA_BASE ** jnp.linspace(0.0, 1.0, half, dtype=jnp.float32))
    ang = pos.astype(jnp.float32)[:, None] * inv[None, :]
    cos, sin = jnp.cos(ang), jnp.sin(ang)
    x1 = x[..., :half].astype(jnp.float32)
    x2 = x[..., half:].astype(jnp.float32)
    out = jnp.concatenate([x1 * cos - x2 * sin, x2 * cos + x1 * sin], axis=-1)
    return out.astype(x.dtype)


def retention_chunkwise(q, k, v):
    B, H, S, dk = q.shape
    dv = v.shape[-1]
    C = RET_CHUNK
    N = S // C
    log_g = jnp.log1p(-(2.0 ** (-5.0 - jnp.arange(H, dtype=jnp.float32))))
    idx = jnp.arange(C, dtype=jnp.float32)
    rel = idx[:, None] - idx[None, :]
    dmask = jnp.where(rel >= 0, jnp.exp(log_g[:, None, None] * jnp.maximum(rel, 0.0)), 0.0)
    zeta = jnp.exp(log_g[:, None] * (C - 1.0 - idx))
    xi = jnp.exp(log_g[:, None] * (idx + 1.0))
    g_chunk = jnp.exp(log_g * C)

    qc = q.reshape(B, H, N, C, dk)
    kc = k.reshape(B, H, N, C, dk)
    vc = v.reshape(B, H, N, C, dv)

    scores = jnp.einsum('bhncd,bhnjd->bhncj', qc, kc) * dmask[None, :, None]
    o_intra = jnp.einsum('bhncj,bhnjv->bhncv', scores, vc)

    kv = jnp.einsum('bhncd,bhncv->nbhdv', kc * zeta[None, :, None, :, None], vc).astype(jnp.float32)

    def step(R, kv_n):
        return R * g_chunk[None, :, None, None] + kv_n, R

    _, r_prev = lax.scan(step, jnp.zeros((B, H, dk, dv), jnp.float32), kv)
    o_inter = jnp.einsum('bhncd,nbhdv->bhncv', qc, r_prev) * xi[None, :, None, :, None]
    return (o_intra + o_inter).reshape(B, H, S, dv)


def diff_attention_causal(q, k, v, lam):
    B, H, _, S, dq = q.shape
    dv = v.shape[-1]
    nb = S // Q_BLOCK
    qb = q.reshape(B, H, 2, nb, Q_BLOCK, dq).transpose(3, 0, 1, 2, 4, 5)
    kpos = jnp.arange(S)
    scale = dq ** -0.5

    def block(args):
        q_blk, i = args
        qpos = i * Q_BLOCK + jnp.arange(Q_BLOCK)
        s = jnp.einsum('bhmqd,bhmkd->bhmqk', q_blk, k).astype(jnp.float32) * scale
        s = jnp.where(kpos[None, :] <= qpos[:, None], s, -jnp.inf)
        p = jax.nn.softmax(s, axis=-1)
        a = p[:, :, 0] - lam * p[:, :, 1]
        return jnp.einsum('bhqk,bhkd->bhqd', a.astype(v.dtype), v)

    o = lax.map(block, (qb, jnp.arange(nb)))
    return o.transpose(1, 2, 0, 3, 4).reshape(B, H, S, dv)


def setup_inputs(seed: int = 0) -> dict:
    key = jax.random.key(seed)
    ks = jax.random.split(key, 24)
    f32 = jnp.float32

    def w(k, shape, fan_in):
        return jax.random.normal(k, shape, f32) * (fan_in ** -0.5)

    def gain(k, shape):
        return 1.0 + 0.02 * jax.random.normal(k, shape, f32)

    L = DEPTH
    return {
        "x": jax.random.normal(ks[0], (BATCH, SEQ, D_MODEL), f32),
        "mem": jax.random.normal(ks[1], (BATCH, MEM_LEN, D_MODEL), f32),
        "norm_mix": gain(ks[2], (L, D_MODEL)),
        "w_in": w(ks[3], (L, D_MODEL, IN_COLS), D_MODEL),
        "diff_q_gain": gain(ks[4], (L, DIFF_DQK)),
        "diff_k_gain": gain(ks[5], (L, DIFF_DQK)),
        "diff_lambda": 0.1 * jax.random.normal(ks[6], (L, 4, DIFF_DQK), f32),
        "diff_subln": gain(ks[7], (L, DIFF_DV)),
        "group_scale": gain(ks[8], (L, MIX_WIDTH)),
        "w_out": w(ks[9], (L, MIX_WIDTH, D_MODEL), MIX_WIDTH),
        "norm_x": gain(ks[10], (L, D_MODEL)),
        "norm_mem": gain(ks[11], (L, D_MODEL)),
        "xq": w(ks[12], (L, D_MODEL, D_MODEL), D_MODEL),
        "xkv": w(ks[13], (L, D_MODEL, 2 * D_MODEL), D_MODEL),
        "xq_gain": gain(ks[14], (L, XATTN_DH)),
        "xk_gain": gain(ks[15], (L, XATTN_DH)),
        "xo": w(ks[16], (L, D_MODEL, D_MODEL), D_MODEL),
        "norm_ffn": gain(ks[17], (L, D_MODEL)),
        "w_gate": w(ks[18], (L, D_MODEL, FFN_HIDDEN), D_MODEL),
        "w_up": w(ks[19], (L, D_MODEL, FFN_HIDDEN), D_MODEL),
        "w_down": w(ks[20], (L, FFN_HIDDEN, D_MODEL), FFN_HIDDEN),
    }


def reference(x, mem, norm_mix, w_in, diff_q_gain, diff_k_gain, diff_lambda, diff_subln,
              group_scale, w_out, norm_x, norm_mem, xq, xkv, xq_gain, xk_gain, xo,
              norm_ffn, w_gate, w_up, w_down):
    B, S, D = x.shape
    M = mem.shape[1]
    pos = jnp.arange(S)
    split_at = list(np.cumsum(IN_SIZES)[:-1])

    for l in range(DEPTH):
        lam_init = 0.8 - 0.6 * math.exp(-0.3 * l)

        h = rms_norm(x, norm_mix[l])
        proj = h @ w_in[l]
        rq, rk, rv, rg, dq, dk, dv = jnp.split(proj, split_at, axis=-1)

        rq = rq.reshape(B, S, RET_HEADS, RET_DK).transpose(0, 2, 1, 3)
        rk = rk.reshape(B, S, RET_HEADS, RET_DK).transpose(0, 2, 1, 3)
        rv = rv.reshape(B, S, RET_HEADS, RET_DV).transpose(0, 2, 1, 3)
        rq = rotary(rq, pos)
        rk = rotary(rk, pos) * (RET_DK ** -0.5)
        o_ret = rms_norm(retention_chunkwise(rq, rk, rv).astype(x.dtype))
        o_ret = o_ret.transpose(0, 2, 1, 3).reshape(B, S, RET_WIDTH) * jax.nn.silu(rg)

        dq = dq.reshape(B, S, DIFF_HEADS, 2, DIFF_DQK).transpose(0, 2, 3, 1, 4)
        dk = dk.reshape(B, S, DIFF_HEADS, 2, DIFF_DQK).transpose(0, 2, 3, 1, 4)
        dv = dv.reshape(B, S, DIFF_HEADS, DIFF_DV).transpose(0, 2, 1, 3)
        dq = rms_norm(dq, diff_q_gain[l])
        dk = rms_norm(dk, diff_k_gain[l])
        lv = diff_lambda[l].astype(jnp.float32)
        lam = jnp.exp(jnp.sum(lv[0] * lv[1])) - jnp.exp(jnp.sum(lv[2] * lv[3])) + lam_init
        o_diff = diff_attention_causal(dq, dk, dv, lam)
        o_diff = rms_norm(o_diff, diff_subln[l]) * (1.0 - lam_init)
        o_diff = o_diff.transpose(0, 2, 1, 3).reshape(B, S, DIFF_WIDTH)

        mix = jnp.concatenate([o_ret, o_diff], axis=-1) * group_scale[l]
        x = x + mix @ w_out[l]

        h = rms_norm(x, norm_x[l])
        m = rms_norm(mem, norm_mem[l])
        q = (h @ xq[l]).reshape(B, S, XATTN_HEADS, XATTN_DH)
        k, v = jnp.split(m @ xkv[l], 2, axis=-1)
        k = k.reshape(B, M, XATTN_HEADS, XATTN_DH)
        v = v.reshape(B, M, XATTN_HEADS, XATTN_DH)
        q = rms_norm(q, xq_gain[l])
        k = rms_norm(k, xk_gain[l])
        s = jnp.einsum('bshd,bmhd->bhsm', q, k).astype(jnp.float32) * (XATTN_DH ** -0.5)
        p = jax.nn.softmax(s, axis=-1).astype(v.dtype)
        o = jnp.einsum('bhsm,bmhd->bshd', p, v).reshape(B, S, D)
        x = x + o @ xo[l]

        h = rms_norm(x, norm_ffn[l])
        x = x + (jax.nn.silu(h @ w_gate[l]) * (h @ w_up[l])) @ w_down[l]

    return x
```

```cpp
#include <hip/hip_runtime.h>
#include <hip/hip_cooperative_groups.h>
#include <cstdio>
#include <cstdint>
namespace cg = cooperative_groups;
#define XSUM_SWZ(v, m) ((v) + __uint_as_float((unsigned)__builtin_amdgcn_ds_swizzle((int)__float_as_uint(v), ((m) << 10) | 0x1f)))
#define XMAX_SWZ(v, m) fmaxf((v), __uint_as_float((unsigned)__builtin_amdgcn_ds_swizzle((int)__float_as_uint(v), ((m) << 10) | 0x1f)))
__device__ __forceinline__ float xsum32(float v) { auto rr = __builtin_amdgcn_permlane32_swap(__float_as_uint(v), __float_as_uint(v), false, false); return __uint_as_float(rr[0]) + __uint_as_float(rr[1]); }
__device__ __forceinline__ float xmax32(float v) { auto rr = __builtin_amdgcn_permlane32_swap(__float_as_uint(v), __float_as_uint(v), false, false); return fmaxf(__uint_as_float(rr[0]), __uint_as_float(rr[1])); }
__device__ __forceinline__ float xsum16(float v) { return XSUM_SWZ(v, 16); }
__device__ __forceinline__ int lane_id_asm() { int l; asm volatile("v_mbcnt_lo_u32_b32 %0, -1, 0\n\tv_mbcnt_hi_u32_b32 %0, -1, %0" : "=v"(l)); return l; }
namespace pg8 {
#define PG8_LAS __attribute__((address_space(3)))
typedef unsigned short bf16_t;
typedef short bf16x8 __attribute__((ext_vector_type(8)));
typedef float f32x4 __attribute__((ext_vector_type(4)));
typedef unsigned u32x4 __attribute__((ext_vector_type(4)));
constexpr int BM = 256, BK = 64, HALF = 128, HTB = HALF * BK * 2  , STAGE_BYTES = 8 * HTB, NXCD = 8, WGM = 8;

__host__ __device__ __forceinline__ int lds_byte(int r, int c) { const int st = (r >> 4) * 2 + (c >> 5), rr = r & 15, cc = c & 31, ob = rr * 64 + cc * 2; return st * 1024 + (ob ^ (((ob >> 9) & 1) << 5)); }
__host__ __device__ __forceinline__ void stage_rc(int b, int& R, int& C) { const int st = b / 1024, sb = b % 1024, swz = sb ^ (((sb >> 9) & 1) << 5); R = (st >> 1) * 16 + swz / 64; C = (st & 1) * 32 + (swz % 64) / 2; }
__host__ __device__ __forceinline__ int perm32(int rho) { const int n = rho >> 4, i = rho & 15; return 8 * (i >> 2) + 4 * n + (i & 3); }

struct Unit { int pm, pn; };
struct Gemm { const bf16_t* A; const bf16_t* Bt; int M, N, K; };

struct StaticOrder {
    int nM, nN, nwg, G, c;
    __host__ __device__ void init(int M, int N, int G_, int c_) { nM = M / BM; nN = N / BM; nwg = nM * nN; G = G_; c = c_; }
    __host__ __device__ bool next(int i, Unit& u) const {
        const long L = (long)i * G + c; if (L >= nwg) return false;
        int wgid = (int)L; { const int q = nwg / NXCD, r = nwg % NXCD, xcd = wgid % NXCD, off = wgid / NXCD; wgid = (xcd < r ? xcd * (q + 1) : r * (q + 1) + (xcd - r) * q) + off; }
        const int nig = WGM * nN, gid = wgid / nig, fm = gid * WGM, gsz = (nM - fm) < WGM ? (nM - fm) : WGM;
        u.pm = fm + ((wgid % nig) % gsz); u.pn = (wgid % nig) / gsz; return true;
    }
    __device__ __forceinline__ void a_ready(const Unit&) const {}
    __device__ __forceinline__ void done(const Unit&) const {}
};

__device__ __forceinline__ unsigned cvt_pk_bf16(float lo, float hi) { unsigned r; asm volatile("v_cvt_pk_bf16_f32 %0, %1, %2" : "=v"(r) : "v"(lo), "v"(hi)); return r; }
typedef float f32x2 __attribute__((ext_vector_type(2)));
typedef unsigned u32x2 __attribute__((ext_vector_type(2)));
constexpr float EPS_RMS = 1e-6f;
__device__ __forceinline__ u32x4 pack8(const float (&v)[8]) { u32x4 w; w.x = cvt_pk_bf16(v[0], v[1]); w.y = cvt_pk_bf16(v[2], v[3]); w.z = cvt_pk_bf16(v[4], v[5]); w.w = cvt_pk_bf16(v[6], v[7]); return w; }
__device__ __forceinline__ float silu_f(float v) { return v * __builtin_amdgcn_rcpf(1.0f + __builtin_amdgcn_exp2f(v * -1.4426950408889634f)); }

struct EpiG1 {
    static constexpr bool PERM = true, AFTER_DRAIN = false;
    bf16_t* O; const float* rstd; const float* cs; const float* gq; const float* gk; float c2;
    __device__ __forceinline__ void operator()(const f32x4 (&acc)[2][2][4][2], const Unit& u, int wr, int wc, int fr, int fq) const {
        const int pn = u.pn; const int row0 = u.pm * BM + wr * 64 + fr;
        if (pn < 4) {
            const float sc = pn >= 2 ? 0.125f : 1.0f;
#pragma unroll
            for (int ai = 0; ai < 2; ++ai) {
                f32x4 ct[4][4]; float fr_[4];
#pragma unroll
                for (int m = 0; m < 4; ++m) { const int row = row0 + ai * HALF + m * 16; fr_[m] = rstd[row] * sc;
                    const f32x4* c4 = (const f32x4*)(cs + ((size_t)(row & 8191) * 32 + 8 * fq) * 2);
#pragma unroll
                    for (int k = 0; k < 4; ++k) ct[m][k] = c4[k]; }
#pragma unroll
                for (int m = 0; m < 4; ++m) { const int row = row0 + ai * HALF + m * 16; const float f = fr_[m];
                    float o1[8], o2[8];
#pragma unroll
                    for (int k = 0; k < 4; ++k) { const f32x4 c = ct[m][k];
#pragma unroll
                        for (int z = 0; z < 2; ++z) { const int i8 = 2 * k + z; const float co = z ? c[2] : c[0], si = z ? c[3] : c[1];
                            const float x1 = acc[ai][0][m][i8 >> 2][i8 & 3], x2 = acc[ai][1][m][i8 >> 2][i8 & 3];
                            o1[i8] = (x1 * co - x2 * si) * f; o2[i8] = (x2 * co + x1 * si) * f; } }
                    bf16_t* p = O + (size_t)row * 2560 + pn * 256 + wc * 64 + 8 * fq;
                    *(u32x4*)p = pack8(o1); *(u32x4*)(p + 32) = pack8(o2); } }
        } else if (pn < 6) {
#pragma unroll
            for (int ai = 0; ai < 2; ++ai)
#pragma unroll
                for (int m = 0; m < 4; ++m) { const int row = row0 + ai * HALF + m * 16; const float f = rstd[row];
#pragma unroll
                    for (int bj = 0; bj < 2; ++bj) { float v[8];
#pragma unroll
                        for (int i8 = 0; i8 < 8; ++i8) v[i8] = silu_f(acc[ai][bj][m][i8 >> 2][i8 & 3] * f);
                        *(u32x4*)(O + (size_t)row * 2560 + pn * 256 + bj * HALF + wc * 32 + 8 * fq) = pack8(v); } }
        } else {
            const float* g = pn < 8 ? gq : gk; const float sc = pn < 8 ? c2 : 1.0f;
            float gv[2][8];
#pragma unroll
            for (int bj = 0; bj < 2; ++bj)
#pragma unroll
                for (int i8 = 0; i8 < 8; ++i8) gv[bj][i8] = g[32 * bj + 8 * fq + i8] * sc;
#pragma unroll
            for (int ai = 0; ai < 2; ++ai)
#pragma unroll
                for (int m = 0; m < 4; ++m) { const int row = row0 + ai * HALF + m * 16; const float f = rstd[row];
                    float ss = 0.f;
#pragma unroll
                    for (int bj = 0; bj < 2; ++bj)
#pragma unroll
                        for (int i8 = 0; i8 < 8; ++i8) { const float v = acc[ai][bj][m][i8 >> 2][i8 & 3] * f; ss += v * v; }
                    ss = xsum16(ss); ss = xsum32(ss);
                    const float rr = f * rsqrtf(ss * (1.0f / 64.0f) + EPS_RMS);
#pragma unroll
                    for (int bj = 0; bj < 2; ++bj) { float v[8];
#pragma unroll
                        for (int i8 = 0; i8 < 8; ++i8) v[i8] = acc[ai][bj][m][i8 >> 2][i8 & 3] * rr * gv[bj][i8];
                        *(u32x4*)(O + (size_t)row * 2560 + pn * 256 + wc * 64 + bj * 32 + 8 * fq) = pack8(v); } }
        }
    }
};

struct EpiTR {
    static constexpr bool PERM = true, AFTER_DRAIN = false;
    bf16_t* O; const float* rstd; const float* cs;
    __device__ __forceinline__ void operator()(const f32x4 (&acc)[2][2][4][2], const Unit& u, int wr, int wc, int fr, int fq) const {
        const int pm = u.pm; const int col0 = u.pn * BM + wc * 32 + 8 * fq;
        float rs[2][8];
#pragma unroll
        for (int bj = 0; bj < 2; ++bj) { const f32x4 a = *(const f32x4*)(rstd + col0 + bj * HALF), b = *(const f32x4*)(rstd + col0 + bj * HALF + 4);
            rs[bj][0] = a[0]; rs[bj][1] = a[1]; rs[bj][2] = a[2]; rs[bj][3] = a[3]; rs[bj][4] = b[0]; rs[bj][5] = b[1]; rs[bj][6] = b[2]; rs[bj][7] = b[3]; }
        if (pm < 2) {
#pragma unroll
            for (int bj = 0; bj < 2; ++bj) {
                float2 ct[2][8];
#pragma unroll
                for (int mm = 0; mm < 2; ++mm)
#pragma unroll
                    for (int i8 = 0; i8 < 8; ++i8) { const int pos = (col0 + bj * HALF + i8) & 8191; ct[mm][i8] = *(const float2*)(cs + ((size_t)pos * 32 + 16 * mm + fr) * 2); }
#pragma unroll
                for (int m = 0; m < 4; ++m) { const int hl = 2 * wr + (m >> 1), i = 16 * (m & 1) + fr, head = 4 * pm + hl;
                    const float l2g = log1pf(-exp2f(-5.0f - (float)head)) * 1.4426950408889634f;
                    const int rown = pm * 256 + 64 * hl + i;
                    float o1[8], o2[8];
#pragma unroll
                    for (int i8 = 0; i8 < 8; ++i8) { const int col = col0 + bj * HALF + i8;
                        const float2 c = ct[m & 1][i8];
                        const float f = rs[bj][i8] * 0.125f * __builtin_amdgcn_exp2f(l2g * (float)(127 - (col & 127)));
                        const float x1 = acc[0][bj][m][i8 >> 2][i8 & 3], x2 = acc[1][bj][m][i8 >> 2][i8 & 3];
                        o1[i8] = (x1 * c.x - x2 * c.y) * f; o2[i8] = (x2 * c.x + x1 * c.y) * f; }
                    *(u32x4*)(O + (size_t)rown * 16384 + col0 + bj * HALF) = pack8(o1);
                    *(u32x4*)(O + (size_t)(rown + 32) * 16384 + col0 + bj * HALF) = pack8(o2); } }
        } else {
#pragma unroll
            for (int ai = 0; ai < 2; ++ai)
#pragma unroll
                for (int m = 0; m < 4; ++m) { const int row = pm * BM + ai * HALF + wr * 64 + m * 16 + fr;
#pragma unroll
                    for (int bj = 0; bj < 2; ++bj) { float v[8];
#pragma unroll
                        for (int i8 = 0; i8 < 8; ++i8) v[i8] = acc[ai][bj][m][i8 >> 2][i8 & 3] * rs[bj][i8];
                        *(u32x4*)(O + (size_t)row * 16384 + col0 + bj * HALF) = pack8(v); } }
        }
    }
};

template <bool SSQ> struct EpiRowScale {
    static constexpr bool PERM = true, AFTER_DRAIN = false;
    bf16_t* O; int ldc; const float* rs;
    __device__ __forceinline__ void operator()(const f32x4 (&acc)[2][2][4][2], const Unit& u, int wr, int wc, int fr, int fq) const {
        const int row0 = u.pm * BM + wr * 64 + fr, col0 = u.pn * BM + wc * 32 + 8 * fq;
#pragma unroll
        for (int ai = 0; ai < 2; ++ai)
#pragma unroll
            for (int m = 0; m < 4; ++m) { const int row = row0 + ai * HALF + m * 16; float f = rs[row]; if (SSQ) f = rsqrtf(f * (1.0f / 1024.0f) + EPS_RMS);
#pragma unroll
                for (int bj = 0; bj < 2; ++bj) { float v[8];
#pragma unroll
                    for (int i8 = 0; i8 < 8; ++i8) v[i8] = acc[ai][bj][m][i8 >> 2][i8 & 3] * f;
                    *(u32x4*)(O + (size_t)row * ldc + col0 + bj * HALF) = pack8(v); } }
    }
};
struct EpiColScale {
    static constexpr bool PERM = true, AFTER_DRAIN = false;
    bf16_t* O; int ldc; const float* rs;
    __device__ __forceinline__ void operator()(const f32x4 (&acc)[2][2][4][2], const Unit& u, int wr, int wc, int fr, int fq) const {
        const int row0 = u.pm * BM + wr * 64 + fr, col0 = u.pn * BM + wc * 32 + 8 * fq;
        float rsv[2][8];
#pragma unroll
        for (int bj = 0; bj < 2; ++bj)
#pragma unroll
            for (int i8 = 0; i8 < 8; ++i8) rsv[bj][i8] = rs[col0 + bj * HALF + i8];
#pragma unroll
        for (int ai = 0; ai < 2; ++ai)
#pragma unroll
            for (int m = 0; m < 4; ++m) { const int row = row0 + ai * HALF + m * 16;
#pragma unroll
                for (int bj = 0; bj < 2; ++bj) { float v[8];
#pragma unroll
                    for (int i8 = 0; i8 < 8; ++i8) v[i8] = acc[ai][bj][m][i8 >> 2][i8 & 3] * rsv[bj][i8];
                    *(u32x4*)(O + (size_t)row * ldc + col0 + bj * HALF) = pack8(v); } }
    }
};
template <bool AUX> struct EpiResid {
    static constexpr bool PERM = true, AFTER_DRAIN = false;
    const float* base; float* out; bf16_t* xb; float* ssq;
    __device__ __forceinline__ void operator()(const f32x4 (&acc)[2][2][4][2], const Unit& u, int wr, int wc, int fr, int fq) const {
        const int row0 = u.pm * BM + wr * 64 + fr, col0 = u.pn * BM + wc * 32 + 8 * fq;
#pragma unroll
        for (int ai = 0; ai < 2; ++ai) {
            f32x4 bv[4][2][2];
#pragma unroll
            for (int m = 0; m < 4; ++m)
#pragma unroll
                for (int bj = 0; bj < 2; ++bj) { const size_t off = (size_t)(row0 + ai * HALF + m * 16) * 1024 + col0 + bj * HALF;
                    bv[m][bj][0] = *(const f32x4*)(base + off); bv[m][bj][1] = *(const f32x4*)(base + off + 4); }
#pragma unroll
            for (int m = 0; m < 4; ++m) { const int row = row0 + ai * HALF + m * 16; float ss = 0.f;
#pragma unroll
                for (int bj = 0; bj < 2; ++bj) { const size_t off = (size_t)row * 1024 + col0 + bj * HALF;
                    const f32x4 v0 = bv[m][bj][0] + acc[ai][bj][m][0], v1 = bv[m][bj][1] + acc[ai][bj][m][1];
                    *(f32x4*)(out + off) = v0; *(f32x4*)(out + off + 4) = v1;
                    if (AUX) { u32x4 w; w.x = cvt_pk_bf16(v0[0], v0[1]); w.y = cvt_pk_bf16(v0[2], v0[3]); w.z = cvt_pk_bf16(v1[0], v1[1]); w.w = cvt_pk_bf16(v1[2], v1[3]);
                        *(u32x4*)(xb + off) = w;
                        ss += (v0[0] * v0[0] + v0[1] * v0[1]) + (v0[2] * v0[2] + v0[3] * v0[3]) + (v1[0] * v1[0] + v1[1] * v1[1]) + (v1[2] * v1[2] + v1[3] * v1[3]); } }
                if (AUX) { ss = xsum16(ss); ss = xsum32(ss); if (fq == 0) atomicAdd(ssq + row, ss); } }
        }
    }
};
struct EpiResidF {
    static constexpr bool PERM = false, AFTER_DRAIN = false;
    const float* base; float* out;
    __device__ __forceinline__ void operator()(const f32x4 (&acc)[2][2][4][2], const Unit& u, int wr, int wc, int fr, int fq) const {
        const int row0 = u.pm * BM + wr * 64 + fr, col0 = u.pn * BM + wc * 32 + 4 * fq;
#pragma unroll
        for (int ai = 0; ai < 2; ++ai) {
            f32x4 bv[4][2][2];
#pragma unroll
            for (int m = 0; m < 4; ++m)
#pragma unroll
                for (int bj = 0; bj < 2; ++bj) { const size_t off = (size_t)(row0 + ai * HALF + m * 16) * 1024 + col0 + bj * HALF;
                    bv[m][bj][0] = *(const f32x4*)(base + off); bv[m][bj][1] = *(const f32x4*)(base + off + 16); }
#pragma unroll
            for (int m = 0; m < 4; ++m)
#pragma unroll
                for (int bj = 0; bj < 2; ++bj) { const size_t off = (size_t)(row0 + ai * HALF + m * 16) * 1024 + col0 + bj * HALF;
                    *(f32x4*)(out + off) = bv[m][bj][0] + acc[ai][bj][m][0]; *(f32x4*)(out + off + 16) = bv[m][bj][1] + acc[ai][bj][m][1]; }
        }
    }
};
struct EpiSwiglu {
    static constexpr bool PERM = true, AFTER_DRAIN = false;
    bf16_t* O; const float* ssq;
    __device__ __forceinline__ void operator()(const f32x4 (&acc)[2][2][4][2], const Unit& u, int wr, int wc, int fr, int fq) const {
        const int row0 = u.pm * BM + wr * 64 + fr, col0 = u.pn * HALF + wc * 32 + 8 * fq;
#pragma unroll
        for (int ai = 0; ai < 2; ++ai)
#pragma unroll
            for (int m = 0; m < 4; ++m) { const int row = row0 + ai * HALF + m * 16; const float f = rsqrtf(ssq[row] * (1.0f / 1024.0f) + EPS_RMS);
                float v[8];
#pragma unroll
                for (int i8 = 0; i8 < 8; ++i8) v[i8] = silu_f(acc[ai][0][m][i8 >> 2][i8 & 3] * f) * (acc[ai][1][m][i8 >> 2][i8 & 3] * f);
                *(u32x4*)(O + (size_t)row * 2816 + col0) = pack8(v); }
    }
};
template <class Epi, class Sched, bool ALIGN_EPI = false, bool SP2 = false>
__device__ __forceinline__ void gemm_phase(PG8_LAS unsigned char* lds, const Gemm g, const Sched& S, const Epi& E, int wid_s) {
    const int lane = lane_id_asm(), wid = wid_s, tid = wid * 64 + lane, wr = wid >> 2, wc = wid & 3, fr = lane & 15, fq = lane >> 4;
    const int K = g.K, nt = K / BK;
    unsigned voffA[2], voffB[2];
#pragma unroll
    for (int i = 0; i < 2; ++i) { int R, C; stage_rc(tid * 16 + i * 8192, R, C); const int Rb = Epi::PERM ? ((R & ~31) + perm32(R & 31)) : R;
        voffA[i] = (unsigned)(R * K + C) * 2u; voffB[i] = (unsigned)(Rb * K + C) * 2u; }
    const size_t kstep = (size_t)(BK * 2);
    const size_t hstep = (size_t)HALF * K * 2;
    const size_t tstep = 2 * hstep;
    const unsigned ldsw = (unsigned)wid * 1024u;
    const int aoff = lds_byte(wr * 64 + fr, fq * 8), boff = lds_byte(wc * 32 + fr, fq * 8);
#define PG8_SA(b, h) (((b) * 2 + (h)) * HTB)
#define PG8_SB(b, h) ((4 + (b) * 2 + (h)) * HTB)
#define PG8_STAGE(bufoff, gbase, voff) do { _Pragma("unroll") for (int _i = 0; _i < 2; ++_i) \
        __builtin_amdgcn_global_load_lds((const unsigned*)((const char*)(gbase) + (voff)[_i]), (PG8_LAS unsigned*)(lds + (bufoff) + ldsw + _i * 8192), 16, 0, 0); } while (0)
#define PG8_LDA(dst, b, h) do { _Pragma("unroll") for (int m = 0; m < 4; ++m) _Pragma("unroll") for (int k = 0; k < 2; ++k) dst[m][k] = *(const PG8_LAS bf16x8*)(lds + PG8_SA(b, h) + aoff + m * 2048 + k * 1024); } while (0)
#define PG8_LDB(dst, b, h) do { _Pragma("unroll") for (int n = 0; n < 2; ++n) _Pragma("unroll") for (int k = 0; k < 2; ++k) dst[n][k] = *(const PG8_LAS bf16x8*)(lds + PG8_SB(b, h) + boff + n * 2048 + k * 1024); } while (0)
#define PG8_MMA(ai, bj, At, Bt) do { __builtin_amdgcn_s_setprio(1); _Pragma("unroll") for (int m = 0; m < 4; ++m) _Pragma("unroll") for (int n = 0; n < 2; ++n) _Pragma("unroll") for (int k = 0; k < 2; ++k) \
        acc[ai][bj][m][n] = __builtin_amdgcn_mfma_f32_16x16x32_bf16(Bt[n][k], At[m][k], acc[ai][bj][m][n], 0, 0, 0); __builtin_amdgcn_s_setprio(0); } while (0)
#define PG8_WAIT_V(n) asm volatile("s_waitcnt vmcnt(" #n ")" ::: "memory")
#define PG8_WAIT_L(n) asm volatile("s_waitcnt lgkmcnt(" #n ")" ::: "memory")
#define PG8_BAR __builtin_amdgcn_s_barrier()
#define PG8_SCHED __builtin_amdgcn_sched_barrier(0)
    Unit cur, nxt; int ui = 0;
    if (!S.next(0, cur)) return;
    f32x4 acc[2][2][4][2];
#pragma unroll
    for (int a = 0; a < 2; ++a)
#pragma unroll
        for (int b = 0; b < 2; ++b)
#pragma unroll
            for (int m = 0; m < 4; ++m)
#pragma unroll
                for (int n = 0; n < 2; ++n) acc[a][b][m][n] = (f32x4){0.f, 0.f, 0.f, 0.f};
    bf16x8 At[4][2], B0[2][2], B1[2][2];
    const char* cA = (const char*)g.A + (size_t)cur.pm * tstep; const char* cB = (const char*)g.Bt + (size_t)cur.pn * tstep;
    S.a_ready(cur);
    if constexpr (SP2) {
        PG8_STAGE(PG8_SB(0, 0), cB, voffB); PG8_STAGE(PG8_SB(0, 1), cB + hstep, voffB); PG8_STAGE(PG8_SA(0, 0), cA, voffA); PG8_STAGE(PG8_SA(0, 1), cA + hstep, voffA);
        if (wr == 1) PG8_BAR;
        PG8_WAIT_V(2); PG8_BAR;
        PG8_STAGE(PG8_SB(1, 0), cB + kstep, voffB); PG8_STAGE(PG8_SA(1, 0), cA + kstep, voffA); PG8_STAGE(PG8_SB(1, 1), cB + hstep + kstep, voffB);
        PG8_WAIT_V(6); PG8_BAR;
    } else {
        PG8_STAGE(PG8_SB(0, 0), cB, voffB); PG8_STAGE(PG8_SA(0, 0), cA, voffA); PG8_STAGE(PG8_SB(0, 1), cB + hstep, voffB); PG8_STAGE(PG8_SA(0, 1), cA + hstep, voffA);
        if (wr == 1) PG8_BAR;
        PG8_WAIT_V(4); PG8_BAR;
        PG8_STAGE(PG8_SB(1, 0), cB + kstep, voffB); PG8_STAGE(PG8_SA(1, 0), cA + kstep, voffA); PG8_STAGE(PG8_SB(1, 1), cB + hstep + kstep, voffB);
        PG8_WAIT_V(6); PG8_BAR;
    }
    for (;;) {
        const bool has_next = S.next(ui + 1, nxt);
        const char* nA = has_next ? (const char*)g.A + (size_t)nxt.pm * tstep : cA; const char* nB = has_next ? (const char*)g.Bt + (size_t)nxt.pn * tstep : cB;
        for (int t = 0; t < nt; t += 2) {
            const bool last = (t == nt - 2);
            const char* a1 = cA + (size_t)(t + 1) * kstep;
            const char* a2 = last ? nA : cA + (size_t)(t + 2) * kstep; const char* b2 = last ? nB : cB + (size_t)(t + 2) * kstep;
            const char* a3 = a2 + kstep; const char* b3 = b2 + kstep;
            if (last && has_next) S.a_ready(nxt);
            if constexpr (SP2) {
            PG8_LDB(B0, 0, 0); PG8_LDB(B1, 0, 1); PG8_SCHED; PG8_LDA(At, 0, 0); PG8_STAGE(PG8_SA(1, 1), a1 + hstep, voffA);
            PG8_WAIT_V(8); PG8_WAIT_L(0); PG8_BAR; PG8_MMA(0, 0, At, B0); PG8_MMA(0, 1, At, B1); PG8_BAR; PG8_SCHED;
            PG8_LDA(At, 0, 1); PG8_STAGE(PG8_SB(0, 0), b2, voffB); PG8_STAGE(PG8_SB(0, 1), b2 + hstep, voffB); PG8_STAGE(PG8_SA(0, 0), a2, voffA);
            PG8_WAIT_V(8); PG8_WAIT_L(0); PG8_BAR; PG8_MMA(1, 0, At, B0); PG8_MMA(1, 1, At, B1); PG8_BAR; PG8_SCHED;
            PG8_LDB(B0, 1, 0); PG8_LDB(B1, 1, 1); PG8_SCHED; PG8_LDA(At, 1, 0); PG8_STAGE(PG8_SA(0, 1), a2 + hstep, voffA);
            PG8_WAIT_V(8); PG8_WAIT_L(0); PG8_BAR; PG8_MMA(0, 0, At, B0); PG8_MMA(0, 1, At, B1); PG8_BAR; PG8_SCHED;
            PG8_LDA(At, 1, 1); PG8_STAGE(PG8_SB(1, 0), b3, voffB); PG8_STAGE(PG8_SB(1, 1), b3 + hstep, voffB); PG8_STAGE(PG8_SA(1, 0), a3, voffA);
            PG8_WAIT_V(8); PG8_WAIT_L(0); PG8_BAR; PG8_MMA(1, 0, At, B0); PG8_MMA(1, 1, At, B1); PG8_BAR; PG8_SCHED;
            } else {
            PG8_LDB(B0, 0, 0); PG8_SCHED; PG8_LDA(At, 0, 0); PG8_STAGE(PG8_SA(1, 1), a1 + hstep, voffA);
            PG8_WAIT_L(8); PG8_BAR; PG8_WAIT_L(0); PG8_MMA(0, 0, At, B0); PG8_BAR; PG8_SCHED;
            PG8_LDB(B1, 0, 1); PG8_STAGE(PG8_SB(0, 0), b2, voffB);
            PG8_BAR; PG8_WAIT_L(0); PG8_MMA(0, 1, At, B1); PG8_BAR;
            PG8_LDA(At, 0, 1); PG8_STAGE(PG8_SA(0, 0), a2, voffA);
            PG8_BAR; PG8_WAIT_L(0); PG8_MMA(1, 0, At, B0); PG8_BAR; PG8_SCHED;
            PG8_STAGE(PG8_SB(0, 1), b2 + hstep, voffB);
            PG8_WAIT_V(6); PG8_BAR; PG8_MMA(1, 1, At, B1); PG8_BAR;
            PG8_LDB(B0, 1, 0); PG8_SCHED; PG8_LDA(At, 1, 0); PG8_STAGE(PG8_SA(0, 1), a2 + hstep, voffA);
            PG8_WAIT_L(8); PG8_BAR; PG8_WAIT_L(0); PG8_MMA(0, 0, At, B0); PG8_BAR; PG8_SCHED;
            PG8_LDB(B1, 1, 1); PG8_STAGE(PG8_SB(1, 0), b3, voffB);
            PG8_BAR; PG8_WAIT_L(0); PG8_MMA(0, 1, At, B1); PG8_BAR;
            PG8_LDA(At, 1, 1); PG8_STAGE(PG8_SA(1, 0), a3, voffA);
            PG8_BAR; PG8_WAIT_L(0); PG8_MMA(1, 0, At, B0); PG8_BAR; PG8_SCHED;
            PG8_STAGE(PG8_SB(1, 1), b3 + hstep, voffB);
            PG8_WAIT_V(6); PG8_BAR; PG8_MMA(1, 1, At, B1); PG8_BAR;
            }
        }
        if constexpr (ALIGN_EPI) { if (wr == 0) PG8_BAR; }
        if constexpr (!Epi::AFTER_DRAIN) { E(acc, cur, wr, wc, fr, fq); S.done(cur); }
        if (!has_next) break;
#pragma unroll
        for (int a = 0; a < 2; ++a)
#pragma unroll
            for (int b = 0; b < 2; ++b)
#pragma unroll
                for (int m = 0; m < 4; ++m)
#pragma unroll
                    for (int n = 0; n < 2; ++n) acc[a][b][m][n] = (f32x4){0.f, 0.f, 0.f, 0.f};
        cur = nxt; cA = nA; cB = nB; ++ui;
        if constexpr (ALIGN_EPI) { if (wr == 1) PG8_BAR; }
    }
    PG8_WAIT_V(0);
    if constexpr (!ALIGN_EPI) { if (wr == 0) PG8_BAR; }
    PG8_BAR;
    if constexpr (Epi::AFTER_DRAIN) { E.fused(acc, cur, wr, wc, fr, fq, lds, wid, lane); S.done(cur); }
#undef PG8_SA
#undef PG8_SB
#undef PG8_STAGE
#undef PG8_LDA
#undef PG8_LDB
#undef PG8_MMA
#undef PG8_WAIT_V
#undef PG8_WAIT_L
#undef PG8_BAR
#undef PG8_SCHED
}
}

#define LAS __attribute__((address_space(3)))
typedef unsigned short bf16;
typedef short bf16x8 __attribute__((ext_vector_type(8)));
typedef float f32x4 __attribute__((ext_vector_type(4)));
typedef float f32x16 __attribute__((ext_vector_type(16)));
typedef unsigned u32x4 __attribute__((ext_vector_type(4)));
typedef unsigned u32x2 __attribute__((ext_vector_type(2)));
typedef float f32x2_t __attribute__((ext_vector_type(2)));
typedef __bf16 bf16x2_t __attribute__((ext_vector_type(2)));
#define MFMA32(a, b, c) __builtin_amdgcn_mfma_f32_32x32x16_bf16((a), (b), (c), 0, 0, 0)
__device__ __forceinline__ unsigned cvtpk(float lo, float hi) { f32x2_t v = {lo, hi}; bf16x2_t b = __builtin_convertvector(v, bf16x2_t); return __builtin_bit_cast(unsigned, b); }
__device__ __forceinline__ float bflo(unsigned w) { return __uint_as_float(w << 16); }
__device__ __forceinline__ float bfhi(unsigned w) { return __uint_as_float(w & 0xffff0000u); }
__device__ __forceinline__ int crow(int i, int hh) { return (i & 3) + 8 * (i >> 2) + 4 * hh; }
__device__ __forceinline__ int pi32(int r) { return (r & ~12) | ((r & 4) << 1) | ((r & 8) >> 1); }
__device__ __forceinline__ bf16x8 packf(const f32x16& s, int half) {
    u32x4 w;
    if (half == 0) { w.x = cvtpk(s[0], s[1]); w.y = cvtpk(s[2], s[3]); w.z = cvtpk(s[4], s[5]); w.w = cvtpk(s[6], s[7]); }
    else { w.x = cvtpk(s[8], s[9]); w.y = cvtpk(s[10], s[11]); w.z = cvtpk(s[12], s[13]); w.w = cvtpk(s[14], s[15]); }
    return __builtin_bit_cast(bf16x8, w);
}
__device__ __forceinline__ float wave_sum(float v) { v = XSUM_SWZ(v, 1); v = XSUM_SWZ(v, 2); v = XSUM_SWZ(v, 4); v = XSUM_SWZ(v, 8); v = XSUM_SWZ(v, 16); return xsum32(v); }
__device__ __forceinline__ float wave_max(float v) { v = XMAX_SWZ(v, 1); v = XMAX_SWZ(v, 2); v = XMAX_SWZ(v, 4); v = XMAX_SWZ(v, 8); v = XMAX_SWZ(v, 16); return xmax32(v); }
__device__ __forceinline__ void glds16(const void* g, LAS unsigned char* l) { __builtin_amdgcn_global_load_lds((const unsigned*)g, (LAS unsigned*)l, 16, 0, 0); }

constexpr int NTOK = 16384, SEQ = 8192, DM = 1024, FFH = 2816, MEML = 256;
constexpr float EPS = 1e-6f;
constexpr float LOG2E = 1.4426950408889634f;
constexpr size_t MiB = 1u << 20;
constexpr size_t WS_SSQ1 = 0, WS_SSQ2 = 65536, WS_RSTD1 = 131072, WS_RSTDM = 196608;
constexpr size_t WS_CS = 1 * MiB;
constexpr size_t WS_WN = 3 * MiB;
constexpr size_t WS_WTR = 8 * MiB;
constexpr size_t WS_WOUT = 11 * MiB, WS_XQ = 13 * MiB, WS_XKV = 15 * MiB, WS_XO = 19 * MiB;
constexpr size_t WS_WGU = 21 * MiB;
constexpr size_t WS_WD = 32 * MiB;
constexpr size_t WS_XB = 38 * MiB;
constexpr size_t WS_PROJ = 70 * MiB;
constexpr size_t WS_TR = 150 * MiB;
constexpr size_t WS_MIX = 198 * MiB;
constexpr size_t WS_KVS = 230 * MiB;
constexpr size_t WS_K2 = 246 * MiB, WS_V2T = 247 * MiB, WS_MEMB = 248 * MiB, WS_PARTL = 249 * MiB;
constexpr size_t WS_BAR = 250 * MiB;
constexpr size_t WS_END = 256 * MiB;
constexpr int LDS_BYTES = 147456;

struct Params { const float* in[21]; float* out; unsigned char* ws; int use_cg; int pad; };

template <int NCH> __device__ __forceinline__ void otile_put(LAS unsigned char* stg, int r, int hh, int chunk, u32x2 w) { *(LAS u32x2*)(stg + r * (NCH * 16) + ((chunk ^ (r & (NCH - 1))) << 4) + hh * 8) = w; }
template <int NCH> __device__ __forceinline__ void otile_flush(const LAS unsigned char* stg, bf16* g, int ld, int lane_) {
    int lane = lane_; asm volatile("" : "+v"(lane));
#pragma unroll
    for (int i = 0; i < NCH / 2; ++i) { const int row = i * (64 / NCH) + lane / NCH, chunk = lane % NCH;
        const u32x4 v = *(const LAS u32x4*)(stg + row * (NCH * 16) + ((chunk ^ (row & (NCH - 1))) << 4));
        *(u32x4*)(g + (size_t)row * ld + chunk * 8) = v; }
}

__device__ __forceinline__ int rperm32(int c) { return 256 * (c >> 8) + 128 * ((c & 63) >> 5) + 32 * ((c & 255) >> 6); }
struct TrDesc { const float* W; const float* gain; bf16* D0; bf16* D1; int K, N, d0, d1, item; };
__device__ __forceinline__ void tr_load(const TrDesc& t, float (&wv)[32], int lane) {
    const int nblk = t.N / 32, kb = t.item / nblk, nb = t.item % nblk, k0 = 64 * kb, n0 = 32 * nb;
#pragma unroll
    for (int i = 0; i < 32; ++i) { const int kk = 2 * i + (lane >> 5); wv[i] = t.W[(size_t)(k0 + kk) * t.N + n0 + (lane & 31)]; }
}
__device__ __forceinline__ void tr_store(const TrDesc& t, const float (&wv)[32], LAS float* scr, int lane) {
    const int nblk = t.N / 32, kb = t.item / nblk, k0 = 64 * kb;
#pragma unroll
    for (int i = 0; i < 32; ++i) { const int kk = 2 * i + (lane >> 5); const float g = t.gain ? t.gain[k0 + kk] : 1.0f; scr[kk * 33 + (lane & 31)] = wv[i] * g; }
    asm volatile("s_waitcnt lgkmcnt(0)" ::: "memory");
    const int c = lane & 7;
#pragma unroll
    for (int j = 0; j < 4; ++j) { const int n = (lane >> 3) + 8 * j; const LAS float* s = scr + (8 * c) * 33 + n;
        u32x4 o; o.x = cvtpk(s[0 * 33], s[1 * 33]); o.y = cvtpk(s[2 * 33], s[3 * 33]); o.z = cvtpk(s[4 * 33], s[5 * 33]); o.w = cvtpk(s[6 * 33], s[7 * 33]);
        if (t.D0) *(u32x4*)(t.D0 + (size_t)(t.d0 + n) * t.K + k0 + 8 * c) = o;
        if (t.D1) *(u32x4*)(t.D1 + (size_t)(t.d1 + n) * t.K + k0 + 8 * c) = o; }
    asm volatile("s_waitcnt lgkmcnt(0)" ::: "memory");
}
__device__ __forceinline__ TrDesc tr_decode(const Params& P, int it) {
    unsigned char* ws = P.ws; bf16* WN = (bf16*)(ws + WS_WN); bf16* WTR = (bf16*)(ws + WS_WTR);
    constexpr int I0 = 16 * 112, I1 = 512, I2 = 512, I3 = 16 * 64, I4 = 512, I5 = 16 * 88, I6 = 16 * 88;
    TrDesc t; t.D1 = nullptr; t.d1 = 0; t.K = 1024; int r = it;
    if (r < I0) { const int n0 = 32 * (r % 112), seg = n0 >> 9, wi = n0 & 511;
        t.W = P.in[3]; t.N = 3584; t.gain = P.in[2]; t.D0 = nullptr; t.d0 = 0; t.item = r;
        if (seg == 0) { t.D0 = WN; t.d0 = rperm32(wi); }
        else if (seg == 1) { t.D0 = WN; t.d0 = 512 + rperm32(wi); t.D1 = WTR; t.d1 = rperm32(wi); }
        else if (seg == 2) { t.D1 = WTR; t.d1 = 512 + wi; }
        else if (seg == 3) { t.D0 = WN; t.d0 = 1024 + wi; }
        else if (seg == 4) { t.D0 = WN; t.d0 = 1536 + rperm32(wi); }
        else if (seg == 5) { t.D0 = WN; t.d0 = 2048 + rperm32(wi); }
        else { t.D1 = WTR; t.d1 = 1024 + wi; }
        return t; }
    r -= I0;
    if (r < I1) { t.W = P.in[9]; t.N = 1024; t.gain = P.in[8]; t.D0 = (bf16*)(ws + WS_WOUT); t.d0 = 32 * (r % 32); t.item = r; return t; } r -= I1;
    if (r < I2) { t.W = P.in[12]; t.N = 1024; t.gain = P.in[10]; t.D0 = (bf16*)(ws + WS_XQ); t.d0 = 32 * (r % 32); t.item = r; return t; } r -= I2;
    if (r < I3) { t.W = P.in[13]; t.N = 2048; t.gain = P.in[11]; t.D0 = (bf16*)(ws + WS_XKV); t.d0 = 32 * (r % 64); t.item = r; return t; } r -= I3;
    if (r < I4) { t.W = P.in[16]; t.N = 1024; t.gain = nullptr; t.D0 = (bf16*)(ws + WS_XO); t.d0 = 32 * (r % 32); t.item = r; return t; } r -= I4;
    if (r < I5) { const int n0 = 32 * (r % 88); t.W = P.in[18]; t.N = 2816; t.gain = P.in[17]; t.D0 = (bf16*)(ws + WS_WGU); t.d0 = (n0 >> 7) * 256 + (n0 & 127); t.item = r; return t; } r -= I5;
    if (r < I6) { const int n0 = 32 * (r % 88); t.W = P.in[19]; t.N = 2816; t.gain = P.in[17]; t.D0 = (bf16*)(ws + WS_WGU); t.d0 = (n0 >> 7) * 256 + 128 + (n0 & 127); t.item = r; return t; } r -= I6;
    t.W = P.in[20]; t.K = 2816; t.N = 1024; t.gain = nullptr; t.D0 = (bf16*)(ws + WS_WD); t.d0 = 32 * (r % 32); t.item = r; return t;
}
template <int NR> __device__ __forceinline__ void rows_to_bf16(const float* x, bf16* o, float* rstd_out, int m0, int mstride, int lane) {
    f32x4 v[NR][4]; float s[NR];
#pragma unroll
    for (int q = 0; q < NR; ++q) { const f32x4* xr = (const f32x4*)(x + (size_t)(m0 + q * mstride) * DM) + lane;
#pragma unroll
        for (int j = 0; j < 4; ++j) v[q][j] = xr[64 * j]; }
#pragma unroll
    for (int q = 0; q < NR; ++q) { float a = 0.f;
#pragma unroll
        for (int j = 0; j < 4; ++j) a += (v[q][j][0] * v[q][j][0] + v[q][j][1] * v[q][j][1]) + (v[q][j][2] * v[q][j][2] + v[q][j][3] * v[q][j][3]);
        s[q] = wave_sum(a); }
#pragma unroll
    for (int q = 0; q < NR; ++q) { u32x2* o8 = (u32x2*)(o + (size_t)(m0 + q * mstride) * DM) + lane;
#pragma unroll
        for (int j = 0; j < 4; ++j) { u32x2 w; w.x = cvtpk(v[q][j][0], v[q][j][1]); w.y = cvtpk(v[q][j][2], v[q][j][3]); o8[64 * j] = w; }
        if (lane == 0) rstd_out[m0 + q * mstride] = rsqrtf(s[q] * (1.0f / 1024.0f) + EPS); }
}
__device__ __forceinline__ void p0_prologue(const Params& P, LAS unsigned char* lds, int wid_s) {
    const int lane = lane_id_asm(), wid = wid_s, tid = wid * 64 + lane;
    const int gw = blockIdx.x * 8 + wid, NGW = gridDim.x * 8;
    unsigned char* ws = P.ws;
    LAS float* scr = (LAS float*)(lds + wid * 16384);
    constexpr int NIT = 16 * 112 + 512 + 512 + 16 * 64 + 512 + 16 * 88 + 16 * 88 + 44 * 32;
    if (gw < NIT) {
        int it = gw; TrDesc cur = tr_decode(P, it); float a[32]; tr_load(cur, a, lane);
        for (;;) {
            const int nx = it + NGW; const bool has = nx < NIT; TrDesc nxt = cur; float bnx[32];
            if (has) { nxt = tr_decode(P, nx); tr_load(nxt, bnx, lane); }
            tr_store(cur, a, scr, lane);
            if (!has) break;
            cur = nxt; it = nx;
#pragma unroll
            for (int i = 0; i < 32; ++i) a[i] = bnx[i];
        }
    }
    {   int m = gw;
        for (; m + 3 * NGW < NTOK; m += 4 * NGW) rows_to_bf16<4>(P.in[0], (bf16*)(ws + WS_XB), (float*)(ws + WS_RSTD1), m, NGW, lane);
        for (; m < NTOK; m += NGW) rows_to_bf16<1>(P.in[0], (bf16*)(ws + WS_XB), (float*)(ws + WS_RSTD1), m, NGW, lane); }
    for (int m = gw; m < 2 * MEML; m += NGW) rows_to_bf16<1>(P.in[1], (bf16*)(ws + WS_MEMB), (float*)(ws + WS_RSTDM), m, NGW, lane);
    const int gt = blockIdx.x * 512 + tid, NGT = gridDim.x * 512;
    for (int e = gt; e < SEQ * 32; e += NGT) {
        const int pos = e >> 5, i = e & 31;
        const float inv = 1.0f / exp2f((float)i * (1.0f / 31.0f) * 13.287712379549449f);
        const float ang = (float)pos * inv;
        double t = (double)ang * 0.15915494309189535; t -= floor(t);
        const float tf = (float)t;
        float2 v; v.x = __builtin_amdgcn_cosf(tf); v.y = __builtin_amdgcn_sinf(tf);
        ((float2*)(ws + WS_CS))[e] = v;
    }
    for (int e = gt; e < NTOK; e += NGT) { ((float*)(ws + WS_SSQ1))[e] = 0.f; ((float*)(ws + WS_SSQ2))[e] = 0.f; }
}

__device__ __forceinline__ float ret_l2g(int h) { return log1pf(-exp2f(-5.0f - (float)h)) * LOG2E; }
__device__ __forceinline__ void ret_kv_phase(const Params& P, int wid_s) {
    const int lane = lane_id_asm(), wid = wid_s, tid = wid * 64 + lane, r = lane & 31, hh = lane >> 5;
    const bf16* TR = (const bf16*)(P.ws + WS_TR); float* KVS = (float*)(P.ws + WS_KVS);
    for (int pair = blockIdx.x; pair < 512; pair += gridDim.x) {
        const int chunk = pair * 2 + (wid >> 2), j = wid & 3, bh = chunk >> 6, n = chunk & 63, b = bh >> 3, h = bh & 7, a = j >> 1, bb = j & 1;
        const size_t tok0 = (size_t)b * SEQ + n * 128;
        const bf16* vt = TR + (size_t)(512 + h * 64 + 32 * a + r) * NTOK + tok0 + 8 * hh;
        const bf16* kt = TR + (size_t)(h * 64 + 32 * bb + r) * NTOK + tok0 + 8 * hh;
        f32x16 acc = {};
#pragma unroll
        for (int s = 0; s < 8; ++s) acc = MFMA32(*(const bf16x8*)(vt + 16 * s), *(const bf16x8*)(kt + 16 * s), acc);
        float* dst = KVS + (size_t)chunk * 4096 + (32 * a) * 64 + 32 * bb + r;
#pragma unroll
        for (int i = 0; i < 16; ++i) dst[crow(i, hh) * 64] = acc[i];
    }
}
__device__ __forceinline__ void ret_scan_phase(const Params& P, int wid_s) {
    float* KVS = (float*)(P.ws + WS_KVS);
    if (wid_s >= 4) return;
    for (int e = blockIdx.x * 256 + wid_s * 64 + lane_id_asm(); e < 16 * 4096; e += gridDim.x * 256) {
        const int bh = e >> 12, el = e & 4095, h = bh & 7;
        const float gC = exp2f(128.0f * ret_l2g(h));
        unsigned idx = (unsigned)(bh * 64 * 4096 + el); float R = 0.f;
        for (int n0 = 0; n0 < 64; n0 += 16) { float t[16];
#pragma unroll
            for (int k = 0; k < 16; ++k) t[k] = KVS[idx + (unsigned)(k * 4096)];
#pragma unroll
            for (int k = 0; k < 16; ++k) { KVS[idx + (unsigned)(k * 4096)] = R; R = R * gC + t[k]; }
            idx += 16 * 4096; }
    }
}
template <int MODE = 0> __device__ __forceinline__ void ret_out_phase(const Params& P, LAS unsigned char* lds, int wid_s) {
    const int lane = lane_id_asm(), wid = wid_s, r = lane & 31, hh = lane >> 5;
    const bf16* PROJ = (const bf16*)(P.ws + WS_PROJ); const bf16* TR = (const bf16*)(P.ws + WS_TR); const float* KVS = (const float*)(P.ws + WS_KVS); bf16* MIX = (bf16*)(P.ws + WS_MIX);
    const int cg = wid >> 2, j = wid & 3, tl = j * 64 + lane;
    LAS unsigned char* base = lds + cg * 65536;
    for (int pair = blockIdx.x; pair < 512; pair += gridDim.x) {
        const int chunk = pair * 2 + cg, bh = chunk >> 6, n = chunk & 63, b = bh >> 3, h = bh & 7;
        const size_t tok0 = (size_t)b * SEQ + n * 128; const int c0 = 32 * j;
        const float l2g = ret_l2g(h);
        __syncthreads();
        {   u32x4 t0_[4], t1_[4], t2_[4], t3_[4];
#pragma unroll
            for (int k = 0; k < 4; ++k) { const int idx = tl + 256 * k, row = idx >> 3, piece = idx & 7; const bf16* src = PROJ + (tok0 + row) * 2560 + h * 64 + piece * 8;
                t0_[k] = *(const u32x4*)(src); t1_[k] = *(const u32x4*)(src + 512); t2_[k] = *(const u32x4*)(src + 1024);
                const int vrow = idx >> 4, vpiece = idx & 15; t3_[k] = *(const u32x4*)(TR + (size_t)(512 + h * 64 + vrow) * NTOK + tok0 + vpiece * 8); }
#pragma unroll
            for (int k = 0; k < 4; ++k) { const int idx = tl + 256 * k, row = idx >> 3, piece = idx & 7; const int off = row * 128 + ((piece ^ ((row >> 1) & 7)) << 4);
                *(LAS u32x4*)(base + off) = t0_[k]; *(LAS u32x4*)(base + 16384 + off) = t1_[k]; *(LAS u32x4*)(base + 32768 + off) = t2_[k];
                const int vrow = idx >> 4, vpiece = idx & 15; *(LAS u32x4*)(base + 49152 + vrow * 256 + ((vpiece ^ (vrow & 15)) << 4)) = t3_[k]; }
        }
        __syncthreads();
        bf16x8 qf[4];
        { const int row = c0 + r;
#pragma unroll
          for (int d0 = 0; d0 < 4; ++d0) qf[d0] = *(const LAS bf16x8*)(base + row * 128 + (((2 * d0 + hh) ^ ((row >> 1) & 7)) << 4)); }
        f32x16 o[2]; o[0] = f32x16{}; o[1] = f32x16{};
        for (int jb = 0; jb <= j; ++jb) {
            const int krow = 32 * jb + pi32(r);
            f32x16 S = {};
#pragma unroll
            for (int d0 = 0; d0 < 4; ++d0) S = MFMA32(*(const LAS bf16x8*)(base + 16384 + krow * 128 + (((2 * d0 + hh) ^ ((krow >> 1) & 7)) << 4)), qf[d0], S);
#pragma unroll
            for (int i = 0; i < 16; ++i) { const int kvi = 32 * jb + 16 * (i >> 3) + 8 * hh + (i & 7); const int rel = (c0 + r) - kvi;
                S[i] = rel >= 0 ? S[i] * __builtin_amdgcn_exp2f(l2g * (float)rel) : 0.f; }
            const bf16x8 pk0 = packf(S, 0), pk1 = packf(S, 1);
#pragma unroll
            for (int a = 0; a < 2; ++a) { const int vrow = 32 * a + r;
                o[a] = MFMA32(*(const LAS bf16x8*)(base + 49152 + vrow * 256 + (((4 * jb + hh) ^ (vrow & 15)) << 4)), pk0, o[a]);
                o[a] = MFMA32(*(const LAS bf16x8*)(base + 49152 + vrow * 256 + (((4 * jb + 2 + hh) ^ (vrow & 15)) << 4)), pk1, o[a]); }
        }
        const float xi = exp2f(l2g * (float)(c0 + r + 1));
#pragma unroll
        for (int a = 0; a < 2; ++a) { f32x16 t = {}; const float* rp = KVS + (size_t)chunk * 4096 + (32 * a + r) * 64 + 8 * hh;
#pragma unroll
            for (int d0 = 0; d0 < 4; ++d0) { const f32x4 lo = *(const f32x4*)(rp + 16 * d0), hi4 = *(const f32x4*)(rp + 16 * d0 + 4);
                u32x4 w; w.x = cvtpk(lo[0], lo[1]); w.y = cvtpk(lo[2], lo[3]); w.z = cvtpk(hi4[0], hi4[1]); w.w = cvtpk(hi4[2], hi4[3]);
                t = MFMA32(__builtin_bit_cast(bf16x8, w), qf[d0], t); }
#pragma unroll
            for (int i = 0; i < 16; ++i) o[a][i] += t[i] * xi; }
        float ss = 0.f;
#pragma unroll
        for (int a = 0; a < 2; ++a)
#pragma unroll
            for (int i = 0; i < 16; ++i) ss += o[a][i] * o[a][i];
        ss = xsum32(ss);
        const float rr = rsqrtf(ss * (1.0f / 64.0f) + EPS);
        LAS unsigned char* stg = base + c0 * 128;
        { const int row = c0 + r;
#pragma unroll
          for (int a = 0; a < 2; ++a)
#pragma unroll
              for (int g = 0; g < 4; ++g) {
                  const u32x2 gw = *(const LAS u32x2*)(base + 32768 + row * 128 + (((4 * a + g) ^ ((row >> 1) & 7)) << 4) + hh * 8);
                  u32x2 w; w.x = cvtpk(o[a][4 * g] * rr * bflo(gw.x), o[a][4 * g + 1] * rr * bfhi(gw.x)); w.y = cvtpk(o[a][4 * g + 2] * rr * bflo(gw.y), o[a][4 * g + 3] * rr * bfhi(gw.y));
                  otile_put<8>(stg, r, hh, 4 * a + g, w); } }
        otile_flush<8>(stg, MIX + (tok0 + c0) * 1024 + h * 64, 1024, lane);
    }
    __syncthreads();
}

struct DiffCtx { const bf16* PROJ; const bf16* TR; bf16* MIX; float* partO0; float* partO1; float* partL0; float* partL1; unsigned* flags; const float* subln; float lam; float shift; };
__device__ __forceinline__ void diff_epilogue(f32x16 (&o)[4], const DiffCtx& C, size_t tokw, int h, int lane, LAS unsigned char* stg) {
    const int r = lane & 31, hh = lane >> 5;
    float ss = 0.f;
#pragma unroll
    for (int db = 0; db < 4; ++db)
#pragma unroll
        for (int i = 0; i < 16; ++i) ss += o[db][i] * o[db][i];
    ss = xsum32(ss);
    const float rr = rsqrtf(ss * (1.0f / 128.0f) + EPS) * 0.8f;
#pragma unroll
    for (int db = 0; db < 4; ++db)
#pragma unroll
        for (int g = 0; g < 4; ++g) { const int d = 32 * db + 8 * g + 4 * hh; const f32x4 sg = *(const f32x4*)(C.subln + d);
            u32x2 w; w.x = cvtpk(o[db][4 * g] * rr * sg[0], o[db][4 * g + 1] * rr * sg[1]); w.y = cvtpk(o[db][4 * g + 2] * rr * sg[2], o[db][4 * g + 3] * rr * sg[3]);
            otile_put<16>(stg, r, hh, 4 * db + g, w); }
    otile_flush<16>(stg, C.MIX + tokw * 1024 + 512 + h * 128, 1024, lane);
}
template <bool SHIFT, int MODE = 0> __device__ __forceinline__ void diff_segment(const DiffCtx& C, LAS unsigned char* lds, int b, int h, int qb, int t0, int t1, int outmode, int unitidx, int wid_s) {
    const int lane = lane_id_asm(), wid = wid_s, r = lane & 31, hh = lane >> 5;
    const int q0 = 256 * qb + 32 * wid; const size_t tokbase = (size_t)b * SEQ;
    bf16x8 qf[2][4];
    { const bf16* qp = C.PROJ + (tokbase + q0 + r) * 2560 + 1536 + h * 128 + 8 * hh;
#pragma unroll
      for (int mp = 0; mp < 2; ++mp)
#pragma unroll
          for (int d0 = 0; d0 < 4; ++d0) qf[mp][d0] = *(const bf16x8*)(qp + mp * 64 + d0 * 16); }
    f32x16 o[2][4];
#pragma unroll
    for (int mp = 0; mp < 2; ++mp)
#pragma unroll
        for (int db = 0; db < 4; ++db) o[mp][db] = f32x16{};
    float l0 = 0.f, l1 = 0.f;
    unsigned kg[4], vg[4];
    const bf16* kbase = C.PROJ + tokbase * 2560 + 2048 + h * 128; const bf16* vbase = C.TR + (size_t)(1024 + h * 128) * NTOK + tokbase;
#pragma unroll
    for (int j = 0; j < 4; ++j) { const int c = wid * 4 + j, row = 4 * c + (lane >> 4), pc = (lane & 15) ^ (row & 15);
        kg[j] = (unsigned)(row * 2560 + pc * 8); vg[j] = (unsigned)(row * NTOK + pc * 8); }
#define DIFF_STAGE(t, buf) do { _Pragma("unroll") for (int j_ = 0; j_ < 4; ++j_) { \
        glds16(kbase + (size_t)(t) * 128 * 2560 + kg[j_], lds + (buf) * 65536 + (wid * 4 + j_) * 1024); \
        glds16(vbase + (size_t)(t) * 128 + vg[j_], lds + (buf) * 65536 + 32768 + (wid * 4 + j_) * 1024); } } while (0)
    DIFF_STAGE(t0, 0);
    for (int t = t0; t < t1; ++t) {
        const int buf = (t - t0) & 1;
        asm volatile("s_waitcnt vmcnt(0)" ::: "memory"); __syncthreads();
        if (t + 1 < t1) DIFF_STAGE(t + 1, buf ^ 1);
        const int k0 = 128 * t;
        if (k0 <= q0 + 31) {
            const LAS unsigned char* Kb = lds + buf * 65536; const LAS unsigned char* Vb = Kb + 32768;
            const bool needmask = (k0 + 127 > q0);
#pragma unroll
            for (int kb = 0; kb < 4; ++kb) {
                if (k0 + 32 * kb <= q0 + 31) {
                const int krow = 32 * kb + pi32(r);
                bf16x8 pk[2][2];
#pragma unroll
                for (int mp = 0; mp < 2; ++mp) {
                    f32x16 S = {};
#pragma unroll
                    for (int d0 = 0; d0 < 4; ++d0) { const int piece = mp * 8 + 2 * d0 + hh;
                        const bf16x8 kf = *(const LAS bf16x8*)(Kb + krow * 256 + ((piece ^ (krow & 15)) << 4));
                        S = MFMA32(kf, qf[mp][d0], S); }
                    float ls = 0.f;
#pragma unroll
                    for (int i = 0; i < 16; ++i) { float p = __builtin_amdgcn_exp2f(SHIFT ? S[i] - C.shift : S[i]);
                        if (needmask) { const int kv = k0 + 32 * kb + 16 * (i >> 3) + 8 * hh + (i & 7); if (kv > q0 + r) p = 0.f; }
                        S[i] = p; ls += p; }
                    if (mp == 0) l0 += ls; else l1 += ls;
                    pk[mp][0] = packf(S, 0); pk[mp][1] = packf(S, 1);
                }
#pragma unroll
                for (int db = 0; db < 4; ++db) { const int vrow = 32 * db + r;
#pragma unroll
                    for (int s2 = 0; s2 < 2; ++s2) { const int piece = 2 * (2 * kb + s2) + hh;
                        const bf16x8 vf = *(const LAS bf16x8*)(Vb + vrow * 256 + ((piece ^ (vrow & 15)) << 4));
                        o[0][db] = MFMA32(vf, pk[0][s2], o[0][db]); o[1][db] = MFMA32(vf, pk[1][s2], o[1][db]); } }
                }
            }
        }
    }
#undef DIFF_STAGE
    __syncthreads();
    l0 = xsum32(l0); l1 = xsum32(l1);
    if (outmode == 2) {
        if (wid == 0 && lane == 0) { unsigned sp = 0; while (__hip_atomic_load(C.flags + 64 * unitidx, __ATOMIC_RELAXED, __HIP_MEMORY_SCOPE_AGENT) == 0u && ++sp < (1u << 22)) __builtin_amdgcn_s_sleep(1);
            __builtin_amdgcn_fence(__ATOMIC_ACQUIRE, "agent"); asm volatile("s_waitcnt vmcnt(0)" ::: "memory"); }
        __syncthreads();
        const float* po = C.partO0 + (size_t)(unitidx * 8 + wid) * 8192 + lane;
#pragma unroll
        for (int mp = 0; mp < 2; ++mp)
#pragma unroll
            for (int db = 0; db < 4; ++db) { const float* pp = po + (mp * 4 + db) * 1024; asm volatile("" : "+v"(pp));
#pragma unroll
                for (int i = 0; i < 16; ++i) o[mp][db][i] += pp[i * 64]; }
        const float* pl = C.partL0 + (size_t)(unitidx * 8 + wid) * 128 + lane; l0 += pl[0]; l1 += pl[64];
    }
    if (outmode != 1) { const float i0 = 1.0f / l0, i1 = C.lam / l1;
#pragma unroll
        for (int db = 0; db < 4; ++db)
#pragma unroll
            for (int i = 0; i < 16; ++i) o[0][db][i] = o[0][db][i] * i0 - o[1][db][i] * i1;
        diff_epilogue(o[0], C, tokbase + q0, h, lane, lds + wid * 8192); }
    else {
        float* po = C.partO0 + (size_t)(unitidx * 8 + wid) * 8192 + lane;
#pragma unroll
        for (int mp = 0; mp < 2; ++mp)
#pragma unroll
            for (int db = 0; db < 4; ++db) { float* pp = po + (mp * 4 + db) * 1024; asm volatile("" : "+v"(pp));
#pragma unroll
                for (int i = 0; i < 16; ++i) pp[i * 64] = o[mp][db][i]; }
        float* pl = C.partL0 + (size_t)(unitidx * 8 + wid) * 128 + lane; pl[0] = l0; pl[64] = l1;
    }
    asm volatile("s_waitcnt vmcnt(0)" ::: "memory");
    __syncthreads();
    if (outmode == 1 && wid == 0 && lane == 0) { __builtin_amdgcn_fence(__ATOMIC_RELEASE, "agent"); asm volatile("s_waitcnt vmcnt(0)" ::: "memory");
        (void)__hip_atomic_fetch_add(C.flags + 64 * unitidx, 1u, __ATOMIC_RELAXED, __HIP_MEMORY_SCOPE_AGENT); }
}
__device__ __forceinline__ DiffCtx diff_ctx(const Params& P) {
    const int lane = lane_id_asm();
    DiffCtx C; C.PROJ = (const bf16*)(P.ws + WS_PROJ); C.TR = (const bf16*)(P.ws + WS_TR); C.MIX = (bf16*)(P.ws + WS_MIX);
    C.partO0 = P.out; C.partO1 = (float*)(P.ws + WS_XB); C.partL0 = (float*)(P.ws + WS_PARTL); C.partL1 = (float*)(P.ws + WS_PARTL + 512 * 1024);
    C.subln = P.in[7]; C.flags = (unsigned*)(P.ws + WS_BAR + 16384);
    const float* lv = P.in[6];
    const float s01 = wave_sum(lv[lane] * lv[64 + lane]), s23 = wave_sum(lv[128 + lane] * lv[192 + lane]);
    C.lam = __uint_as_float(__builtin_amdgcn_readfirstlane(__float_as_uint(expf(s01) - expf(s23) + 0.2f)));
    const float mq = wave_max(fabsf(P.in[4][lane])), mk = wave_max(fabsf(P.in[5][lane]));
    C.shift = __uint_as_float(__builtin_amdgcn_readfirstlane(__float_as_uint(fmaxf(mq * mk * 64.0f * (0.125f * LOG2E) - 60.0f, 0.f))));
    return C;
}
__device__ __forceinline__ void diff_phase(const Params& P, LAS unsigned char* lds, int wid_s) {
    const DiffCtx C = diff_ctx(P);
    for (int pass = 0; pass < 2; ++pass)
    for (int v = blockIdx.x; v < 256; v += gridDim.x) {
        const int bh = v & 7, s = v >> 3, b = bh >> 2, h = bh & 3;
        if ((s < 16) != (pass == 0)) continue;
        const int q = s & 15, nseg = s < 16 ? 1 : 2;
        for (int sg = 0; sg < nseg; ++sg) {
            const bool small_ = (s >= 16) && sg == 0;
            const int a_qb = small_ ? q : 31 - q, a_t0 = small_ ? 0 : (s < 16 ? 0 : 33), a_t1 = small_ ? 2 * q + 2 : (s < 16 ? 33 : 64 - 2 * q), a_om = small_ ? 0 : (s < 16 ? 1 : 2), a_ui = bh * 16 + (15 - q);
            if (C.shift == 0.f) diff_segment<false>(C, lds, b, h, a_qb, a_t0, a_t1, a_om, a_ui, wid_s);
            else diff_segment<true>(C, lds, b, h, a_qb, a_t0, a_t1, a_om, a_ui, wid_s);
        }
    }
}
template <int MODE> __device__ __forceinline__ void diff_probe_phase(const Params& P, LAS unsigned char* lds, int wid_s) {
    const DiffCtx C = diff_ctx(P);
    for (int v = blockIdx.x; v < 256; v += gridDim.x) {
        const int bh = v & 7, s = v >> 3, b = bh >> 2, h = bh & 3;
        const int q = s & 15, nseg = s < 16 ? 1 : 2;
        for (int sg = 0; sg < nseg; ++sg) {
            const bool small_ = sg == 1;
            const int a_qb = small_ ? q : 31 - q, a_t0 = small_ ? 0 : (s < 16 ? 0 : 33), a_t1 = small_ ? 2 * q + 2 : (s < 16 ? 33 : 64 - 2 * q), a_om = small_ ? 0 : (s < 16 ? 1 : 2), a_ui = bh * 16 + (15 - q);
            diff_segment<false, MODE>(C, lds, b, h, a_qb, a_t0, a_t1, a_om, a_ui, wid_s);
        }
    }
}
__device__ __forceinline__ void diff_combine_phase(const Params& P, LAS unsigned char* lds, int wid_s) {
    const DiffCtx C = diff_ctx(P);
    const int lane = lane_id_asm(), wid = wid_s, tid = wid * 64 + lane, r = lane & 31, hh = lane >> 5;
    const float* A = C.partO0; const float* B = C.partO1;
    for (int it = blockIdx.x * 8 + wid; it < 1024; it += gridDim.x * 8) {
        const int unitidx = it >> 3, w = it & 7, bh = unitidx >> 4, qb = 16 + (unitidx & 15), b = bh >> 2, h = bh & 3;
        const unsigned base = (unsigned)it * 8192u + (unsigned)lane;
        const float l0 = C.partL0[it * 128 + lane] + C.partL1[it * 128 + lane], l1 = C.partL0[it * 128 + 64 + lane] + C.partL1[it * 128 + 64 + lane];
        const float i0 = 1.0f / l0, i1 = C.lam / l1;
        float ss = 0.f;
#pragma unroll
        for (int db = 0; db < 4; ++db) { unsigned o0 = base + db * 1024, o1 = base + 4096 + db * 1024; asm volatile("" : "+v"(o0), "+v"(o1));
#pragma unroll
            for (int i = 0; i < 16; ++i) { const float v = (A[o0 + i * 64] + B[o0 + i * 64]) * i0 - (A[o1 + i * 64] + B[o1 + i * 64]) * i1; ss += v * v; } }
        ss = xsum32(ss);
        const float rr = rsqrtf(ss * (1.0f / 128.0f) + EPS) * 0.8f;
        LAS unsigned char* stg = lds + wid * 8192;
#pragma unroll
        for (int db = 0; db < 4; ++db) { unsigned o0 = base + db * 1024, o1 = base + 4096 + db * 1024; asm volatile("" : "+v"(o0), "+v"(o1));
#pragma unroll
            for (int g = 0; g < 4; ++g) { const int d = 32 * db + 8 * g + 4 * hh; const f32x4 sg = *(const f32x4*)(C.subln + d); float v[4];
#pragma unroll
                for (int e = 0; e < 4; ++e) { const int i = 4 * g + e; v[e] = ((A[o0 + i * 64] + B[o0 + i * 64]) * i0 - (A[o1 + i * 64] + B[o1 + i * 64]) * i1) * rr * sg[e]; }
                u32x2 wv; wv.x = cvtpk(v[0], v[1]); wv.y = cvtpk(v[2], v[3]); otile_put<16>(stg, r, hh, 4 * db + g, wv); } }
        otile_flush<16>(stg, C.MIX + ((size_t)b * SEQ + 256 * qb + 32 * w) * 1024 + 512 + h * 128, 1024, lane);
    }
    __syncthreads();
}

__device__ __forceinline__ void kv2_phase(const Params& P, int wid_s) {
    const int lane = lane_id_asm(), r = lane & 31, hh = lane >> 5;
    const bf16* MEMB = (const bf16*)(P.ws + WS_MEMB); const bf16* XKV = (const bf16*)(P.ws + WS_XKV); const float* RSTDM = (const float*)(P.ws + WS_RSTDM);
    bf16* K2 = (bf16*)(P.ws + WS_K2); bf16* V2T = (bf16*)(P.ws + WS_V2T);
    if (wid_s < 4) return;
    for (int blk = (wid_s - 4) * gridDim.x + blockIdx.x; blk < 1024; blk += gridDim.x * 4) {
        const bool isv = blk >= 512; const int bb = blk & 511;
        const int rb = isv ? (bb >> 4) : (bb >> 5), cb = isv ? (bb & 15) : (bb & 31);
        const bf16* ap = (isv ? XKV + (size_t)(1024 + 32 * rb + r) * 1024 : MEMB + (size_t)(32 * rb + r) * 1024) + 8 * hh;
        const bf16* bp = (isv ? MEMB + (size_t)(32 * cb + r) * 1024 : XKV + (size_t)(32 * cb + r) * 1024) + 8 * hh;
        f32x16 acc = {};
#pragma unroll 16
        for (int s = 0; s < 64; ++s) acc = MFMA32(*(const bf16x8*)(ap + 16 * s), *(const bf16x8*)(bp + 16 * s), acc);
        if (!isv) {
#pragma unroll
            for (int i = 0; i < 16; ++i) { const int m = 32 * rb + crow(i, hh); const unsigned w = cvtpk(acc[i] * RSTDM[m], 0.f);
                *(unsigned short*)(K2 + (size_t)m * 1024 + 32 * cb + r) = (unsigned short)w; }
        } else { const float rs = RSTDM[32 * cb + r];
#pragma unroll
            for (int i = 0; i < 16; ++i) { const int n = 32 * rb + crow(i, hh); const unsigned w = cvtpk(acc[i] * rs, 0.f);
                *(unsigned short*)(V2T + (size_t)n * 512 + 32 * cb + r) = (unsigned short)w; }
        }
    }
}

__device__ __forceinline__ void knorm_phase(const Params& P, int wid_s) {
    const int lane = lane_id_asm(); bf16* K2 = (bf16*)(P.ws + WS_K2); const float* gk = P.in[15];
    for (int t = blockIdx.x * 8 + wid_s; t < 2 * MEML * 4; t += gridDim.x * 8) {
        bf16* p = K2 + (size_t)(t >> 2) * 1024 + (t & 3) * 256 + 4 * lane;
        const u32x2 raw = *(const u32x2*)p; const f32x4 g = *(const f32x4*)(gk + 4 * lane);
        const float a0 = bflo(raw.x), a1 = bfhi(raw.x), a2 = bflo(raw.y), a3 = bfhi(raw.y);
        const float ss = wave_sum((a0 * a0 + a1 * a1) + (a2 * a2 + a3 * a3));
        const float rk = rsqrtf(ss * (1.0f / 256.0f) + EPS) * (0.0625f * LOG2E);
        u32x2 w; w.x = cvtpk(a0 * rk * g[0], a1 * rk * g[1]); w.y = cvtpk(a2 * rk * g[2], a3 * rk * g[3]);
        *(u32x2*)p = w;
    }
}

template <int MODE = 0> __device__ __forceinline__ void xattn_phase(const Params& P, LAS unsigned char* lds, int wid_s) {
    const int lane = lane_id_asm(), wid = wid_s, tid = wid * 64 + lane, r = lane & 31, hh = lane >> 5;
    const bf16* Q2 = (const bf16*)(P.ws + WS_PROJ); const bf16* K2 = (const bf16*)(P.ws + WS_K2); const bf16* V2T = (const bf16*)(P.ws + WS_V2T); bf16* O2 = (bf16*)(P.ws + WS_PROJ + 32 * MiB);
    const float* gq = P.in[14]; const float* gk = P.in[15];
    float mq = 0.f, mk = 0.f;
#pragma unroll
    for (int j = 0; j < 4; ++j) { mq = fmaxf(mq, fabsf(gq[lane + 64 * j])); mk = fmaxf(mk, fabsf(gk[lane + 64 * j])); }
    mq = wave_max(mq); mk = wave_max(mk);
    const float M2 = __uint_as_float(__builtin_amdgcn_readfirstlane(__float_as_uint(fmaxf(mq * mk * 256.0f * (0.0625f * LOG2E) - 60.0f, 0.f))));
    LAS unsigned char* Kb = lds; LAS unsigned char* Vb = lds + 32768; LAS unsigned char* Qb = lds + 65536;
    const int dh = wid >> 2;
    for (int item = blockIdx.x; item < 512; item += gridDim.x) {
        const int bhd = item >> 6, qblk = item & 63, b = bhd >> 2, head = bhd & 3;
        const size_t tokb = (size_t)b * SEQ + 128 * qblk; const size_t tok = tokb + 32 * (wid & 3) + r;
        __syncthreads();
        {
            const int sub = tid & 7; u32x4 raw[2][4];
#pragma unroll
            for (int p = 0; p < 2; ++p) { const bf16* qp = Q2 + (tokb + 64 * p + (tid >> 3)) * 1024 + head * 256 + 8 * sub;
#pragma unroll
                for (int k = 0; k < 4; ++k) raw[p][k] = *(const u32x4*)(qp + 64 * k); }
#pragma unroll
            for (int p = 0; p < 2; ++p) { const int row = 64 * p + (tid >> 3); float ss = 0.f;
#pragma unroll
                for (int k = 0; k < 4; ++k)
#pragma unroll
                    for (int e = 0; e < 4; ++e) { const float a = bflo(raw[p][k][e]), c = bfhi(raw[p][k][e]); ss += a * a + c * c; }
                ss = XSUM_SWZ(ss, 1); ss = XSUM_SWZ(ss, 2); ss = XSUM_SWZ(ss, 4);
                const float rq = rsqrtf(ss * (1.0f / 256.0f) + EPS);
                LAS unsigned char* qdst = Qb + (row >> 5) * 16384 + (row & 31) * 512;
#pragma unroll
                for (int k = 0; k < 4; ++k) { const int piece = sub + 8 * k; const f32x4 g0 = *(const f32x4*)(gq + 8 * piece), g1 = *(const f32x4*)(gq + 8 * piece + 4); u32x4 w;
                    w.x = cvtpk(bflo(raw[p][k].x) * rq * g0[0], bfhi(raw[p][k].x) * rq * g0[1]); w.y = cvtpk(bflo(raw[p][k].y) * rq * g0[2], bfhi(raw[p][k].y) * rq * g0[3]);
                    w.z = cvtpk(bflo(raw[p][k].z) * rq * g1[0], bfhi(raw[p][k].z) * rq * g1[1]); w.w = cvtpk(bflo(raw[p][k].w) * rq * g1[2], bfhi(raw[p][k].w) * rq * g1[3]);
                    *(LAS u32x4*)(qdst + ((piece ^ (row & 15)) << 4)) = w; } }
        }
        const LAS unsigned char* Qg = Qb + (wid & 3) * 16384 + r * 512;
        f32x16 o[8];
#pragma unroll
        for (int db = 0; db < 8; ++db) o[db] = f32x16{};
        float l = 0.f;
        const int krow_ = tid >> 3, ksub_ = tid & 7;
        const bf16* kp_ = K2 + (size_t)(b * MEML + krow_) * 1024 + head * 256 + 8 * ksub_;
        const bf16* vp_ = V2T + (size_t)(head * 256 + (tid >> 3)) * 512 + b * MEML + 8 * (tid & 7);
        for (int mt = 0; mt < 4; ++mt) {
            if (mt > 0) __syncthreads();
            if (MODE != 2) {   u32x4 kraw[4], vraw[4];
#pragma unroll
                for (int k = 0; k < 4; ++k) { kraw[k] = *(const u32x4*)(kp_ + (size_t)(64 * mt) * 1024 + 64 * k); vraw[k] = *(const u32x4*)(vp_ + (size_t)(64 * k) * 512 + 64 * mt); }
#pragma unroll
                for (int k = 0; k < 4; ++k) { const int piece = ksub_ + 8 * k; *(LAS u32x4*)(Kb + krow_ * 512 + ((piece ^ (krow_ & 15)) << 4)) = kraw[k]; }
#pragma unroll
                for (int k = 0; k < 4; ++k) { const int row = (tid >> 3) + 64 * k, piece = tid & 7;
                    *(LAS u32x4*)(Vb + row * 128 + ((piece ^ ((row >> 1) & 7)) << 4)) = vraw[k]; }
            }
            __syncthreads();
            if (MODE == 1) continue;
            bf16x8 pk[2];
            {   const int krow = 32 * dh + pi32(r); f32x16 S = {};
#pragma unroll 4
                for (int d0 = 0; d0 < 16; ++d0) { const int piece = 2 * d0 + hh;
                    const bf16x8 kf = *(const LAS bf16x8*)(Kb + krow * 512 + ((piece ^ (krow & 15)) << 4));
                    const bf16x8 qfr = *(const LAS bf16x8*)(Qg + ((piece ^ (r & 15)) << 4));
                    S = MFMA32(kf, qfr, S); }
#pragma unroll
                for (int i = 0; i < 16; ++i) { const float p = __builtin_amdgcn_exp2f(S[i] - M2); S[i] = p; l += p; }
                pk[0] = packf(S, 0); pk[1] = packf(S, 1); }
#pragma unroll
            for (int db = 0; db < 8; ++db) { const int vrow = 32 * db + r;
#pragma unroll
                for (int s2 = 0; s2 < 2; ++s2) { const int piece = 2 * (2 * dh + s2) + hh;
                    const bf16x8 vf = *(const LAS bf16x8*)(Vb + vrow * 128 + ((piece ^ ((vrow >> 1) & 7)) << 4));
                    o[db] = MFMA32(vf, pk[s2], o[db]); }
                if (db & 1) asm volatile("" ::: "memory"); }
        }
        l = xsum32(l);
        if (MODE != 0) { if (l + o[0][0] + o[7][7] == 123.456f) O2[0] = 0; continue; }
        __syncthreads();
        LAS float* xch = (LAS float*)(lds + (wid & 3) * 32768) + lane;
        if (dh == 1) {
#pragma unroll
            for (int db = 0; db < 8; ++db) {
#pragma unroll
                for (int i = 0; i < 16; ++i) xch[(db * 16 + i) * 64] = o[db][i];
                asm volatile("" ::: "memory"); }
            ((LAS float*)(lds + 131072))[(wid & 3) * 64 + lane] = l;
        }
        __syncthreads();
        if (dh == 0) {
            const float inv = 1.0f / (l + ((LAS float*)(lds + 131072))[(wid & 3) * 64 + lane]);
#pragma unroll
            for (int db = 0; db < 8; ++db) {
#pragma unroll
                for (int i = 0; i < 16; ++i) o[db][i] = (o[db][i] + xch[(db * 16 + i) * 64]) * inv;
                asm volatile("" ::: "memory"); }
            LAS unsigned char* stg = lds + (wid & 3) * 32768;
#pragma unroll
            for (int db = 0; db < 8; ++db)
#pragma unroll
                for (int g = 0; g < 4; ++g) {
                    u32x2 w; w.x = cvtpk(o[db][4 * g], o[db][4 * g + 1]); w.y = cvtpk(o[db][4 * g + 2], o[db][4 * g + 3]);
                    otile_put<32>(stg, r, hh, 4 * db + g, w); }
            otile_flush<32>(stg, O2 + (tokb + 32 * (wid & 3)) * 1024 + head * 256, 1024, lane);
        }
    }
    __syncthreads();
}

#define XB_TMO      128
#define XB_XCNT(j)  (256  + 64 * (j))
#define XB_XSUB(j)  (1280 + 64 * (j))
#define XB_XGEN(j)  (2304 + 64 * (j))
#define XB_TOP      3328
#define XB_TOPGEN   3392
#define XCD_BAR_WORDS 3456
#define XB_SPIN_CAP (1u << 18)

__device__ __forceinline__ unsigned xb_ld(unsigned* p)              { return __hip_atomic_load(p, __ATOMIC_RELAXED, __HIP_MEMORY_SCOPE_AGENT); }
__device__ __forceinline__ unsigned xb_add(unsigned* p, unsigned v) { return __hip_atomic_fetch_add(p, v, __ATOMIC_RELAXED, __HIP_MEMORY_SCOPE_AGENT); }
__device__ __forceinline__ unsigned xb_xcc_id() { return (unsigned)__builtin_amdgcn_s_getreg((3 << 11) | 20) & 0xFu; }
#define XB_SPIN(cond, bar) do { unsigned _sp = 0; while (cond) { __builtin_amdgcn_s_sleep(1); \
    if ((++_sp & 255u) == 0u) { if (xb_ld(&(bar)[XB_TMO])) break; if (_sp > XB_SPIN_CAP) { atomicAdd(&(bar)[XB_TMO], 1u); break; } } } } while (0)

struct XcdBarrier {
    unsigned* bar; unsigned x;
    volatile LAS unsigned* st;
};

__device__ __forceinline__ XcdBarrier xcd_barrier_post(unsigned* bar, volatile LAS unsigned* st, int wid_s) {
    XcdBarrier b; b.bar = bar; b.x = xb_xcc_id(); b.st = st;
    if (wid_s == 0 && lane_id_asm() == 0) (void)xb_add(&bar[XB_XCNT(b.x)], 1u);
    return b;
}
__device__ __forceinline__ void xcd_barrier_complete(unsigned* bar, unsigned x, unsigned& nloc, unsigned& nx) {
    const unsigned G = gridDim.x * gridDim.y * gridDim.z;
    unsigned sum, cnt, mine, sp = 0u;
    for (;;) {
        sum = 0u; cnt = 0u; mine = 0u;
#pragma unroll
        for (unsigned j = 0; j < 16; ++j) { const unsigned c = xb_ld(&bar[XB_XCNT(j)]); sum += c; cnt += (c > 0u) ? 1u : 0u; mine = (j == x) ? c : mine; }
        if (sum == G) break;
        __builtin_amdgcn_s_sleep(1);
        if ((++sp & 255u) == 0u) { if (xb_ld(&bar[XB_TMO])) break; if (sp > XB_SPIN_CAP) { atomicAdd(&bar[XB_TMO], 1u); break; } }
    }
    nloc = mine > 0u ? mine : 1u; nx = cnt > 0u ? cnt : 1u;
}

__device__ __forceinline__ void xcd_barrier(const XcdBarrier& b, int wid_s) {
    asm volatile("s_waitcnt vmcnt(0)" ::: "memory");
    __syncthreads();
    if (wid_s == 0 && lane_id_asm() == 0) {
        unsigned* bar = b.bar;
        __builtin_amdgcn_s_waitcnt(0);
        unsigned nloc = b.st[0], nx = b.st[1];
        if (nloc == 0u) { xcd_barrier_complete(bar, b.x, nloc, nx); b.st[0] = nloc; b.st[1] = nx; }
        const unsigned old = xb_add(&bar[XB_XSUB(b.x)], 1u);
        const unsigned gen = old / nloc;
        if (old + 1u == (gen + 1u) * nloc) {
            __builtin_amdgcn_fence(__ATOMIC_RELEASE, "agent");
            asm volatile("s_waitcnt vmcnt(0)" ::: "memory");
            const unsigned og = xb_add(&bar[XB_TOP], 1u);
            const unsigned tg = og / nx;
            if (og + 1u == (tg + 1u) * nx) xb_add(&bar[XB_TOPGEN], 1u);
            else XB_SPIN(xb_ld(&bar[XB_TOPGEN]) == tg, bar);
            __builtin_amdgcn_fence(__ATOMIC_ACQUIRE, "agent");
            xb_add(&bar[XB_XGEN(b.x)], 1u);
            asm volatile("s_waitcnt vmcnt(0)" ::: "memory");
        } else {
            XB_SPIN(xb_ld(&bar[XB_XGEN(b.x)]) == gen, bar);
            __builtin_amdgcn_fence(__ATOMIC_ACQUIRE, "agent");
            asm volatile("s_waitcnt vmcnt(0)" ::: "memory");
        }
    }
    __syncthreads();
}

__global__ void __launch_bounds__(512) hymba_fwd(Params P) {
    extern __shared__ __attribute__((aligned(16))) unsigned char lds_raw[];
    LAS unsigned char* lds = (LAS unsigned char*)lds_raw;
    cg::grid_group grid = cg::this_grid();
    unsigned char* ws = P.ws;
    const int G = gridDim.x, c = blockIdx.x;
    float* SSQ1 = (float*)(ws + WS_SSQ1); float* SSQ2 = (float*)(ws + WS_SSQ2); const float* RSTD1 = (const float*)(ws + WS_RSTD1); const float* RSTDM = (const float*)(ws + WS_RSTDM);
    bf16* XB = (bf16*)(ws + WS_XB); bf16* PROJ = (bf16*)(ws + WS_PROJ); bf16* TR = (bf16*)(ws + WS_TR); bf16* MIX = (bf16*)(ws + WS_MIX);
    bf16* Q2 = (bf16*)(ws + WS_PROJ); bf16* O2 = (bf16*)(ws + WS_PROJ + 32 * MiB); bf16* ACT = (bf16*)(ws + WS_TR);

    volatile LAS unsigned* st = (volatile LAS unsigned*)(lds + 135168);
    unsigned* barw = (unsigned*)(ws + WS_BAR);
    const int wid_s = __builtin_amdgcn_readfirstlane(threadIdx.x >> 6);
    if (wid_s == 0 && lane_id_asm() < 2) st[lane_id_asm()] = 0u;
    __syncthreads();
    const XcdBarrier xb = xcd_barrier_post(barw, st, wid_s);
#ifndef NO_P0
    p0_prologue(P, lds, wid_s);
#endif
#ifdef REP_P0
    p0_prologue(P, lds, wid_s);
#endif
    if (P.use_cg) grid.sync();
    xcd_barrier(xb, wid_s);
#ifdef REP_G1
    for (int rep_ = 0; rep_ < 2; ++rep_) {
#else
    {
#endif
    {   pg8::Gemm g{XB, (const bf16*)(ws + WS_WN), NTOK, 2560, DM}; pg8::StaticOrder S; S.init(NTOK, 2560, G, c);
        pg8::EpiG1 E{PROJ, RSTD1, (const float*)(ws + WS_CS), P.in[4], P.in[5], 0.125f * LOG2E};
        pg8::gemm_phase<pg8::EpiG1, pg8::StaticOrder, true, true>(lds, g, S, E, wid_s); }
    {   pg8::Gemm g{(const bf16*)(ws + WS_WTR), XB, 1536, NTOK, DM}; pg8::StaticOrder S; S.init(1536, NTOK, G, (c + G / 2) % G);
        pg8::EpiTR E{TR, RSTD1, (const float*)(ws + WS_CS)};
        pg8::gemm_phase<pg8::EpiTR, pg8::StaticOrder, true, true>(lds, g, S, E, wid_s); }
    }
    xcd_barrier(xb, wid_s);
#ifndef NO_RETKV
    ret_kv_phase(P, wid_s);
#endif
#ifdef REP_RETKV
    ret_kv_phase(P, wid_s);
#endif
#ifndef NO_DIFF
    diff_phase(P, lds, wid_s);
#endif
#ifdef REP_DIFF
    diff_phase(P, lds, wid_s);
#endif
#ifdef REP_DIFF_SKEL
    diff_probe_phase<1>(P, lds, wid_s);
#endif
#ifdef REP_DIFF_COMP
    diff_probe_phase<2>(P, lds, wid_s);
#endif
    xcd_barrier(xb, wid_s);
    ret_scan_phase(P, wid_s);

    kv2_phase(P, wid_s);
    xcd_barrier(xb, wid_s);
#ifdef REP_SYNC
    for (int rep_ = 0; rep_ < 20; ++rep_) xcd_barrier(xb, wid_s);
#endif
#ifndef NO_RETOUT
    ret_out_phase(P, lds, wid_s);
#endif
    knorm_phase(P, wid_s);
#ifdef REP_RETOUT
    ret_out_phase(P, lds, wid_s);
#endif
#ifdef REP_RETOUT_NOST
    ret_out_phase<1>(P, lds, wid_s);
#endif
    xcd_barrier(xb, wid_s);
    {   pg8::Gemm g{MIX, (const bf16*)(ws + WS_WOUT), NTOK, DM, DM}; pg8::StaticOrder S; S.init(NTOK, DM, G, c);
        pg8::EpiResid<true> E{P.in[0], P.out, XB, SSQ1};
        pg8::gemm_phase<pg8::EpiResid<true>, pg8::StaticOrder, true, true>(lds, g, S, E, wid_s); }
#ifdef REP_G2
    {   pg8::Gemm g{MIX, (const bf16*)(ws + WS_WOUT), NTOK, DM, DM}; pg8::StaticOrder S; S.init(NTOK, DM, G, c);
        pg8::EpiResid<false> E{P.in[0], (float*)(ws + WS_PROJ), nullptr, nullptr};
        pg8::gemm_phase<pg8::EpiResid<false>, pg8::StaticOrder, true, true>(lds, g, S, E, wid_s); }
#endif
    xcd_barrier(xb, wid_s);
#ifdef REP_G3
    for (int rep_ = 0; rep_ < 2; ++rep_) {
#else
    {
#endif
    {   pg8::Gemm g{XB, (const bf16*)(ws + WS_XQ), NTOK, DM, DM}; pg8::StaticOrder S; S.init(NTOK, DM, G, c);
        pg8::EpiRowScale<true> E{Q2, 1024, SSQ1};
        pg8::gemm_phase<pg8::EpiRowScale<true>, pg8::StaticOrder, true, true>(lds, g, S, E, wid_s); }
    }
    xcd_barrier(xb, wid_s);
#ifndef NO_XATTN
    xattn_phase(P, lds, wid_s);
#endif
#ifdef REP_XATTN
    xattn_phase(P, lds, wid_s);
#endif
#ifdef REP_XATTN_SKEL
    xattn_phase<1>(P, lds, wid_s);
#endif
#ifdef REP_XATTN_COMP
    xattn_phase<2>(P, lds, wid_s);
#endif
    xcd_barrier(xb, wid_s);
    {   pg8::Gemm g{O2, (const bf16*)(ws + WS_XO), NTOK, DM, DM}; pg8::StaticOrder S; S.init(NTOK, DM, G, c);
#ifdef REP_G4
    {   pg8::Gemm g2{O2, (const bf16*)(ws + WS_XO), NTOK, DM, DM}; pg8::StaticOrder S2; S2.init(NTOK, DM, G, c);
        pg8::EpiResid<false> E2{P.out, (float*)(ws + WS_TR), nullptr, nullptr};
        pg8::gemm_phase<pg8::EpiResid<false>, pg8::StaticOrder, true, true>(lds, g2, S2, E2, wid_s); }
#endif
        pg8::EpiResid<true> E{P.out, P.out, XB, SSQ2};
        pg8::gemm_phase<pg8::EpiResid<true>, pg8::StaticOrder, true, true>(lds, g, S, E, wid_s); }
    xcd_barrier(xb, wid_s);
#ifdef REP_G5
    for (int rep_ = 0; rep_ < 2; ++rep_) {
#else
    {
#endif
    {   pg8::Gemm g{XB, (const bf16*)(ws + WS_WGU), NTOK, 2 * FFH, DM}; pg8::StaticOrder S; S.init(NTOK, 2 * FFH, G, c);
        pg8::EpiSwiglu E{ACT, SSQ2};
        pg8::gemm_phase<pg8::EpiSwiglu, pg8::StaticOrder, true, true>(lds, g, S, E, wid_s); }
    }
    xcd_barrier(xb, wid_s);
    {   pg8::Gemm g{ACT, (const bf16*)(ws + WS_WD), NTOK, DM, FFH}; pg8::StaticOrder S; S.init(NTOK, DM, G, c);
#ifdef REP_G6
    {   pg8::Gemm g2{ACT, (const bf16*)(ws + WS_WD), NTOK, DM, FFH}; pg8::StaticOrder S2; S2.init(NTOK, DM, G, c);
        pg8::EpiResid<false> E2{P.out, (float*)(ws + WS_PROJ), nullptr, nullptr};
        pg8::gemm_phase<pg8::EpiResid<false>, pg8::StaticOrder, true, true>(lds, g2, S2, E2, wid_s); }
#endif
        pg8::EpiResidF E{P.out, P.out};
        pg8::gemm_phase<pg8::EpiResidF, pg8::StaticOrder, true, true>(lds, g, S, E, wid_s); }
}

extern "C" void kernel_launch(void* const* d_in, const int* in_sizes, int n_in, void* d_out, int out_size, void* d_ws, size_t ws_size, hipStream_t stream) {
    static int grid = 0;
    if (grid == 0) {
        if (n_in != 21 || out_size != NTOK * DM || ws_size < WS_END) { fprintf(stderr, "kernel_launch: unexpected shapes (n_in %d, out %d, ws %zu)\n", n_in, out_size, ws_size); grid = -1; return; }
        int dev = 0, cus = 0, per_cu = 0;
        (void)hipGetDevice(&dev); (void)hipDeviceGetAttribute(&cus, hipDeviceAttributeMultiprocessorCount, dev);
        if (hipFuncSetAttribute((const void*)hymba_fwd, hipFuncAttributeMaxDynamicSharedMemorySize, LDS_BYTES) != hipSuccess) { fprintf(stderr, "kernel_launch: hipFuncSetAttribute failed\n"); grid = -1; return; }
        if (hipOccupancyMaxActiveBlocksPerMultiprocessor(&per_cu, (const void*)hymba_fwd, 512, LDS_BYTES) != hipSuccess || per_cu < 1) { fprintf(stderr, "kernel_launch: occupancy query failed (%d)\n", per_cu); (void)hipGetLastError(); per_cu = 1; }
        grid = cus * (per_cu > 1 ? 1 : per_cu);
        if (grid > 256) grid = 256;
    }
    if (grid < 0) return;
    if (hipMemsetAsync((char*)d_ws + WS_BAR, 0, 65536, stream) != hipSuccess) { fprintf(stderr, "kernel_launch: memset of the barrier words failed\n"); return; }
    Params p{};
    for (int i = 0; i < 21; ++i) p.in[i] = (const float*)d_in[i];
    p.out = (float*)d_out; p.ws = (unsigned char*)d_ws;
    void* args[] = {&p};
    hipError_t e = hipLaunchCooperativeKernel((const void*)hymba_fwd, dim3(grid), dim3(512), args, LDS_BYTES, stream);
    if (e != hipSuccess) fprintf(stderr, "cooperative launch failed: %s (grid %d)\n", hipGetErrorString(e), grid);
}
```

```cpp
#include <hip/hip_runtime.h>
#include <hip/hip_cooperative_groups.h>
#include <cstdio>
#include <cstdint>
namespace cg = cooperative_groups;
#define XSUM_SWZ(v, m) ((v) + __uint_as_float((unsigned)__builtin_amdgcn_ds_swizzle((int)__float_as_uint(v), ((m) << 10) | 0x1f)))
#define XMAX_SWZ(v, m) fmaxf((v), __uint_as_float((unsigned)__builtin_amdgcn_ds_swizzle((int)__float_as_uint(v), ((m) << 10) | 0x1f)))
__device__ __forceinline__ float xsum32(float v) { auto rr = __builtin_amdgcn_permlane32_swap(__float_as_uint(v), __float_as_uint(v), false, false); return __uint_as_float(rr[0]) + __uint_as_float(rr[1]); }
__device__ __forceinline__ float xmax32(float v) { auto rr = __builtin_amdgcn_permlane32_swap(__float_as_uint(v), __float_as_uint(v), false, false); return fmaxf(__uint_as_float(rr[0]), __uint_as_float(rr[1])); }
__device__ __forceinline__ float xsum16(float v) { return XSUM_SWZ(v, 16); }
__device__ __forceinline__ int lane_id_asm() { int l; asm volatile("v_mbcnt_lo_u32_b32 %0, -1, 0\n\tv_mbcnt_hi_u32_b32 %0, -1, %0" : "=v"(l)); return l; }
namespace pg8 {
#define PG8_LAS __attribute__((address_space(3)))
typedef unsigned short bf16_t;
typedef short bf16x8 __attribute__((ext_vector_type(8)));
typedef float f32x4 __attribute__((ext_vector_type(4)));
typedef unsigned u32x4 __attribute__((ext_vector_type(4)));
constexpr int BM = 256, BK = 64, HALF = 128, HTB = HALF * BK * 2  , STAGE_BYTES = 8 * HTB, NXCD = 8, WGM = 8;

__host__ __device__ __forceinline__ int lds_byte(int r, int c) { const int st = (r >> 4) * 2 + (c >> 5), rr = r & 15, cc = c & 31, ob = rr * 64 + cc * 2; return st * 1024 + (ob ^ (((ob >> 9) & 1) << 5)); }
__host__ __device__ __forceinline__ void stage_rc(int b, int& R, int& C) { const int st = b / 1024, sb = b % 1024, swz = sb ^ (((sb >> 9) & 1) << 5); R = (st >> 1) * 16 + swz / 64; C = (st & 1) * 32 + (swz % 64) / 2; }
__host__ __device__ __forceinline__ int perm32(int rho) { const int n = rho >> 4, i = rho & 15; return 8 * (i >> 2) + 4 * n + (i & 3); }

struct Unit { int pm, pn; };
struct Gemm { const bf16_t* A; const bf16_t* Bt; int M, N, K; };

struct StaticOrder {
    int nM, nN, nwg, G, c;
    __host__ __device__ void init(int M, int N, int G_, int c_) { nM = M / BM; nN = N / BM; nwg = nM * nN; G = G_; c = c_; }
    __host__ __device__ bool next(int i, Unit& u) const {
        const long L = (long)i * G + c; if (L >= nwg) return false;
        int wgid = (int)L; { const int q = nwg / NXCD, r = nwg % NXCD, xcd = wgid % NXCD, off = wgid / NXCD; wgid = (xcd < r ? xcd * (q + 1) : r * (q + 1) + (xcd - r) * q) + off; }
        const int nig = WGM * nN, gid = wgid / nig, fm = gid * WGM, gsz = (nM - fm) < WGM ? (nM - fm) : WGM;
        u.pm = fm + ((wgid % nig) % gsz); u.pn = (wgid % nig) / gsz; return true;
    }
    __device__ __forceinline__ void a_ready(const Unit&) const {}
    __device__ __forceinline__ void done(const Unit&) const {}
};

__device__ __forceinline__ unsigned cvt_pk_bf16(float lo, float hi) { unsigned r; asm volatile("v_cvt_pk_bf16_f32 %0, %1, %2" : "=v"(r) : "v"(lo), "v"(hi)); return r; }
typedef float f32x2 __attribute__((ext_vector_type(2)));
typedef unsigned u32x2 __attribute__((ext_vector_type(2)));
constexpr float EPS_RMS = 1e-6f;
__device__ __forceinline__ u32x4 pack8(const float (&v)[8]) { u32x4 w; w.x = cvt_pk_bf16(v[0], v[1]); w.y = cvt_pk_bf16(v[2], v[3]); w.z = cvt_pk_bf16(v[4], v[5]); w.w = cvt_pk_bf16(v[6], v[7]); return w; }
__device__ __forceinline__ float silu_f(float v) { return v * __builtin_amdgcn_rcpf(1.0f + __builtin_amdgcn_exp2f(v * -1.4426950408889634f)); }

struct EpiG1 {
    static constexpr bool PERM = true, AFTER_DRAIN = false;
    bf16_t* O; const float* rstd; const float* cs; const float* gq; const float* gk; float c2;
    __device__ __forceinline__ void operator()(const f32x4 (&acc)[2][2][4][2], const Unit& u, int wr, int wc, int fr, int fq) const {
        const int pn = u.pn; const int row0 = u.pm * BM + wr * 64 + fr;
        if (pn < 4) {
            const float sc = pn >= 2 ? 0.125f : 1.0f;
#pragma unroll
            for (int ai = 0; ai < 2; ++ai)
#pragma unroll
                for (int m = 0; m < 4; ++m) { const int row = row0 + ai * HALF + m * 16; const float f = rstd[row] * sc;
                    const f32x4* c4 = (const f32x4*)(cs + ((size_t)(row & 8191) * 32 + 8 * fq) * 2);
                    float o1[8], o2[8];
#pragma unroll
                    for (int k = 0; k < 4; ++k) { const f32x4 c = c4[k];
#pragma unroll
                        for (int z = 0; z < 2; ++z) { const int i8 = 2 * k + z; const float co = z ? c[2] : c[0], si = z ? c[3] : c[1];
                            const float x1 = acc[ai][0][m][i8 >> 2][i8 & 3], x2 = acc[ai][1][m][i8 >> 2][i8 & 3];
                            o1[i8] = (x1 * co - x2 * si) * f; o2[i8] = (x2 * co + x1 * si) * f; } }
                    bf16_t* p = O + (size_t)row * 2560 + pn * 256 + wc * 64 + 8 * fq;
                    *(u32x4*)p = pack8(o1); *(u32x4*)(p + 32) = pack8(o2); }
        } else if (pn < 6) {
#pragma unroll
            for (int ai = 0; ai < 2; ++ai)
#pragma unroll
                for (int m = 0; m < 4; ++m) { const int row = row0 + ai * HALF + m * 16; const float f = rstd[row];
#pragma unroll
                    for (int bj = 0; bj < 2; ++bj) { float v[8];
#pragma unroll
                        for (int i8 = 0; i8 < 8; ++i8) v[i8] = silu_f(acc[ai][bj][m][i8 >> 2][i8 & 3] * f);
                        *(u32x4*)(O + (size_t)row * 2560 + pn * 256 + bj * HALF + wc * 32 + 8 * fq) = pack8(v); } }
        } else {
            const float* g = pn < 8 ? gq : gk; const float sc = pn < 8 ? c2 : 1.0f;
            float gv[2][8];
#pragma unroll
            for (int bj = 0; bj < 2; ++bj)
#pragma unroll
                for (int i8 = 0; i8 < 8; ++i8) gv[bj][i8] = g[32 * bj + 8 * fq + i8] * sc;
#pragma unroll
            for (int ai = 0; ai < 2; ++ai)
#pragma unroll
                for (int m = 0; m < 4; ++m) { const int row = row0 + ai * HALF + m * 16; const float f = rstd[row];
                    float ss = 0.f;
#pragma unroll
                    for (int bj = 0; bj < 2; ++bj)
#pragma unroll
                        for (int i8 = 0; i8 < 8; ++i8) { const float v = acc[ai][bj][m][i8 >> 2][i8 & 3] * f; ss += v * v; }
                    ss = xsum16(ss); ss = xsum32(ss);
                    const float rr = f * rsqrtf(ss * (1.0f / 64.0f) + EPS_RMS);
#pragma unroll
                    for (int bj = 0; bj < 2; ++bj) { float v[8];
#pragma unroll
                        for (int i8 = 0; i8 < 8; ++i8) v[i8] = acc[ai][bj][m][i8 >> 2][i8 & 3] * rr * gv[bj][i8];
                        *(u32x4*)(O + (size_t)row * 2560 + pn * 256 + wc * 64 + bj * 32 + 8 * fq) = pack8(v); } }
        }
    }
};

struct EpiTR {
    static constexpr bool PERM = true, AFTER_DRAIN = false;
    bf16_t* O; const float* rstd; const float* cs;
    __device__ __forceinline__ void operator()(const f32x4 (&acc)[2][2][4][2], const Unit& u, int wr, int wc, int fr, int fq) const {
        const int pm = u.pm; const int col0 = u.pn * BM + wc * 32 + 8 * fq;
        float rs[2][8];
#pragma unroll
        for (int bj = 0; bj < 2; ++bj) { const f32x4 a = *(const f32x4*)(rstd + col0 + bj * HALF), b = *(const f32x4*)(rstd + col0 + bj * HALF + 4);
            rs[bj][0] = a[0]; rs[bj][1] = a[1]; rs[bj][2] = a[2]; rs[bj][3] = a[3]; rs[bj][4] = b[0]; rs[bj][5] = b[1]; rs[bj][6] = b[2]; rs[bj][7] = b[3]; }
        if (pm < 2) {
#pragma unroll
            for (int m = 0; m < 4; ++m) { const int hl = 2 * wr + (m >> 1), i = 16 * (m & 1) + fr, head = 4 * pm + hl;
                const float l2g = log1pf(-exp2f(-5.0f - (float)head)) * 1.4426950408889634f;
                const int rown = pm * 256 + 64 * hl + i;
#pragma unroll
                for (int bj = 0; bj < 2; ++bj) { float o1[8], o2[8];
#pragma unroll
                    for (int i8 = 0; i8 < 8; ++i8) { const int col = col0 + bj * HALF + i8; const int pos = col & 8191;
                        const float2 c = *(const float2*)(cs + ((size_t)pos * 32 + i) * 2);
                        const float f = rs[bj][i8] * 0.125f * __builtin_amdgcn_exp2f(l2g * (float)(127 - (col & 127)));
                        const float x1 = acc[0][bj][m][i8 >> 2][i8 & 3], x2 = acc[1][bj][m][i8 >> 2][i8 & 3];
                        o1[i8] = (x1 * c.x - x2 * c.y) * f; o2[i8] = (x2 * c.x + x1 * c.y) * f; }
                    *(u32x4*)(O + (size_t)rown * 16384 + col0 + bj * HALF) = pack8(o1);
                    *(u32x4*)(O + (size_t)(rown + 32) * 16384 + col0 + bj * HALF) = pack8(o2); } }
        } else {
#pragma unroll
            for (int ai = 0; ai < 2; ++ai)
#pragma unroll
                for (int m = 0; m < 4; ++m) { const int row = pm * BM + ai * HALF + wr * 64 + m * 16 + fr;
#pragma unroll
                    for (int bj = 0; bj < 2; ++bj) { float v[8];
#pragma unroll
                        for (int i8 = 0; i8 < 8; ++i8) v[i8] = acc[ai][bj][m][i8 >> 2][i8 & 3] * rs[bj][i8];
                        *(u32x4*)(O + (size_t)row * 16384 + col0 + bj * HALF) = pack8(v); } }
        }
    }
};

template <bool SSQ> struct EpiRowScale {
    static constexpr bool PERM = true, AFTER_DRAIN = false;
    bf16_t* O; int ldc; const float* rs;
    __device__ __forceinline__ void operator()(const f32x4 (&acc)[2][2][4][2], const Unit& u, int wr, int wc, int fr, int fq) const {
        const int row0 = u.pm * BM + wr * 64 + fr, col0 = u.pn * BM + wc * 32 + 8 * fq;
#pragma unroll
        for (int ai = 0; ai < 2; ++ai)
#pragma unroll
            for (int m = 0; m < 4; ++m) { const int row = row0 + ai * HALF + m * 16; float f = rs[row]; if (SSQ) f = rsqrtf(f * (1.0f / 1024.0f) + EPS_RMS);
#pragma unroll
                for (int bj = 0; bj < 2; ++bj) { float v[8];
#pragma unroll
                    for (int i8 = 0; i8 < 8; ++i8) v[i8] = acc[ai][bj][m][i8 >> 2][i8 & 3] * f;
                    *(u32x4*)(O + (size_t)row * ldc + col0 + bj * HALF) = pack8(v); } }
    }
};
struct EpiColScale {
    static constexpr bool PERM = true, AFTER_DRAIN = false;
    bf16_t* O; int ldc; const float* rs;
    __device__ __forceinline__ void operator()(const f32x4 (&acc)[2][2][4][2], const Unit& u, int wr, int wc, int fr, int fq) const {
        const int row0 = u.pm * BM + wr * 64 + fr, col0 = u.pn * BM + wc * 32 + 8 * fq;
        float rsv[2][8];
#pragma unroll
        for (int bj = 0; bj < 2; ++bj)
#pragma unroll
            for (int i8 = 0; i8 < 8; ++i8) rsv[bj][i8] = rs[col0 + bj * HALF + i8];
#pragma unroll
        for (int ai = 0; ai < 2; ++ai)
#pragma unroll
            for (int m = 0; m < 4; ++m) { const int row = row0 + ai * HALF + m * 16;
#pragma unroll
                for (int bj = 0; bj < 2; ++bj) { float v[8];
#pragma unroll
                    for (int i8 = 0; i8 < 8; ++i8) v[i8] = acc[ai][bj][m][i8 >> 2][i8 & 3] * rsv[bj][i8];
                    *(u32x4*)(O + (size_t)row * ldc + col0 + bj * HALF) = pack8(v); } }
    }
};
template <bool AUX> struct EpiResid {
    static constexpr bool PERM = true, AFTER_DRAIN = false;
    const float* base; float* out; bf16_t* xb; float* ssq;
    __device__ __forceinline__ void operator()(const f32x4 (&acc)[2][2][4][2], const Unit& u, int wr, int wc, int fr, int fq) const {
        const int row0 = u.pm * BM + wr * 64 + fr, col0 = u.pn * BM + wc * 32 + 8 * fq;
#pragma unroll
        for (int ai = 0; ai < 2; ++ai) {
            f32x4 bv[4][2][2];
#pragma unroll
            for (int m = 0; m < 4; ++m)
#pragma unroll
                for (int bj = 0; bj < 2; ++bj) { const size_t off = (size_t)(row0 + ai * HALF + m * 16) * 1024 + col0 + bj * HALF;
                    bv[m][bj][0] = *(const f32x4*)(base + off); bv[m][bj][1] = *(const f32x4*)(base + off + 4); }
#pragma unroll
            for (int m = 0; m < 4; ++m) { const int row = row0 + ai * HALF + m * 16; float ss = 0.f;
#pragma unroll
                for (int bj = 0; bj < 2; ++bj) { const size_t off = (size_t)row * 1024 + col0 + bj * HALF;
                    const f32x4 v0 = bv[m][bj][0] + acc[ai][bj][m][0], v1 = bv[m][bj][1] + acc[ai][bj][m][1];
                    *(f32x4*)(out + off) = v0; *(f32x4*)(out + off + 4) = v1;
                    if (AUX) { u32x4 w; w.x = cvt_pk_bf16(v0[0], v0[1]); w.y = cvt_pk_bf16(v0[2], v0[3]); w.z = cvt_pk_bf16(v1[0], v1[1]); w.w = cvt_pk_bf16(v1[2], v1[3]);
                        *(u32x4*)(xb + off) = w;
                        ss += (v0[0] * v0[0] + v0[1] * v0[1]) + (v0[2] * v0[2] + v0[3] * v0[3]) + (v1[0] * v1[0] + v1[1] * v1[1]) + (v1[2] * v1[2] + v1[3] * v1[3]); } }
                if (AUX) { ss = xsum16(ss); ss = xsum32(ss); if (fq == 0) atomicAdd(ssq + row, ss); } }
        }
    }
};
struct EpiResidF {
    static constexpr bool PERM = false, AFTER_DRAIN = false;
    const float* base; float* out;
    __device__ __forceinline__ void operator()(const f32x4 (&acc)[2][2][4][2], const Unit& u, int wr, int wc, int fr, int fq) const {
        const int row0 = u.pm * BM + wr * 64 + fr, col0 = u.pn * BM + wc * 32 + 4 * fq;
#pragma unroll
        for (int ai = 0; ai < 2; ++ai) {
            f32x4 bv[4][2][2];
#pragma unroll
            for (int m = 0; m < 4; ++m)
#pragma unroll
                for (int bj = 0; bj < 2; ++bj) { const size_t off = (size_t)(row0 + ai * HALF + m * 16) * 1024 + col0 + bj * HALF;
                    bv[m][bj][0] = *(const f32x4*)(base + off); bv[m][bj][1] = *(const f32x4*)(base + off + 16); }
#pragma unroll
            for (int m = 0; m < 4; ++m)
#pragma unroll
                for (int bj = 0; bj < 2; ++bj) { const size_t off = (size_t)(row0 + ai * HALF + m * 16) * 1024 + col0 + bj * HALF;
                    *(f32x4*)(out + off) = bv[m][bj][0] + acc[ai][bj][m][0]; *(f32x4*)(out + off + 16) = bv[m][bj][1] + acc[ai][bj][m][1]; }
        }
    }
};
struct EpiSwiglu {
    static constexpr bool PERM = true, AFTER_DRAIN = false;
    bf16_t* O; const float* ssq;
    __device__ __forceinline__ void operator()(const f32x4 (&acc)[2][2][4][2], const Unit& u, int wr, int wc, int fr, int fq) const {
        const int row0 = u.pm * BM + wr * 64 + fr, col0 = u.pn * HALF + wc * 32 + 8 * fq;
#pragma unroll
        for (int ai = 0; ai < 2; ++ai)
#pragma unroll
            for (int m = 0; m < 4; ++m) { const int row = row0 + ai * HALF + m * 16; const float f = rsqrtf(ssq[row] * (1.0f / 1024.0f) + EPS_RMS);
                float v[8];
#pragma unroll
                for (int i8 = 0; i8 < 8; ++i8) v[i8] = silu_f(acc[ai][0][m][i8 >> 2][i8 & 3] * f) * (acc[ai][1][m][i8 >> 2][i8 & 3] * f);
                *(u32x4*)(O + (size_t)row * 2816 + col0) = pack8(v); }
    }
};
template <class Epi, class Sched, bool ALIGN_EPI = false, bool SP2 = false>
__device__ __forceinline__ void gemm_phase(PG8_LAS unsigned char* lds, const Gemm g, const Sched& S, const Epi& E, int wid_s) {
    const int lane = lane_id_asm(), wid = wid_s, tid = wid * 64 + lane, wr = wid >> 2, wc = wid & 3, fr = lane & 15, fq = lane >> 4;
    const int K = g.K, nt = K / BK;
    unsigned voffA[2], voffB[2];
#pragma unroll
    for (int i = 0; i < 2; ++i) { int R, C; stage_rc(tid * 16 + i * 8192, R, C); const int Rb = Epi::PERM ? ((R & ~31) + perm32(R & 31)) : R;
        voffA[i] = (unsigned)(R * K + C) * 2u; voffB[i] = (unsigned)(Rb * K + C) * 2u; }
    const size_t kstep = (size_t)(BK * 2);
    const size_t hstep = (size_t)HALF * K * 2;
    const size_t tstep = 2 * hstep;
    const unsigned ldsw = (unsigned)wid * 1024u;
    const int aoff = lds_byte(wr * 64 + fr, fq * 8), boff = lds_byte(wc * 32 + fr, fq * 8);
#define PG8_SA(b, h) (((b) * 2 + (h)) * HTB)
#define PG8_SB(b, h) ((4 + (b) * 2 + (h)) * HTB)
#define PG8_STAGE(bufoff, gbase, voff) do { _Pragma("unroll") for (int _i = 0; _i < 2; ++_i) \
        __builtin_amdgcn_global_load_lds((const unsigned*)((const char*)(gbase) + (voff)[_i]), (PG8_LAS unsigned*)(lds + (bufoff) + ldsw + _i * 8192), 16, 0, 0); } while (0)
#define PG8_LDA(dst, b, h) do { _Pragma("unroll") for (int m = 0; m < 4; ++m) _Pragma("unroll") for (int k = 0; k < 2; ++k) dst[m][k] = *(const PG8_LAS bf16x8*)(lds + PG8_SA(b, h) + aoff + m * 2048 + k * 1024); } while (0)
#define PG8_LDB(dst, b, h) do { _Pragma("unroll") for (int n = 0; n < 2; ++n) _Pragma("unroll") for (int k = 0; k < 2; ++k) dst[n][k] = *(const PG8_LAS bf16x8*)(lds + PG8_SB(b, h) + boff + n * 2048 + k * 1024); } while (0)
#define PG8_MMA(ai, bj, At, Bt) do { __builtin_amdgcn_s_setprio(1); _Pragma("unroll") for (int m = 0; m < 4; ++m) _Pragma("unroll") for (int n = 0; n < 2; ++n) _Pragma("unroll") for (int k = 0; k < 2; ++k) \
        acc[ai][bj][m][n] = __builtin_amdgcn_mfma_f32_16x16x32_bf16(Bt[n][k], At[m][k], acc[ai][bj][m][n], 0, 0, 0); __builtin_amdgcn_s_setprio(0); } while (0)
#define PG8_WAIT_V(n) asm volatile("s_waitcnt vmcnt(" #n ")" ::: "memory")
#define PG8_WAIT_L(n) asm volatile("s_waitcnt lgkmcnt(" #n ")" ::: "memory")
#define PG8_BAR __builtin_amdgcn_s_barrier()
#define PG8_SCHED __builtin_amdgcn_sched_barrier(0)
    Unit cur, nxt; int ui = 0;
    if (!S.next(0, cur)) return;
    f32x4 acc[2][2][4][2];
#pragma unroll
    for (int a = 0; a < 2; ++a)
#pragma unroll
        for (int b = 0; b < 2; ++b)
#pragma unroll
            for (int m = 0; m < 4; ++m)
#pragma unroll
                for (int n = 0; n < 2; ++n) acc[a][b][m][n] = (f32x4){0.f, 0.f, 0.f, 0.f};
    bf16x8 At[4][2], B0[2][2], B1[2][2];
    const char* cA = (const char*)g.A + (size_t)cur.pm * tstep; const char* cB = (const char*)g.Bt + (size_t)cur.pn * tstep;
    S.a_ready(cur);
    if constexpr (SP2) {
        PG8_STAGE(PG8_SB(0, 0), cB, voffB); PG8_STAGE(PG8_SB(0, 1), cB + hstep, voffB); PG8_STAGE(PG8_SA(0, 0), cA, voffA); PG8_STAGE(PG8_SA(0, 1), cA + hstep, voffA);
        if (wr == 1) PG8_BAR;
        PG8_WAIT_V(2); PG8_BAR;
        PG8_STAGE(PG8_SB(1, 0), cB + kstep, voffB); PG8_STAGE(PG8_SA(1, 0), cA + kstep, voffA); PG8_STAGE(PG8_SB(1, 1), cB + hstep + kstep, voffB);
        PG8_WAIT_V(6); PG8_BAR;
    } else {
        PG8_STAGE(PG8_SB(0, 0), cB, voffB); PG8_STAGE(PG8_SA(0, 0), cA, voffA); PG8_STAGE(PG8_SB(0, 1), cB + hstep, voffB); PG8_STAGE(PG8_SA(0, 1), cA + hstep, voffA);
        if (wr == 1) PG8_BAR;
        PG8_WAIT_V(4); PG8_BAR;
        PG8_STAGE(PG8_SB(1, 0), cB + kstep, voffB); PG8_STAGE(PG8_SA(1, 0), cA + kstep, voffA); PG8_STAGE(PG8_SB(1, 1), cB + hstep + kstep, voffB);
        PG8_WAIT_V(6); PG8_BAR;
    }
    for (;;) {
        const bool has_next = S.next(ui + 1, nxt);
        const char* nA = has_next ? (const char*)g.A + (size_t)nxt.pm * tstep : cA; const char* nB = has_next ? (const char*)g.Bt + (size_t)nxt.pn * tstep : cB;
        for (int t = 0; t < nt; t += 2) {
            const bool last = (t == nt - 2);
            const char* a1 = cA + (size_t)(t + 1) * kstep;
            const char* a2 = last ? nA : cA + (size_t)(t + 2) * kstep; const char* b2 = last ? nB : cB + (size_t)(t + 2) * kstep;
            const char* a3 = a2 + kstep; const char* b3 = b2 + kstep;
            if (last && has_next) S.a_ready(nxt);
            if constexpr (SP2) {
            PG8_LDB(B0, 0, 0); PG8_LDB(B1, 0, 1); PG8_SCHED; PG8_LDA(At, 0, 0); PG8_STAGE(PG8_SA(1, 1), a1 + hstep, voffA);
            PG8_WAIT_V(8); PG8_WAIT_L(0); PG8_BAR; PG8_MMA(0, 0, At, B0); PG8_MMA(0, 1, At, B1); PG8_BAR; PG8_SCHED;
            PG8_LDA(At, 0, 1); PG8_STAGE(PG8_SB(0, 0), b2, voffB); PG8_STAGE(PG8_SB(0, 1), b2 + hstep, voffB); PG8_STAGE(PG8_SA(0, 0), a2, voffA);
            PG8_WAIT_V(8); PG8_WAIT_L(0); PG8_BAR; PG8_MMA(1, 0, At, B0); PG8_MMA(1, 1, At, B1); PG8_BAR; PG8_SCHED;
            PG8_LDB(B0, 1, 0); PG8_LDB(B1, 1, 1); PG8_SCHED; PG8_LDA(At, 1, 0); PG8_STAGE(PG8_SA(0, 1), a2 + hstep, voffA);
            PG8_WAIT_V(8); PG8_WAIT_L(0); PG8_BAR; PG8_MMA(0, 0, At, B0); PG8_MMA(0, 1, At, B1); PG8_BAR; PG8_SCHED;
            PG8_LDA(At, 1, 1); PG8_STAGE(PG8_SB(1, 0), b3, voffB); PG8_STAGE(PG8_SB(1, 1), b3 + hstep, voffB); PG8_STAGE(PG8_SA(1, 0), a3, voffA);
            PG8_WAIT_V(8); PG8_WAIT_L(0); PG8_BAR; PG8_MMA(1, 0, At, B0); PG8_MMA(1, 1, At, B1); PG8_BAR; PG8_SCHED;
            } else {
            PG8_LDB(B0, 0, 0); PG8_SCHED; PG8_LDA(At, 0, 0); PG8_STAGE(PG8_SA(1, 1), a1 + hstep, voffA);
            PG8_WAIT_L(8); PG8_BAR; PG8_WAIT_L(0); PG8_MMA(0, 0, At, B0); PG8_BAR; PG8_SCHED;
            PG8_LDB(B1, 0, 1); PG8_STAGE(PG8_SB(0, 0), b2, voffB);
            PG8_BAR; PG8_WAIT_L(0); PG8_MMA(0, 1, At, B1); PG8_BAR;
            PG8_LDA(At, 0, 1); PG8_STAGE(PG8_SA(0, 0), a2, voffA);
            PG8_BAR; PG8_WAIT_L(0); PG8_MMA(1, 0, At, B0); PG8_BAR; PG8_SCHED;
            PG8_STAGE(PG8_SB(0, 1), b2 + hstep, voffB);
            PG8_WAIT_V(6); PG8_BAR; PG8_MMA(1, 1, At, B1); PG8_BAR;
            PG8_LDB(B0, 1, 0); PG8_SCHED; PG8_LDA(At, 1, 0); PG8_STAGE(PG8_SA(0, 1), a2 + hstep, voffA);
            PG8_WAIT_L(8); PG8_BAR; PG8_WAIT_L(0); PG8_MMA(0, 0, At, B0); PG8_BAR; PG8_SCHED;
            PG8_LDB(B1, 1, 1); PG8_STAGE(PG8_SB(1, 0), b3, voffB);
            PG8_BAR; PG8_WAIT_L(0); PG8_MMA(0, 1, At, B1); PG8_BAR;
            PG8_LDA(At, 1, 1); PG8_STAGE(PG8_SA(1, 0), a3, voffA);
            PG8_BAR; PG8_WAIT_L(0); PG8_MMA(1, 0, At, B0); PG8_BAR; PG8_SCHED;
            PG8_STAGE(PG8_SB(1, 1), b3 + hstep, voffB);
            PG8_WAIT_V(6); PG8_BAR; PG8_MMA(1, 1, At, B1); PG8_BAR;
            }
        }
        if constexpr (ALIGN_EPI) { if (wr == 0) PG8_BAR; }
        if constexpr (!Epi::AFTER_DRAIN) { E(acc, cur, wr, wc, fr, fq); S.done(cur); }
        if (!has_next) break;
#pragma unroll
        for (int a = 0; a < 2; ++a)
#pragma unroll
            for (int b = 0; b < 2; ++b)
#pragma unroll
                for (int m = 0; m < 4; ++m)
#pragma unroll
                    for (int n = 0; n < 2; ++n) acc[a][b][m][n] = (f32x4){0.f, 0.f, 0.f, 0.f};
        cur = nxt; cA = nA; cB = nB; ++ui;
        if constexpr (ALIGN_EPI) { if (wr == 1) PG8_BAR; }
    }
    PG8_WAIT_V(0);
    if constexpr (!ALIGN_EPI) { if (wr == 0) PG8_BAR; }
    PG8_BAR;
    if constexpr (Epi::AFTER_DRAIN) { E.fused(acc, cur, wr, wc, fr, fq, lds, wid, lane); S.done(cur); }
#undef PG8_SA
#undef PG8_SB
#undef PG8_STAGE
#undef PG8_LDA
#undef PG8_LDB
#undef PG8_MMA
#undef PG8_WAIT_V
#undef PG8_WAIT_L
#undef PG8_BAR
#undef PG8_SCHED
}
}

#define LAS __attribute__((address_space(3)))
typedef unsigned short bf16;
typedef short bf16x8 __attribute__((ext_vector_type(8)));
typedef float f32x4 __attribute__((ext_vector_type(4)));
typedef float f32x16 __attribute__((ext_vector_type(16)));
typedef unsigned u32x4 __attribute__((ext_vector_type(4)));
typedef unsigned u32x2 __attribute__((ext_vector_type(2)));
typedef float f32x2_t __attribute__((ext_vector_type(2)));
typedef __bf16 bf16x2_t __attribute__((ext_vector_type(2)));
#define MFMA32(a, b, c) __builtin_amdgcn_mfma_f32_32x32x16_bf16((a), (b), (c), 0, 0, 0)
__device__ __forceinline__ unsigned cvtpk(float lo, float hi) { f32x2_t v = {lo, hi}; bf16x2_t b = __builtin_convertvector(v, bf16x2_t); return __builtin_bit_cast(unsigned, b); }
__device__ __forceinline__ float bflo(unsigned w) { return __uint_as_float(w << 16); }
__device__ __forceinline__ float bfhi(unsigned w) { return __uint_as_float(w & 0xffff0000u); }
__device__ __forceinline__ int crow(int i, int hh) { return (i & 3) + 8 * (i >> 2) + 4 * hh; }
__device__ __forceinline__ int pi32(int r) { return (r & ~12) | ((r & 4) << 1) | ((r & 8) >> 1); }
__device__ __forceinline__ bf16x8 packf(const f32x16& s, int half) {
    u32x4 w;
    if (half == 0) { w.x = cvtpk(s[0], s[1]); w.y = cvtpk(s[2], s[3]); w.z = cvtpk(s[4], s[5]); w.w = cvtpk(s[6], s[7]); }
    else { w.x = cvtpk(s[8], s[9]); w.y = cvtpk(s[10], s[11]); w.z = cvtpk(s[12], s[13]); w.w = cvtpk(s[14], s[15]); }
    return __builtin_bit_cast(bf16x8, w);
}
__device__ __forceinline__ float wave_sum(float v) { v = XSUM_SWZ(v, 1); v = XSUM_SWZ(v, 2); v = XSUM_SWZ(v, 4); v = XSUM_SWZ(v, 8); v = XSUM_SWZ(v, 16); return xsum32(v); }
__device__ __forceinline__ float wave_max(float v) { v = XMAX_SWZ(v, 1); v = XMAX_SWZ(v, 2); v = XMAX_SWZ(v, 4); v = XMAX_SWZ(v, 8); v = XMAX_SWZ(v, 16); return xmax32(v); }
__device__ __forceinline__ void glds16(const void* g, LAS unsigned char* l) { __builtin_amdgcn_global_load_lds((const unsigned*)g, (LAS unsigned*)l, 16, 0, 0); }

constexpr int NTOK = 16384, SEQ = 8192, DM = 1024, FFH = 2816, MEML = 256;
constexpr float EPS = 1e-6f;
constexpr float LOG2E = 1.4426950408889634f;
constexpr size_t MiB = 1u << 20;
constexpr size_t WS_SSQ1 = 0, WS_SSQ2 = 65536, WS_RSTD1 = 131072, WS_RSTDM = 196608;
constexpr size_t WS_CS = 1 * MiB;
constexpr size_t WS_WN = 3 * MiB;
constexpr size_t WS_WTR = 8 * MiB;
constexpr size_t WS_WOUT = 11 * MiB, WS_XQ = 13 * MiB, WS_XKV = 15 * MiB, WS_XO = 19 * MiB;
constexpr size_t WS_WGU = 21 * MiB;
constexpr size_t WS_WD = 32 * MiB;
constexpr size_t WS_XB = 38 * MiB;
constexpr size_t WS_PROJ = 70 * MiB;
constexpr size_t WS_TR = 150 * MiB;
constexpr size_t WS_MIX = 198 * MiB;
constexpr size_t WS_KVS = 230 * MiB;
constexpr size_t WS_K2 = 246 * MiB, WS_V2T = 247 * MiB, WS_MEMB = 248 * MiB, WS_PARTL = 249 * MiB;
constexpr size_t WS_BAR = 250 * MiB;
constexpr size_t WS_END = 256 * MiB;
constexpr int LDS_BYTES = 147456;

struct Params { const float* in[21]; float* out; unsigned char* ws; int use_cg; int pad; };

template <int NCH> __device__ __forceinline__ void otile_put(LAS unsigned char* stg, int r, int hh, int chunk, u32x2 w) { *(LAS u32x2*)(stg + r * (NCH * 16) + ((chunk ^ (r & (NCH - 1))) << 4) + hh * 8) = w; }
template <int NCH> __device__ __forceinline__ void otile_flush(const LAS unsigned char* stg, bf16* g, int ld, int lane_) {
    int lane = lane_; asm volatile("" : "+v"(lane));
#pragma unroll
    for (int i = 0; i < NCH / 2; ++i) { const int row = i * (64 / NCH) + lane / NCH, chunk = lane % NCH;
        const u32x4 v = *(const LAS u32x4*)(stg + row * (NCH * 16) + ((chunk ^ (row & (NCH - 1))) << 4));
        *(u32x4*)(g + (size_t)row * ld + chunk * 8) = v; }
}

__device__ __forceinline__ int rperm32(int c) { return 256 * (c >> 8) + 128 * ((c & 63) >> 5) + 32 * ((c & 255) >> 6); }
struct TrDesc { const float* W; const float* gain; bf16* D0; bf16* D1; int K, N, d0, d1, item; };
__device__ __forceinline__ void tr_load(const TrDesc& t, float (&wv)[32], int lane) {
    const int nblk = t.N / 32, kb = t.item / nblk, nb = t.item % nblk, k0 = 64 * kb, n0 = 32 * nb;
#pragma unroll
    for (int i = 0; i < 32; ++i) { const int kk = 2 * i + (lane >> 5); wv[i] = __builtin_nontemporal_load(t.W + (size_t)(k0 + kk) * t.N + n0 + (lane & 31)); }
}
__device__ __forceinline__ void tr_store(const TrDesc& t, const float (&wv)[32], LAS float* scr, int lane) {
    const int nblk = t.N / 32, kb = t.item / nblk, k0 = 64 * kb;
#pragma unroll
    for (int i = 0; i < 32; ++i) { const int kk = 2 * i + (lane >> 5); const float g = t.gain ? t.gain[k0 + kk] : 1.0f; scr[kk * 33 + (lane & 31)] = wv[i] * g; }
    asm volatile("s_waitcnt lgkmcnt(0)" ::: "memory");
    const int c = lane & 7;
#pragma unroll
    for (int j = 0; j < 4; ++j) { const int n = (lane >> 3) + 8 * j; const LAS float* s = scr + (8 * c) * 33 + n;
        u32x4 o; o.x = cvtpk(s[0 * 33], s[1 * 33]); o.y = cvtpk(s[2 * 33], s[3 * 33]); o.z = cvtpk(s[4 * 33], s[5 * 33]); o.w = cvtpk(s[6 * 33], s[7 * 33]);
        if (t.D0) *(u32x4*)(t.D0 + (size_t)(t.d0 + n) * t.K + k0 + 8 * c) = o;
        if (t.D1) *(u32x4*)(t.D1 + (size_t)(t.d1 + n) * t.K + k0 + 8 * c) = o; }
    asm volatile("s_waitcnt lgkmcnt(0)" ::: "memory");
}
__device__ __forceinline__ TrDesc tr_decode(const Params& P, int it) {
    unsigned char* ws = P.ws; bf16* WN = (bf16*)(ws + WS_WN); bf16* WTR = (bf16*)(ws + WS_WTR);
    constexpr int I0 = 16 * 112, I1 = 512, I2 = 512, I3 = 16 * 64, I4 = 512, I5 = 16 * 88, I6 = 16 * 88;
    TrDesc t; t.D1 = nullptr; t.d1 = 0; t.K = 1024; int r = it;
    if (r < I0) { const int n0 = 32 * (r % 112), seg = n0 >> 9, wi = n0 & 511;
        t.W = P.in[3]; t.N = 3584; t.gain = P.in[2]; t.D0 = nullptr; t.d0 = 0; t.item = r;
        if (seg == 0) { t.D0 = WN; t.d0 = rperm32(wi); }
        else if (seg == 1) { t.D0 = WN; t.d0 = 512 + rperm32(wi); t.D1 = WTR; t.d1 = rperm32(wi); }
        else if (seg == 2) { t.D1 = WTR; t.d1 = 512 + wi; }
        else if (seg == 3) { t.D0 = WN; t.d0 = 1024 + wi; }
        else if (seg == 4) { t.D0 = WN; t.d0 = 1536 + rperm32(wi); }
        else if (seg == 5) { t.D0 = WN; t.d0 = 2048 + rperm32(wi); }
        else { t.D1 = WTR; t.d1 = 1024 + wi; }
        return t; }
    r -= I0;
    if (r < I1) { t.W = P.in[9]; t.N = 1024; t.gain = P.in[8]; t.D0 = (bf16*)(ws + WS_WOUT); t.d0 = 32 * (r % 32); t.item = r; return t; } r -= I1;
    if (r < I2) { t.W = P.in[12]; t.N = 1024; t.gain = P.in[10]; t.D0 = (bf16*)(ws + WS_XQ); t.d0 = 32 * (r % 32); t.item = r; return t; } r -= I2;
    if (r < I3) { t.W = P.in[13]; t.N = 2048; t.gain = P.in[11]; t.D0 = (bf16*)(ws + WS_XKV); t.d0 = 32 * (r % 64); t.item = r; return t; } r -= I3;
    if (r < I4) { t.W = P.in[16]; t.N = 1024; t.gain = nullptr; t.D0 = (bf16*)(ws + WS_XO); t.d0 = 32 * (r % 32); t.item = r; return t; } r -= I4;
    if (r < I5) { const int n0 = 32 * (r % 88); t.W = P.in[18]; t.N = 2816; t.gain = P.in[17]; t.D0 = (bf16*)(ws + WS_WGU); t.d0 = (n0 >> 7) * 256 + (n0 & 127); t.item = r; return t; } r -= I5;
    if (r < I6) { const int n0 = 32 * (r % 88); t.W = P.in[19]; t.N = 2816; t.gain = P.in[17]; t.D0 = (bf16*)(ws + WS_WGU); t.d0 = (n0 >> 7) * 256 + 128 + (n0 & 127); t.item = r; return t; } r -= I6;
    t.W = P.in[20]; t.K = 2816; t.N = 1024; t.gain = nullptr; t.D0 = (bf16*)(ws + WS_WD); t.d0 = 32 * (r % 32); t.item = r; return t;
}
template <int NR> __device__ __forceinline__ void rows_to_bf16(const float* x, bf16* o, float* rstd_out, int m0, int mstride, int lane) {
    f32x4 v[NR][4]; float s[NR];
#pragma unroll
    for (int q = 0; q < NR; ++q) { const f32x4* xr = (const f32x4*)(x + (size_t)(m0 + q * mstride) * DM) + lane;
#pragma unroll
        for (int j = 0; j < 4; ++j) v[q][j] = __builtin_nontemporal_load(xr + 64 * j); }
#pragma unroll
    for (int q = 0; q < NR; ++q) { float a = 0.f;
#pragma unroll
        for (int j = 0; j < 4; ++j) a += (v[q][j][0] * v[q][j][0] + v[q][j][1] * v[q][j][1]) + (v[q][j][2] * v[q][j][2] + v[q][j][3] * v[q][j][3]);
        s[q] = wave_sum(a); }
#pragma unroll
    for (int q = 0; q < NR; ++q) { u32x2* o8 = (u32x2*)(o + (size_t)(m0 + q * mstride) * DM) + lane;
#pragma unroll
        for (int j = 0; j < 4; ++j) { u32x2 w; w.x = cvtpk(v[q][j][0], v[q][j][1]); w.y = cvtpk(v[q][j][2], v[q][j][3]); o8[64 * j] = w; }
        if (lane == 0) rstd_out[m0 + q * mstride] = rsqrtf(s[q] * (1.0f / 1024.0f) + EPS); }
}
__device__ __forceinline__ void p0_prologue(const Params& P, LAS unsigned char* lds, int wid_s) {
    const int lane = lane_id_asm(), wid = wid_s, tid = wid * 64 + lane;
    const int gw = blockIdx.x * 8 + wid, NGW = gridDim.x * 8;
    unsigned char* ws = P.ws;
    LAS float* scr = (LAS float*)(lds + wid * 16384);
    constexpr int NIT = 16 * 112 + 512 + 512 + 16 * 64 + 512 + 16 * 88 + 16 * 88 + 44 * 32;
    if (gw < NIT) {
        int it = gw; TrDesc cur = tr_decode(P, it); float a[32]; tr_load(cur, a, lane);
        for (;;) {
            const int nx = it + NGW; const bool has = nx < NIT; TrDesc nxt = cur; float bnx[32];
            if (has) { nxt = tr_decode(P, nx); tr_load(nxt, bnx, lane); }
            tr_store(cur, a, scr, lane);
            if (!has) break;
            cur = nxt; it = nx;
#pragma unroll
            for (int i = 0; i < 32; ++i) a[i] = bnx[i];
        }
    }
    {   int m = gw;
        for (; m + 3 * NGW < NTOK; m += 4 * NGW) rows_to_bf16<4>(P.in[0], (bf16*)(ws + WS_XB), (float*)(ws + WS_RSTD1), m, NGW, lane);
        for (; m < NTOK; m += NGW) rows_to_bf16<1>(P.in[0], (bf16*)(ws + WS_XB), (float*)(ws + WS_RSTD1), m, NGW, lane); }
    for (int m = gw; m < 2 * MEML; m += NGW) rows_to_bf16<1>(P.in[1], (bf16*)(ws + WS_MEMB), (float*)(ws + WS_RSTDM), m, NGW, lane);
    const int gt = blockIdx.x * 512 + tid, NGT = gridDim.x * 512;
    for (int e = gt; e < SEQ * 32; e += NGT) {
        const int pos = e >> 5, i = e & 31;
        const float inv = 1.0f / exp2f((float)i * (1.0f / 31.0f) * 13.287712379549449f);
        const float ang = (float)pos * inv;
        double t = (double)ang * 0.15915494309189535; t -= floor(t);
        const float tf = (float)t;
        float2 v; v.x = __builtin_amdgcn_cosf(tf); v.y = __builtin_amdgcn_sinf(tf);
        ((float2*)(ws + WS_CS))[e] = v;
    }
    for (int e = gt; e < NTOK; e += NGT) { ((float*)(ws + WS_SSQ1))[e] = 0.f; ((float*)(ws + WS_SSQ2))[e] = 0.f; }
}

__device__ __forceinline__ float ret_l2g(int h) { return log1pf(-exp2f(-5.0f - (float)h)) * LOG2E; }
__device__ __forceinline__ void ret_kv_phase(const Params& P, int wid_s) {
    const int lane = lane_id_asm(), wid = wid_s, tid = wid * 64 + lane, r = lane & 31, hh = lane >> 5;
    const bf16* TR = (const bf16*)(P.ws + WS_TR); float* KVS = (float*)(P.ws + WS_KVS);
    for (int pair = blockIdx.x; pair < 512; pair += gridDim.x) {
        const int chunk = pair * 2 + (wid >> 2), j = wid & 3, bh = chunk >> 6, n = chunk & 63, b = bh >> 3, h = bh & 7, a = j >> 1, bb = j & 1;
        const size_t tok0 = (size_t)b * SEQ + n * 128;
        const bf16* vt = TR + (size_t)(512 + h * 64 + 32 * a + r) * NTOK + tok0 + 8 * hh;
        const bf16* kt = TR + (size_t)(h * 64 + 32 * bb + r) * NTOK + tok0 + 8 * hh;
        f32x16 acc = {};
#pragma unroll
        for (int s = 0; s < 8; ++s) acc = MFMA32(*(const bf16x8*)(vt + 16 * s), *(const bf16x8*)(kt + 16 * s), acc);
        float* dst = KVS + (size_t)chunk * 4096 + (32 * a) * 64 + 32 * bb + r;
#pragma unroll
        for (int i = 0; i < 16; ++i) dst[crow(i, hh) * 64] = acc[i];
    }
}
__device__ __forceinline__ void ret_scan_phase(const Params& P, int wid_s) {
    float* KVS = (float*)(P.ws + WS_KVS);
    if (wid_s >= 4) return;
    for (int e = blockIdx.x * 256 + wid_s * 64 + lane_id_asm(); e < 16 * 4096; e += gridDim.x * 256) {
        const int bh = e >> 12, el = e & 4095, h = bh & 7;
        const float gC = exp2f(128.0f * ret_l2g(h));
        unsigned idx = (unsigned)(bh * 64 * 4096 + el); float R = 0.f;
        for (int n0 = 0; n0 < 64; n0 += 16) { float t[16];
#pragma unroll
            for (int k = 0; k < 16; ++k) t[k] = KVS[idx + (unsigned)(k * 4096)];
#pragma unroll
            for (int k = 0; k < 16; ++k) { KVS[idx + (unsigned)(k * 4096)] = R; R = R * gC + t[k]; }
            idx += 16 * 4096; }
    }
}
template <int MODE = 0> __device__ __forceinline__ void ret_out_phase(const Params& P, LAS unsigned char* lds, int wid_s) {
    const int lane = lane_id_asm(), wid = wid_s, r = lane & 31, hh = lane >> 5;
    const bf16* PROJ = (const bf16*)(P.ws + WS_PROJ); const bf16* TR = (const bf16*)(P.ws + WS_TR); const float* KVS = (const float*)(P.ws + WS_KVS); bf16* MIX = (bf16*)(P.ws + WS_MIX);
    const int cg = wid >> 2, j = wid & 3, tl = j * 64 + lane;
    LAS unsigned char* base = lds + cg * 65536;
    for (int pair = blockIdx.x; pair < 512; pair += gridDim.x) {
        const int chunk = pair * 2 + cg, bh = chunk >> 6, n = chunk & 63, b = bh >> 3, h = bh & 7;
        const size_t tok0 = (size_t)b * SEQ + n * 128; const int c0 = 32 * j;
        const float l2g = ret_l2g(h);
        __syncthreads();
        {   u32x4 t0_[4], t1_[4], t2_[4], t3_[4];
#pragma unroll
            for (int k = 0; k < 4; ++k) { const int idx = tl + 256 * k, row = idx >> 3, piece = idx & 7; const bf16* src = PROJ + (tok0 + row) * 2560 + h * 64 + piece * 8;
                t0_[k] = *(const u32x4*)(src); t1_[k] = *(const u32x4*)(src + 512); t2_[k] = *(const u32x4*)(src + 1024);
                const int vrow = idx >> 4, vpiece = idx & 15; t3_[k] = *(const u32x4*)(TR + (size_t)(512 + h * 64 + vrow) * NTOK + tok0 + vpiece * 8); }
#pragma unroll
            for (int k = 0; k < 4; ++k) { const int idx = tl + 256 * k, row = idx >> 3, piece = idx & 7; const int off = row * 128 + ((piece ^ ((row >> 1) & 7)) << 4);
                *(LAS u32x4*)(base + off) = t0_[k]; *(LAS u32x4*)(base + 16384 + off) = t1_[k]; *(LAS u32x4*)(base + 32768 + off) = t2_[k];
                const int vrow = idx >> 4, vpiece = idx & 15; *(LAS u32x4*)(base + 49152 + vrow * 256 + ((vpiece ^ (vrow & 15)) << 4)) = t3_[k]; }
        }
        __syncthreads();
        bf16x8 qf[4];
        { const int row = c0 + r;
#pragma unroll
          for (int d0 = 0; d0 < 4; ++d0) qf[d0] = *(const LAS bf16x8*)(base + row * 128 + (((2 * d0 + hh) ^ ((row >> 1) & 7)) << 4)); }
        f32x16 o[2]; o[0] = f32x16{}; o[1] = f32x16{};
        for (int jb = 0; jb <= j; ++jb) {
            const int krow = 32 * jb + pi32(r);
            f32x16 S = {};
#pragma unroll
            for (int d0 = 0; d0 < 4; ++d0) S = MFMA32(*(const LAS bf16x8*)(base + 16384 + krow * 128 + (((2 * d0 + hh) ^ ((krow >> 1) & 7)) << 4)), qf[d0], S);
#pragma unroll
            for (int i = 0; i < 16; ++i) { const int kvi = 32 * jb + 16 * (i >> 3) + 8 * hh + (i & 7); const int rel = (c0 + r) - kvi;
                S[i] = rel >= 0 ? S[i] * __builtin_amdgcn_exp2f(l2g * (float)rel) : 0.f; }
            const bf16x8 pk0 = packf(S, 0), pk1 = packf(S, 1);
#pragma unroll
            for (int a = 0; a < 2; ++a) { const int vrow = 32 * a + r;
                o[a] = MFMA32(*(const LAS bf16x8*)(base + 49152 + vrow * 256 + (((4 * jb + hh) ^ (vrow & 15)) << 4)), pk0, o[a]);
                o[a] = MFMA32(*(const LAS bf16x8*)(base + 49152 + vrow * 256 + (((4 * jb + 2 + hh) ^ (vrow & 15)) << 4)), pk1, o[a]); }
        }
        const float xi = exp2f(l2g * (float)(c0 + r + 1));
#pragma unroll
        for (int a = 0; a < 2; ++a) { f32x16 t = {}; const float* rp = KVS + (size_t)chunk * 4096 + (32 * a + r) * 64 + 8 * hh;
#pragma unroll
            for (int d0 = 0; d0 < 4; ++d0) { const f32x4 lo = *(const f32x4*)(rp + 16 * d0), hi4 = *(const f32x4*)(rp + 16 * d0 + 4);
                u32x4 w; w.x = cvtpk(lo[0], lo[1]); w.y = cvtpk(lo[2], lo[3]); w.z = cvtpk(hi4[0], hi4[1]); w.w = cvtpk(hi4[2], hi4[3]);
                t = MFMA32(__builtin_bit_cast(bf16x8, w), qf[d0], t); }
#pragma unroll
            for (int i = 0; i < 16; ++i) o[a][i] += t[i] * xi; }
        float ss = 0.f;
#pragma unroll
        for (int a = 0; a < 2; ++a)
#pragma unroll
            for (int i = 0; i < 16; ++i) ss += o[a][i] * o[a][i];
        ss = xsum32(ss);
        const float rr = rsqrtf(ss * (1.0f / 64.0f) + EPS);
        LAS unsigned char* stg = base + c0 * 128;
        { const int row = c0 + r;
#pragma unroll
          for (int a = 0; a < 2; ++a)
#pragma unroll
              for (int g = 0; g < 4; ++g) {
                  const u32x2 gw = *(const LAS u32x2*)(base + 32768 + row * 128 + (((4 * a + g) ^ ((row >> 1) & 7)) << 4) + hh * 8);
                  u32x2 w; w.x = cvtpk(o[a][4 * g] * rr * bflo(gw.x), o[a][4 * g + 1] * rr * bfhi(gw.x)); w.y = cvtpk(o[a][4 * g + 2] * rr * bflo(gw.y), o[a][4 * g + 3] * rr * bfhi(gw.y));
                  otile_put<8>(stg, r, hh, 4 * a + g, w); } }
        otile_flush<8>(stg, MIX + (tok0 + c0) * 1024 + h * 64, 1024, lane);
    }
    __syncthreads();
}

struct DiffCtx { const bf16* PROJ; const bf16* TR; bf16* MIX; float* partO0; float* partO1; float* partL0; float* partL1; unsigned* flags; const float* subln; float lam; float shift; };
__device__ __forceinline__ void diff_epilogue(f32x16 (&o)[4], const DiffCtx& C, size_t tokw, int h, int lane, LAS unsigned char* stg) {
    const int r = lane & 31, hh = lane >> 5;
    float ss = 0.f;
#pragma unroll
    for (int db = 0; db < 4; ++db)
#pragma unroll
        for (int i = 0; i < 16; ++i) ss += o[db][i] * o[db][i];
    ss = xsum32(ss);
    const float rr = rsqrtf(ss * (1.0f / 128.0f) + EPS) * 0.8f;
#pragma unroll
    for (int db = 0; db < 4; ++db)
#pragma unroll
        for (int g = 0; g < 4; ++g) { const int d = 32 * db + 8 * g + 4 * hh; const f32x4 sg = *(const f32x4*)(C.subln + d);
            u32x2 w; w.x = cvtpk(o[db][4 * g] * rr * sg[0], o[db][4 * g + 1] * rr * sg[1]); w.y = cvtpk(o[db][4 * g + 2] * rr * sg[2], o[db][4 * g + 3] * rr * sg[3]);
            otile_put<16>(stg, r, hh, 4 * db + g, w); }
    otile_flush<16>(stg, C.MIX + tokw * 1024 + 512 + h * 128, 1024, lane);
}
template <bool SHIFT, int MODE = 0> __device__ __forceinline__ void diff_segment(const DiffCtx& C, LAS unsigned char* lds, int b, int h, int qb, int t0, int t1, int outmode, int unitidx, int wid_s) {
    const int lane = lane_id_asm(), wid = wid_s, r = lane & 31, hh = lane >> 5;
    const int q0 = 256 * qb + 32 * wid; const size_t tokbase = (size_t)b * SEQ;
    bf16x8 qf[2][4];
    { const bf16* qp = C.PROJ + (tokbase + q0 + r) * 2560 + 1536 + h * 128 + 8 * hh;
#pragma unroll
      for (int mp = 0; mp < 2; ++mp)
#pragma unroll
          for (int d0 = 0; d0 < 4; ++d0) qf[mp][d0] = *(const bf16x8*)(qp + mp * 64 + d0 * 16); }
    f32x16 o[2][4];
#pragma unroll
    for (int mp = 0; mp < 2; ++mp)
#pragma unroll
        for (int db = 0; db < 4; ++db) o[mp][db] = f32x16{};
    float l0 = 0.f, l1 = 0.f;
    unsigned kg[4], vg[4];
    const bf16* kbase = C.PROJ + tokbase * 2560 + 2048 + h * 128; const bf16* vbase = C.TR + (size_t)(1024 + h * 128) * NTOK + tokbase;
#pragma unroll
    for (int j = 0; j < 4; ++j) { const int c = wid * 4 + j, row = 4 * c + (lane >> 4), pc = (lane & 15) ^ (row & 15);
        kg[j] = (unsigned)(row * 2560 + pc * 8); vg[j] = (unsigned)(row * NTOK + pc * 8); }
#define DIFF_STAGE(t, buf) do { _Pragma("unroll") for (int j_ = 0; j_ < 4; ++j_) { \
        glds16(kbase + (size_t)(t) * 128 * 2560 + kg[j_], lds + (buf) * 65536 + (wid * 4 + j_) * 1024); \
        glds16(vbase + (size_t)(t) * 128 + vg[j_], lds + (buf) * 65536 + 32768 + (wid * 4 + j_) * 1024); } } while (0)
    DIFF_STAGE(t0, 0);
    for (int t = t0; t < t1; ++t) {
        const int buf = (t - t0) & 1;
        asm volatile("s_waitcnt vmcnt(0)" ::: "memory"); __syncthreads();
        if (t + 1 < t1) DIFF_STAGE(t + 1, buf ^ 1);
        const int k0 = 128 * t;
        if (k0 <= q0 + 31) {
            const LAS unsigned char* Kb = lds + buf * 65536; const LAS unsigned char* Vb = Kb + 32768;
            const bool needmask = (k0 + 127 > q0);
#pragma unroll
            for (int kb = 0; kb < 4; ++kb) {
                if (k0 + 32 * kb <= q0 + 31) {
                const int krow = 32 * kb + pi32(r);
                bf16x8 pk[2][2];
#pragma unroll
                for (int mp = 0; mp < 2; ++mp) {
                    f32x16 S = {};
#pragma unroll
                    for (int d0 = 0; d0 < 4; ++d0) { const int piece = mp * 8 + 2 * d0 + hh;
                        const bf16x8 kf = *(const LAS bf16x8*)(Kb + krow * 256 + ((piece ^ (krow & 15)) << 4));
                        S = MFMA32(kf, qf[mp][d0], S); }
                    float ls = 0.f;
#pragma unroll
                    for (int i = 0; i < 16; ++i) { float p = __builtin_amdgcn_exp2f(SHIFT ? S[i] - C.shift : S[i]);
                        if (needmask) { const int kv = k0 + 32 * kb + 16 * (i >> 3) + 8 * hh + (i & 7); if (kv > q0 + r) p = 0.f; }
                        S[i] = p; ls += p; }
                    if (mp == 0) l0 += ls; else l1 += ls;
                    pk[mp][0] = packf(S, 0); pk[mp][1] = packf(S, 1);
                }
#pragma unroll
                for (int db = 0; db < 4; ++db) { const int vrow = 32 * db + r;
#pragma unroll
                    for (int s2 = 0; s2 < 2; ++s2) { const int piece = 2 * (2 * kb + s2) + hh;
                        const bf16x8 vf = *(const LAS bf16x8*)(Vb + vrow * 256 + ((piece ^ (vrow & 15)) << 4));
                        o[0][db] = MFMA32(vf, pk[0][s2], o[0][db]); o[1][db] = MFMA32(vf, pk[1][s2], o[1][db]); } }
                }
            }
        }
    }
#undef DIFF_STAGE
    __syncthreads();
    l0 = xsum32(l0); l1 = xsum32(l1);
    if (outmode == 2) {
        if (wid == 0 && lane == 0) { unsigned sp = 0; while (__hip_atomic_load(C.flags + 64 * unitidx, __ATOMIC_RELAXED, __HIP_MEMORY_SCOPE_AGENT) == 0u && ++sp < (1u << 22)) __builtin_amdgcn_s_sleep(1);
            __builtin_amdgcn_fence(__ATOMIC_ACQUIRE, "agent"); asm volatile("s_waitcnt vmcnt(0)" ::: "memory"); }
        __syncthreads();
        const float* po = C.partO0 + (size_t)(unitidx * 8 + wid) * 8192 + lane;
#pragma unroll
        for (int mp = 0; mp < 2; ++mp)
#pragma unroll
            for (int db = 0; db < 4; ++db) { const float* pp = po + (mp * 4 + db) * 1024; asm volatile("" : "+v"(pp));
#pragma unroll
                for (int i = 0; i < 16; ++i) o[mp][db][i] += pp[i * 64]; }
        const float* pl = C.partL0 + (size_t)(unitidx * 8 + wid) * 128 + lane; l0 += pl[0]; l1 += pl[64];
    }
    if (outmode != 1) { const float i0 = 1.0f / l0, i1 = C.lam / l1;
#pragma unroll
        for (int db = 0; db < 4; ++db)
#pragma unroll
            for (int i = 0; i < 16; ++i) o[0][db][i] = o[0][db][i] * i0 - o[1][db][i] * i1;
        diff_epilogue(o[0], C, tokbase + q0, h, lane, lds + wid * 8192); }
    else {
        float* po = C.partO0 + (size_t)(unitidx * 8 + wid) * 8192 + lane;
#pragma unroll
        for (int mp = 0; mp < 2; ++mp)
#pragma unroll
            for (int db = 0; db < 4; ++db) { float* pp = po + (mp * 4 + db) * 1024; asm volatile("" : "+v"(pp));
#pragma unroll
                for (int i = 0; i < 16; ++i) pp[i * 64] = o[mp][db][i]; }
        float* pl = C.partL0 + (size_t)(unitidx * 8 + wid) * 128 + lane; pl[0] = l0; pl[64] = l1;
    }
    asm volatile("s_waitcnt vmcnt(0)" ::: "memory");
    __syncthreads();
    if (outmode == 1 && wid == 0 && lane == 0) { __builtin_amdgcn_fence(__ATOMIC_RELEASE, "agent"); asm volatile("s_waitcnt vmcnt(0)" ::: "memory");
        (void)__hip_atomic_fetch_add(C.flags + 64 * unitidx, 1u, __ATOMIC_RELAXED, __HIP_MEMORY_SCOPE_AGENT); }
}
__device__ __forceinline__ DiffCtx diff_ctx(const Params& P) {
    const int lane = lane_id_asm();
    DiffCtx C; C.PROJ = (const bf16*)(P.ws + WS_PROJ); C.TR = (const bf16*)(P.ws + WS_TR); C.MIX = (bf16*)(P.ws + WS_MIX);
    C.partO0 = P.out; C.partO1 = (float*)(P.ws + WS_XB); C.partL0 = (float*)(P.ws + WS_PARTL); C.partL1 = (float*)(P.ws + WS_PARTL + 512 * 1024);
    C.subln = P.in[7]; C.flags = (unsigned*)(P.ws + WS_BAR + 16384);
    const float* lv = P.in[6];
    const float s01 = wave_sum(lv[lane] * lv[64 + lane]), s23 = wave_sum(lv[128 + lane] * lv[192 + lane]);
    C.lam = __uint_as_float(__builtin_amdgcn_readfirstlane(__float_as_uint(expf(s01) - expf(s23) + 0.2f)));
    const float mq = wave_max(fabsf(P.in[4][lane])), mk = wave_max(fabsf(P.in[5][lane]));
    C.shift = __uint_as_float(__builtin_amdgcn_readfirstlane(__float_as_uint(fmaxf(mq * mk * 64.0f * (0.125f * LOG2E) - 60.0f, 0.f))));
    return C;
}
__device__ __forceinline__ void diff_phase(const Params& P, LAS unsigned char* lds, int wid_s) {
    const DiffCtx C = diff_ctx(P);
    for (int pass = 0; pass < 2; ++pass)
    for (int v = blockIdx.x; v < 256; v += gridDim.x) {
        const int bh = v & 7, s = v >> 3, b = bh >> 2, h = bh & 3;
        if ((s < 16) != (pass == 0)) continue;
        const int q = s & 15, nseg = s < 16 ? 1 : 2;
        for (int sg = 0; sg < nseg; ++sg) {
            const bool small_ = (s >= 16) && sg == 0;
            const int a_qb = small_ ? q : 31 - q, a_t0 = small_ ? 0 : (s < 16 ? 0 : 33), a_t1 = small_ ? 2 * q + 2 : (s < 16 ? 33 : 64 - 2 * q), a_om = small_ ? 0 : (s < 16 ? 1 : 2), a_ui = bh * 16 + (15 - q);
            if (C.shift == 0.f) diff_segment<false>(C, lds, b, h, a_qb, a_t0, a_t1, a_om, a_ui, wid_s);
            else diff_segment<true>(C, lds, b, h, a_qb, a_t0, a_t1, a_om, a_ui, wid_s);
        }
    }
}
template <int MODE> __device__ __forceinline__ void diff_probe_phase(const Params& P, LAS unsigned char* lds, int wid_s) {
    const DiffCtx C = diff_ctx(P);
    for (int v = blockIdx.x; v < 256; v += gridDim.x) {
        const int bh = v & 7, s = v >> 3, b = bh >> 2, h = bh & 3;
        const int q = s & 15, nseg = s < 16 ? 1 : 2;
        for (int sg = 0; sg < nseg; ++sg) {
            const bool small_ = sg == 1;
            const int a_qb = small_ ? q : 31 - q, a_t0 = small_ ? 0 : (s < 16 ? 0 : 33), a_t1 = small_ ? 2 * q + 2 : (s < 16 ? 33 : 64 - 2 * q), a_om = small_ ? 0 : (s < 16 ? 1 : 2), a_ui = bh * 16 + (15 - q);
            diff_segment<false, MODE>(C, lds, b, h, a_qb, a_t0, a_t1, a_om, a_ui, wid_s);
        }
    }
}
__device__ __forceinline__ void diff_combine_phase(const Params& P, LAS unsigned char* lds, int wid_s) {
    const DiffCtx C = diff_ctx(P);
    const int lane = lane_id_asm(), wid = wid_s, tid = wid * 64 + lane, r = lane & 31, hh = lane >> 5;
    const float* A = C.partO0; const float* B = C.partO1;
    for (int it = blockIdx.x * 8 + wid; it < 1024; it += gridDim.x * 8) {
        const int unitidx = it >> 3, w = it & 7, bh = unitidx >> 4, qb = 16 + (unitidx & 15), b = bh >> 2, h = bh & 3;
        const unsigned base = (unsigned)it * 8192u + (unsigned)lane;
        const float l0 = C.partL0[it * 128 + lane] + C.partL1[it * 128 + lane], l1 = C.partL0[it * 128 + 64 + lane] + C.partL1[it * 128 + 64 + lane];
        const float i0 = 1.0f / l0, i1 = C.lam / l1;
        float ss = 0.f;
#pragma unroll
        for (int db = 0; db < 4; ++db) { unsigned o0 = base + db * 1024, o1 = base + 4096 + db * 1024; asm volatile("" : "+v"(o0), "+v"(o1));
#pragma unroll
            for (int i = 0; i < 16; ++i) { const float v = (A[o0 + i * 64] + B[o0 + i * 64]) * i0 - (A[o1 + i * 64] + B[o1 + i * 64]) * i1; ss += v * v; } }
        ss = xsum32(ss);
        const float rr = rsqrtf(ss * (1.0f / 128.0f) + EPS) * 0.8f;
        LAS unsigned char* stg = lds + wid * 8192;
#pragma unroll
        for (int db = 0; db < 4; ++db) { unsigned o0 = base + db * 1024, o1 = base + 4096 + db * 1024; asm volatile("" : "+v"(o0), "+v"(o1));
#pragma unroll
            for (int g = 0; g < 4; ++g) { const int d = 32 * db + 8 * g + 4 * hh; const f32x4 sg = *(const f32x4*)(C.subln + d); float v[4];
#pragma unroll
                for (int e = 0; e < 4; ++e) { const int i = 4 * g + e; v[e] = ((A[o0 + i * 64] + B[o0 + i * 64]) * i0 - (A[o1 + i * 64] + B[o1 + i * 64]) * i1) * rr * sg[e]; }
                u32x2 wv; wv.x = cvtpk(v[0], v[1]); wv.y = cvtpk(v[2], v[3]); otile_put<16>(stg, r, hh, 4 * db + g, wv); } }
        otile_flush<16>(stg, C.MIX + ((size_t)b * SEQ + 256 * qb + 32 * w) * 1024 + 512 + h * 128, 1024, lane);
    }
    __syncthreads();
}

__device__ __forceinline__ void kv2_phase(const Params& P, int wid_s) {
    const int lane = lane_id_asm(), r = lane & 31, hh = lane >> 5;
    const bf16* MEMB = (const bf16*)(P.ws + WS_MEMB); const bf16* XKV = (const bf16*)(P.ws + WS_XKV); const float* RSTDM = (const float*)(P.ws + WS_RSTDM);
    bf16* K2 = (bf16*)(P.ws + WS_K2); bf16* V2T = (bf16*)(P.ws + WS_V2T);
    if (wid_s < 4) return;
    for (int blk = (wid_s - 4) * gridDim.x + blockIdx.x; blk < 1024; blk += gridDim.x * 4) {
        const bool isv = blk >= 512; const int bb = blk & 511;
        const int rb = isv ? (bb >> 4) : (bb >> 5), cb = isv ? (bb & 15) : (bb & 31);
        const bf16* ap = (isv ? XKV + (size_t)(1024 + 32 * rb + r) * 1024 : MEMB + (size_t)(32 * rb + r) * 1024) + 8 * hh;
        const bf16* bp = (isv ? MEMB + (size_t)(32 * cb + r) * 1024 : XKV + (size_t)(32 * cb + r) * 1024) + 8 * hh;
        f32x16 acc = {};
#pragma unroll 16
        for (int s = 0; s < 64; ++s) acc = MFMA32(*(const bf16x8*)(ap + 16 * s), *(const bf16x8*)(bp + 16 * s), acc);
        if (!isv) {
#pragma unroll
            for (int i = 0; i < 16; ++i) { const int m = 32 * rb + crow(i, hh); const unsigned w = cvtpk(acc[i] * RSTDM[m], 0.f);
                *(unsigned short*)(K2 + (size_t)m * 1024 + 32 * cb + r) = (unsigned short)w; }
        } else { const float rs = RSTDM[32 * cb + r];
#pragma unroll
            for (int i = 0; i < 16; ++i) { const int n = 32 * rb + crow(i, hh); const unsigned w = cvtpk(acc[i] * rs, 0.f);
                *(unsigned short*)(V2T + (size_t)n * 512 + 32 * cb + r) = (unsigned short)w; }
        }
    }
}

__device__ __forceinline__ void knorm_phase(const Params& P, int wid_s) {
    const int lane = lane_id_asm(); bf16* K2 = (bf16*)(P.ws + WS_K2); const float* gk = P.in[15];
    for (int t = blockIdx.x * 8 + wid_s; t < 2 * MEML * 4; t += gridDim.x * 8) {
        bf16* p = K2 + (size_t)(t >> 2) * 1024 + (t & 3) * 256 + 4 * lane;
        const u32x2 raw = *(const u32x2*)p; const f32x4 g = *(const f32x4*)(gk + 4 * lane);
        const float a0 = bflo(raw.x), a1 = bfhi(raw.x), a2 = bflo(raw.y), a3 = bfhi(raw.y);
        const float ss = wave_sum((a0 * a0 + a1 * a1) + (a2 * a2 + a3 * a3));
        const float rk = rsqrtf(ss * (1.0f / 256.0f) + EPS) * (0.0625f * LOG2E);
        u32x2 w; w.x = cvtpk(a0 * rk * g[0], a1 * rk * g[1]); w.y = cvtpk(a2 * rk * g[2], a3 * rk * g[3]);
        *(u32x2*)p = w;
    }
}

template <int MODE = 0> __device__ __forceinline__ void xattn_phase(const Params& P, LAS unsigned char* lds, int wid_s) {
    const int lane = lane_id_asm(), wid = wid_s, tid = wid * 64 + lane, r = lane & 31, hh = lane >> 5;
    const bf16* Q2 = (const bf16*)(P.ws + WS_PROJ); const bf16* K2 = (const bf16*)(P.ws + WS_K2); const bf16* V2T = (const bf16*)(P.ws + WS_V2T); bf16* O2 = (bf16*)(P.ws + WS_PROJ + 32 * MiB);
    const float* gq = P.in[14]; const float* gk = P.in[15];
    float mq = 0.f, mk = 0.f;
#pragma unroll
    for (int j = 0; j < 4; ++j) { mq = fmaxf(mq, fabsf(gq[lane + 64 * j])); mk = fmaxf(mk, fabsf(gk[lane + 64 * j])); }
    mq = wave_max(mq); mk = wave_max(mk);
    const float M2 = __uint_as_float(__builtin_amdgcn_readfirstlane(__float_as_uint(fmaxf(mq * mk * 256.0f * (0.0625f * LOG2E) - 60.0f, 0.f))));
    LAS unsigned char* Kb = lds; LAS unsigned char* Vb = lds + 32768; LAS unsigned char* Qb = lds + 65536;
    const int dh = wid >> 2;
    for (int item = blockIdx.x; item < 512; item += gridDim.x) {
        const int bhd = item >> 6, qblk = item & 63, b = bhd >> 2, head = bhd & 3;
        const size_t tokb = (size_t)b * SEQ + 128 * qblk; const size_t tok = tokb + 32 * (wid & 3) + r;
        __syncthreads();
        {
            const int sub = tid & 7; u32x4 raw[2][4];
#pragma unroll
            for (int p = 0; p < 2; ++p) { const bf16* qp = Q2 + (tokb + 64 * p + (tid >> 3)) * 1024 + head * 256 + 8 * sub;
#pragma unroll
                for (int k = 0; k < 4; ++k) raw[p][k] = *(const u32x4*)(qp + 64 * k); }
#pragma unroll
            for (int p = 0; p < 2; ++p) { const int row = 64 * p + (tid >> 3); float ss = 0.f;
#pragma unroll
                for (int k = 0; k < 4; ++k)
#pragma unroll
                    for (int e = 0; e < 4; ++e) { const float a = bflo(raw[p][k][e]), c = bfhi(raw[p][k][e]); ss += a * a + c * c; }
                ss = XSUM_SWZ(ss, 1); ss = XSUM_SWZ(ss, 2); ss = XSUM_SWZ(ss, 4);
                const float rq = rsqrtf(ss * (1.0f / 256.0f) + EPS);
                LAS unsigned char* qdst = Qb + (row >> 5) * 16384 + (row & 31) * 512;
#pragma unroll
                for (int k = 0; k < 4; ++k) { const int piece = sub + 8 * k; const f32x4 g0 = *(const f32x4*)(gq + 8 * piece), g1 = *(const f32x4*)(gq + 8 * piece + 4); u32x4 w;
                    w.x = cvtpk(bflo(raw[p][k].x) * rq * g0[0], bfhi(raw[p][k].x) * rq * g0[1]); w.y = cvtpk(bflo(raw[p][k].y) * rq * g0[2], bfhi(raw[p][k].y) * rq * g0[3]);
                    w.z = cvtpk(bflo(raw[p][k].z) * rq * g1[0], bfhi(raw[p][k].z) * rq * g1[1]); w.w = cvtpk(bflo(raw[p][k].w) * rq * g1[2], bfhi(raw[p][k].w) * rq * g1[3]);
                    *(LAS u32x4*)(qdst + ((piece ^ (row & 15)) << 4)) = w; } }
        }
        const LAS unsigned char* Qg = Qb + (wid & 3) * 16384 + r * 512;
        f32x16 o[8];
#pragma unroll
        for (int db = 0; db < 8; ++db) o[db] = f32x16{};
        float l = 0.f;
        const int krow_ = tid >> 3, ksub_ = tid & 7;
        const bf16* kp_ = K2 + (size_t)(b * MEML + krow_) * 1024 + head * 256 + 8 * ksub_;
        const bf16* vp_ = V2T + (size_t)(head * 256 + (tid >> 3)) * 512 + b * MEML + 8 * (tid & 7);
        for (int mt = 0; mt < 4; ++mt) {
            if (mt > 0) __syncthreads();
            if (MODE != 2) {   u32x4 kraw[4], vraw[4];
#pragma unroll
                for (int k = 0; k < 4; ++k) { kraw[k] = *(const u32x4*)(kp_ + (size_t)(64 * mt) * 1024 + 64 * k); vraw[k] = *(const u32x4*)(vp_ + (size_t)(64 * k) * 512 + 64 * mt); }
#pragma unroll
                for (int k = 0; k < 4; ++k) { const int piece = ksub_ + 8 * k; *(LAS u32x4*)(Kb + krow_ * 512 + ((piece ^ (krow_ & 15)) << 4)) = kraw[k]; }
#pragma unroll
                for (int k = 0; k < 4; ++k) { const int row = (tid >> 3) + 64 * k, piece = tid & 7;
                    *(LAS u32x4*)(Vb + row * 128 + ((piece ^ ((row >> 1) & 7)) << 4)) = vraw[k]; }
            }
            __syncthreads();
            if (MODE == 1) continue;
            bf16x8 pk[2];
            {   const int krow = 32 * dh + pi32(r); f32x16 S = {};
#pragma unroll 4
                for (int d0 = 0; d0 < 16; ++d0) { const int piece = 2 * d0 + hh;
                    const bf16x8 kf = *(const LAS bf16x8*)(Kb + krow * 512 + ((piece ^ (krow & 15)) << 4));
                    const bf16x8 qfr = *(const LAS bf16x8*)(Qg + ((piece ^ (r & 15)) << 4));
                    S = MFMA32(kf, qfr, S); }
#pragma unroll
                for (int i = 0; i < 16; ++i) { const float p = __builtin_amdgcn_exp2f(S[i] - M2); S[i] = p; l += p; }
                pk[0] = packf(S, 0); pk[1] = packf(S, 1); }
#pragma unroll
            for (int db = 0; db < 8; ++db) { const int vrow = 32 * db + r;
#pragma unroll
                for (int s2 = 0; s2 < 2; ++s2) { const int piece = 2 * (2 * dh + s2) + hh;
                    const bf16x8 vf = *(const LAS bf16x8*)(Vb + vrow * 128 + ((piece ^ ((vrow >> 1) & 7)) << 4));
                    o[db] = MFMA32(vf, pk[s2], o[db]); }
                if (db & 1) asm volatile("" ::: "memory"); }
        }
        l = xsum32(l);
        if (MODE != 0) { if (l + o[0][0] + o[7][7] == 123.456f) O2[0] = 0; continue; }
        __syncthreads();
        LAS float* xch = (LAS float*)(lds + (wid & 3) * 32768) + lane;
        if (dh == 1) {
#pragma unroll
            for (int db = 0; db < 8; ++db) {
#pragma unroll
                for (int i = 0; i < 16; ++i) xch[(db * 16 + i) * 64] = o[db][i];
                asm volatile("" ::: "memory"); }
            ((LAS float*)(lds + 131072))[(wid & 3) * 64 + lane] = l;
        }
        __syncthreads();
        if (dh == 0) {
            const float inv = 1.0f / (l + ((LAS float*)(lds + 131072))[(wid & 3) * 64 + lane]);
#pragma unroll
            for (int db = 0; db < 8; ++db) {
#pragma unroll
                for (int i = 0; i < 16; ++i) o[db][i] = (o[db][i] + xch[(db * 16 + i) * 64]) * inv;
                asm volatile("" ::: "memory"); }
            LAS unsigned char* stg = lds + (wid & 3) * 32768;
#pragma unroll
            for (int db = 0; db < 8; ++db)
#pragma unroll
                for (int g = 0; g < 4; ++g) {
                    u32x2 w; w.x = cvtpk(o[db][4 * g], o[db][4 * g + 1]); w.y = cvtpk(o[db][4 * g + 2], o[db][4 * g + 3]);
                    otile_put<32>(stg, r, hh, 4 * db + g, w); }
            otile_flush<32>(stg, O2 + (tokb + 32 * (wid & 3)) * 1024 + head * 256, 1024, lane);
        }
    }
    __syncthreads();
}

#define XB_TMO      128
#define XB_XCNT(j)  (256  + 64 * (j))
#define XB_XSUB(j)  (1280 + 64 * (j))
#define XB_XGEN(j)  (2304 + 64 * (j))
#define XB_TOP      3328
#define XB_TOPGEN   3392
#define XCD_BAR_WORDS 3456
#define XB_SPIN_CAP (1u << 18)

__device__ __forceinline__ unsigned xb_ld(unsigned* p)              { return __hip_atomic_load(p, __ATOMIC_RELAXED, __HIP_MEMORY_SCOPE_AGENT); }
__device__ __forceinline__ unsigned xb_add(unsigned* p, unsigned v) { return __hip_atomic_fetch_add(p, v, __ATOMIC_RELAXED, __HIP_MEMORY_SCOPE_AGENT); }
__device__ __forceinline__ unsigned xb_xcc_id() { return (unsigned)__builtin_amdgcn_s_getreg((3 << 11) | 20) & 0xFu; }
#define XB_SPIN(cond, bar) do { unsigned _sp = 0; while (cond) { __builtin_amdgcn_s_sleep(1); \
    if ((++_sp & 255u) == 0u) { if (xb_ld(&(bar)[XB_TMO])) break; if (_sp > XB_SPIN_CAP) { atomicAdd(&(bar)[XB_TMO], 1u); break; } } } } while (0)

struct XcdBarrier {
    unsigned* bar; unsigned x;
    volatile LAS unsigned* st;
};

__device__ __forceinline__ XcdBarrier xcd_barrier_post(unsigned* bar, volatile LAS unsigned* st, int wid_s) {
    XcdBarrier b; b.bar = bar; b.x = xb_xcc_id(); b.st = st;
    if (wid_s == 0 && lane_id_asm() == 0) (void)xb_add(&bar[XB_XCNT(b.x)], 1u);
    return b;
}
__device__ __forceinline__ void xcd_barrier_complete(unsigned* bar, unsigned x, unsigned& nloc, unsigned& nx) {
    const unsigned G = gridDim.x * gridDim.y * gridDim.z;
    unsigned sum, cnt, mine, sp = 0u;
    for (;;) {
        sum = 0u; cnt = 0u; mine = 0u;
#pragma unroll
        for (unsigned j = 0; j < 16; ++j) { const unsigned c = xb_ld(&bar[XB_XCNT(j)]); sum += c; cnt += (c > 0u) ? 1u : 0u; mine = (j == x) ? c : mine; }
        if (sum == G) break;
        __builtin_amdgcn_s_sleep(1);
        if ((++sp & 255u) == 0u) { if (xb_ld(&bar[XB_TMO])) break; if (sp > XB_SPIN_CAP) { atomicAdd(&bar[XB_TMO], 1u); break; } }
    }
    nloc = mine > 0u ? mine : 1u; nx = cnt > 0u ? cnt : 1u;
}

__device__ __forceinline__ void xcd_barrier(const XcdBarrier& b, int wid_s) {
    asm volatile("s_waitcnt vmcnt(0)" ::: "memory");
    __syncthreads();
    if (wid_s == 0 && lane_id_asm() == 0) {
        unsigned* bar = b.bar;
        __builtin_amdgcn_s_waitcnt(0);
        unsigned nloc = b.st[0], nx = b.st[1];
        if (nloc == 0u) { xcd_barrier_complete(bar, b.x, nloc, nx); b.st[0] = nloc; b.st[1] = nx; }
        const unsigned old = xb_add(&bar[XB_XSUB(b.x)], 1u);
        const unsigned gen = old / nloc;
        if (old + 1u == (gen + 1u) * nloc) {
            __builtin_amdgcn_fence(__ATOMIC_RELEASE, "agent");
            asm volatile("s_waitcnt vmcnt(0)" ::: "memory");
            const unsigned og = xb_add(&bar[XB_TOP], 1u);
            const unsigned tg = og / nx;
            if (og + 1u == (tg + 1u) * nx) xb_add(&bar[XB_TOPGEN], 1u);
            else XB_SPIN(xb_ld(&bar[XB_TOPGEN]) == tg, bar);
            __builtin_amdgcn_fence(__ATOMIC_ACQUIRE, "agent");
            xb_add(&bar[XB_XGEN(b.x)], 1u);
            asm volatile("s_waitcnt vmcnt(0)" ::: "memory");
        } else {
            XB_SPIN(xb_ld(&bar[XB_XGEN(b.x)]) == gen, bar);
            __builtin_amdgcn_fence(__ATOMIC_ACQUIRE, "agent");
            asm volatile("s_waitcnt vmcnt(0)" ::: "memory");
        }
    }
    __syncthreads();
}

__global__ void __launch_bounds__(512) hymba_fwd(Params P) {
    extern __shared__ __attribute__((aligned(16))) unsigned char lds_raw[];
    LAS unsigned char* lds = (LAS unsigned char*)lds_raw;
    cg::grid_group grid = cg::this_grid();
    unsigned char* ws = P.ws;
    const int G = gridDim.x, c = blockIdx.x;
    float* SSQ1 = (float*)(ws + WS_SSQ1); float* SSQ2 = (float*)(ws + WS_SSQ2); const float* RSTD1 = (const float*)(ws + WS_RSTD1); const float* RSTDM = (const float*)(ws + WS_RSTDM);
    bf16* XB = (bf16*)(ws + WS_XB); bf16* PROJ = (bf16*)(ws + WS_PROJ); bf16* TR = (bf16*)(ws + WS_TR); bf16* MIX = (bf16*)(ws + WS_MIX);
    bf16* Q2 = (bf16*)(ws + WS_PROJ); bf16* O2 = (bf16*)(ws + WS_PROJ + 32 * MiB); bf16* ACT = (bf16*)(ws + WS_TR);

    volatile LAS unsigned* st = (volatile LAS unsigned*)(lds + 135168);
    unsigned* barw = (unsigned*)(ws + WS_BAR);
    const int wid_s = __builtin_amdgcn_readfirstlane(threadIdx.x >> 6);
    if (wid_s == 0 && lane_id_asm() < 2) st[lane_id_asm()] = 0u;
    __syncthreads();
    const XcdBarrier xb = xcd_barrier_post(barw, st, wid_s);
#ifndef NO_P0
    p0_prologue(P, lds, wid_s);
#endif
#ifdef REP_P0
    p0_prologue(P, lds, wid_s);
#endif
    if (P.use_cg) grid.sync();
    xcd_barrier(xb, wid_s);
#ifdef REP_G1
    for (int rep_ = 0; rep_ < 2; ++rep_) {
#else
    {
#endif
    {   pg8::Gemm g{XB, (const bf16*)(ws + WS_WN), NTOK, 2560, DM}; pg8::StaticOrder S; S.init(NTOK, 2560, G, c);
        pg8::EpiG1 E{PROJ, RSTD1, (const float*)(ws + WS_CS), P.in[4], P.in[5], 0.125f * LOG2E};
        pg8::gemm_phase<pg8::EpiG1, pg8::StaticOrder, true, true>(lds, g, S, E, wid_s); }
    {   pg8::Gemm g{(const bf16*)(ws + WS_WTR), XB, 1536, NTOK, DM}; pg8::StaticOrder S; S.init(1536, NTOK, G, (c + G / 2) % G);
        pg8::EpiTR E{TR, RSTD1, (const float*)(ws + WS_CS)};
        pg8::gemm_phase<pg8::EpiTR, pg8::StaticOrder, true, true>(lds, g, S, E, wid_s); }
    }
    xcd_barrier(xb, wid_s);
#ifndef NO_RETKV
    ret_kv_phase(P, wid_s);
#endif
#ifdef REP_RETKV
    ret_kv_phase(P, wid_s);
#endif
#ifndef NO_DIFF
    diff_phase(P, lds, wid_s);
#endif
#ifdef REP_DIFF
    diff_phase(P, lds, wid_s);
#endif
#ifdef REP_DIFF_SKEL
    diff_probe_phase<1>(P, lds, wid_s);
#endif
#ifdef REP_DIFF_COMP
    diff_probe_phase<2>(P, lds, wid_s);
#endif
    xcd_barrier(xb, wid_s);
    ret_scan_phase(P, wid_s);

    kv2_phase(P, wid_s);
    xcd_barrier(xb, wid_s);
#ifdef REP_SYNC
    for (int rep_ = 0; rep_ < 20; ++rep_) xcd_barrier(xb, wid_s);
#endif
#ifndef NO_RETOUT
    ret_out_phase(P, lds, wid_s);
#endif
    knorm_phase(P, wid_s);
#ifdef REP_RETOUT
    ret_out_phase(P, lds, wid_s);
#endif
#ifdef REP_RETOUT_NOST
    ret_out_phase<1>(P, lds, wid_s);
#endif
    xcd_barrier(xb, wid_s);
    {   pg8::Gemm g{MIX, (const bf16*)(ws + WS_WOUT), NTOK, DM, DM}; pg8::StaticOrder S; S.init(NTOK, DM, G, c);
        pg8::EpiResid<true> E{P.in[0], P.out, XB, SSQ1};
        pg8::gemm_phase<pg8::EpiResid<true>, pg8::StaticOrder, true, true>(lds, g, S, E, wid_s); }
#ifdef REP_G2
    {   pg8::Gemm g{MIX, (const bf16*)(ws + WS_WOUT), NTOK, DM, DM}; pg8::StaticOrder S; S.init(NTOK, DM, G, c);
        pg8::EpiResid<false> E{P.in[0], (float*)(ws + WS_PROJ), nullptr, nullptr};
        pg8::gemm_phase<pg8::EpiResid<false>, pg8::StaticOrder, true, true>(lds, g, S, E, wid_s); }
#endif
    xcd_barrier(xb, wid_s);
#ifdef REP_G3
    for (int rep_ = 0; rep_ < 2; ++rep_) {
#else
    {
#endif
    {   pg8::Gemm g{XB, (const bf16*)(ws + WS_XQ), NTOK, DM, DM}; pg8::StaticOrder S; S.init(NTOK, DM, G, c);
        pg8::EpiRowScale<true> E{Q2, 1024, SSQ1};
        pg8::gemm_phase<pg8::EpiRowScale<true>, pg8::StaticOrder, true, true>(lds, g, S, E, wid_s); }
    }
    xcd_barrier(xb, wid_s);
#ifndef NO_XATTN
    xattn_phase(P, lds, wid_s);
#endif
#ifdef REP_XATTN
    xattn_phase(P, lds, wid_s);
#endif
#ifdef REP_XATTN_SKEL
    xattn_phase<1>(P, lds, wid_s);
#endif
#ifdef REP_XATTN_COMP
    xattn_phase<2>(P, lds, wid_s);
#endif
    xcd_barrier(xb, wid_s);
    {   pg8::Gemm g{O2, (const bf16*)(ws + WS_XO), NTOK, DM, DM}; pg8::StaticOrder S; S.init(NTOK, DM, G, c);
#ifdef REP_G4
    {   pg8::Gemm g2{O2, (const bf16*)(ws + WS_XO), NTOK, DM, DM}; pg8::StaticOrder S2; S2.init(NTOK, DM, G, c);
        pg8::EpiResid<false> E2{P.out, (float*)(ws + WS_TR), nullptr, nullptr};
        pg8::gemm_phase<pg8::EpiResid<false>, pg8::StaticOrder, true, true>(lds, g2, S2, E2, wid_s); }
#endif
        pg8::EpiResid<true> E{P.out, P.out, XB, SSQ2};
        pg8::gemm_phase<pg8::EpiResid<true>, pg8::StaticOrder, true, true>(lds, g, S, E, wid_s); }
    xcd_barrier(xb, wid_s);
#ifdef REP_G5
    for (int rep_ = 0; rep_ < 2; ++rep_) {
#else
    {
#endif
    {   pg8::Gemm g{XB, (const bf16*)(ws + WS_WGU), NTOK, 2 * FFH, DM}; pg8::StaticOrder S; S.init(NTOK, 2 * FFH, G, c);
        pg8::EpiSwiglu E{ACT, SSQ2};
        pg8::gemm_phase<pg8::EpiSwiglu, pg8::StaticOrder, true, true>(lds, g, S, E, wid_s); }
    }
    xcd_barrier(xb, wid_s);
    {   pg8::Gemm g{ACT, (const bf16*)(ws + WS_WD), NTOK, DM, FFH}; pg8::StaticOrder S; S.init(NTOK, DM, G, c);
#ifdef REP_G6
    {   pg8::Gemm g2{ACT, (const bf16*)(ws + WS_WD), NTOK, DM, FFH}; pg8::StaticOrder S2; S2.init(NTOK, DM, G, c);
        pg8::EpiResid<false> E2{P.out, (float*)(ws + WS_PROJ), nullptr, nullptr};
        pg8::gemm_phase<pg8::EpiResid<false>, pg8::StaticOrder, true, true>(lds, g2, S2, E2, wid_s); }
#endif
        pg8::EpiResidF E{P.out, P.out};
        pg8::gemm_phase<pg8::EpiResidF, pg8::StaticOrder, true, true>(lds, g, S, E, wid_s); }
}

extern "C" void kernel_launch(void* const* d_in, const int* in_sizes, int n_in, void* d_out, int out_size, void* d_ws, size_t ws_size, hipStream_t stream) {
    static int grid = 0;
    if (grid == 0) {
        if (n_in != 21 || out_size != NTOK * DM || ws_size < WS_END) { fprintf(stderr, "kernel_launch: unexpected shapes (n_in %d, out %d, ws %zu)\n", n_in, out_size, ws_size); grid = -1; return; }
        int dev = 0, cus = 0, per_cu = 0;
        (void)hipGetDevice(&dev); (void)hipDeviceGetAttribute(&cus, hipDeviceAttributeMultiprocessorCount, dev);
        if (hipFuncSetAttribute((const void*)hymba_fwd, hipFuncAttributeMaxDynamicSharedMemorySize, LDS_BYTES) != hipSuccess) { fprintf(stderr, "kernel_launch: hipFuncSetAttribute failed\n"); grid = -1; return; }
        if (hipOccupancyMaxActiveBlocksPerMultiprocessor(&per_cu, (const void*)hymba_fwd, 512, LDS_BYTES) != hipSuccess || per_cu < 1) { fprintf(stderr, "kernel_launch: occupancy query failed (%d)\n", per_cu); (void)hipGetLastError(); per_cu = 1; }
        grid = cus * (per_cu > 1 ? 1 : per_cu);
        if (grid > 256) grid = 256;
    }
    if (grid < 0) return;
    if (hipMemsetAsync((char*)d_ws + WS_BAR, 0, 65536, stream) != hipSuccess) { fprintf(stderr, "kernel_launch: memset of the barrier words failed\n"); return; }
    Params p{};
    for (int i = 0; i < 21; ++i) p.in[i] = (const float*)d_in[i];
    p.out = (float*)d_out; p.ws = (unsigned char*)d_ws;
    void* args[] = {&p};
    hipError_t e = hipLaunchCooperativeKernel((const void*)hymba_fwd, dim3(grid), dim3(512), args, LDS_BYTES, stream);
    if (e != hipSuccess) fprintf(stderr, "cooperative launch failed: %s (grid %d)\n", hipGetErrorString(e), grid);
}
```

```cpp
#include <hip/hip_runtime.h>
#include <hip/hip_cooperative_groups.h>
#include <cstdio>
#include <cstdint>
namespace cg = cooperative_groups;
#define XSUM_SWZ(v, m) ((v) + __uint_as_float((unsigned)__builtin_amdgcn_ds_swizzle((int)__float_as_uint(v), ((m) << 10) | 0x1f)))
#define XMAX_SWZ(v, m) fmaxf((v), __uint_as_float((unsigned)__builtin_amdgcn_ds_swizzle((int)__float_as_uint(v), ((m) << 10) | 0x1f)))
__device__ __forceinline__ float xsum32(float v) { auto rr = __builtin_amdgcn_permlane32_swap(__float_as_uint(v), __float_as_uint(v), false, false); return __uint_as_float(rr[0]) + __uint_as_float(rr[1]); }
__device__ __forceinline__ float xmax32(float v) { auto rr = __builtin_amdgcn_permlane32_swap(__float_as_uint(v), __float_as_uint(v), false, false); return fmaxf(__uint_as_float(rr[0]), __uint_as_float(rr[1])); }
__device__ __forceinline__ float xsum16(float v) { return XSUM_SWZ(v, 16); }
__device__ __forceinline__ int lane_id_asm() { int l; asm volatile("v_mbcnt_lo_u32_b32 %0, -1, 0\n\tv_mbcnt_hi_u32_b32 %0, -1, %0" : "=v"(l)); return l; }
namespace pg8 {
#define PG8_LAS __attribute__((address_space(3)))
typedef unsigned short bf16_t;
typedef short bf16x8 __attribute__((ext_vector_type(8)));
typedef float f32x4 __attribute__((ext_vector_type(4)));
typedef unsigned u32x4 __attribute__((ext_vector_type(4)));
constexpr int BM = 256, BK = 64, HALF = 128, HTB = HALF * BK * 2  , STAGE_BYTES = 8 * HTB, NXCD = 8, WGM = 8;

__host__ __device__ __forceinline__ int lds_byte(int r, int c) { const int st = (r >> 4) * 2 + (c >> 5), rr = r & 15, cc = c & 31, ob = rr * 64 + cc * 2; return st * 1024 + (ob ^ (((ob >> 9) & 1) << 5)); }
__host__ __device__ __forceinline__ void stage_rc(int b, int& R, int& C) { const int st = b / 1024, sb = b % 1024, swz = sb ^ (((sb >> 9) & 1) << 5); R = (st >> 1) * 16 + swz / 64; C = (st & 1) * 32 + (swz % 64) / 2; }
__host__ __device__ __forceinline__ int perm32(int rho) { const int n = rho >> 4, i = rho & 15; return 8 * (i >> 2) + 4 * n + (i & 3); }

struct Unit { int pm, pn; };
struct Gemm { const bf16_t* A; const bf16_t* Bt; int M, N, K; };

struct StaticOrder {
    int nM, nN, nwg, G, c;
    __host__ __device__ void init(int M, int N, int G_, int c_) { nM = M / BM; nN = N / BM; nwg = nM * nN; G = G_; c = c_; }
    __host__ __device__ bool next(int i, Unit& u) const {
        const long L = (long)i * G + c; if (L >= nwg) return false;
        int wgid = (int)L; { const int q = nwg / NXCD, r = nwg % NXCD, xcd = wgid % NXCD, off = wgid / NXCD; wgid = (xcd < r ? xcd * (q + 1) : r * (q + 1) + (xcd - r) * q) + off; }
        const int nig = WGM * nN, gid = wgid / nig, fm = gid * WGM, gsz = (nM - fm) < WGM ? (nM - fm) : WGM;
        u.pm = fm + ((wgid % nig) % gsz); u.pn = (wgid % nig) / gsz; return true;
    }
    __device__ __forceinline__ void a_ready(const Unit&) const {}
    __device__ __forceinline__ void done(const Unit&) const {}
};

__device__ __forceinline__ unsigned cvt_pk_bf16(float lo, float hi) { unsigned r; asm volatile("v_cvt_pk_bf16_f32 %0, %1, %2" : "=v"(r) : "v"(lo), "v"(hi)); return r; }
typedef float f32x2 __attribute__((ext_vector_type(2)));
typedef unsigned u32x2 __attribute__((ext_vector_type(2)));
constexpr float EPS_RMS = 1e-6f;
__device__ __forceinline__ u32x4 pack8(const float (&v)[8]) { u32x4 w; w.x = cvt_pk_bf16(v[0], v[1]); w.y = cvt_pk_bf16(v[2], v[3]); w.z = cvt_pk_bf16(v[4], v[5]); w.w = cvt_pk_bf16(v[6], v[7]); return w; }
__device__ __forceinline__ float silu_f(float v) { return v * __builtin_amdgcn_rcpf(1.0f + __builtin_amdgcn_exp2f(v * -1.4426950408889634f)); }

struct EpiG1 {
    static constexpr bool PERM = true, AFTER_DRAIN = false;
    bf16_t* O; const float* rstd; const float* cs; const float* gq; const float* gk; float c2;
    __device__ __forceinline__ void operator()(const f32x4 (&acc)[2][2][4][2], const Unit& u, int wr, int wc, int fr, int fq) const {
        const int pn = u.pn; const int row0 = u.pm * BM + wr * 64 + fr;
        if (pn < 4) {
            const float sc = pn >= 2 ? 0.125f : 1.0f;
#pragma unroll
            for (int ai = 0; ai < 2; ++ai)
#pragma unroll
                for (int m = 0; m < 4; ++m) { const int row = row0 + ai * HALF + m * 16; const float f = rstd[row] * sc;
                    const f32x4* c4 = (const f32x4*)(cs + ((size_t)(row & 8191) * 32 + 8 * fq) * 2);
                    float o1[8], o2[8];
#pragma unroll
                    for (int k = 0; k < 4; ++k) { const f32x4 c = c4[k];
#pragma unroll
                        for (int z = 0; z < 2; ++z) { const int i8 = 2 * k + z; const float co = z ? c[2] : c[0], si = z ? c[3] : c[1];
                            const float x1 = acc[ai][0][m][i8 >> 2][i8 & 3], x2 = acc[ai][1][m][i8 >> 2][i8 & 3];
                            o1[i8] = (x1 * co - x2 * si) * f; o2[i8] = (x2 * co + x1 * si) * f; } }
                    bf16_t* p = O + (size_t)row * 2560 + pn * 256 + wc * 64 + 8 * fq;
                    *(u32x4*)p = pack8(o1); *(u32x4*)(p + 32) = pack8(o2); }
        } else if (pn < 6) {
#pragma unroll
            for (int ai = 0; ai < 2; ++ai)
#pragma unroll
                for (int m = 0; m < 4; ++m) { const int row = row0 + ai * HALF + m * 16; const float f = rstd[row];
#pragma unroll
                    for (int bj = 0; bj < 2; ++bj) { float v[8];
#pragma unroll
                        for (int i8 = 0; i8 < 8; ++i8) v[i8] = silu_f(acc[ai][bj][m][i8 >> 2][i8 & 3] * f);
                        *(u32x4*)(O + (size_t)row * 2560 + pn * 256 + bj * HALF + wc * 32 + 8 * fq) = pack8(v); } }
        } else {
            const float* g = pn < 8 ? gq : gk; const float sc = pn < 8 ? c2 : 1.0f;
            float gv[2][8];
#pragma unroll
            for (int bj = 0; bj < 2; ++bj)
#pragma unroll
                for (int i8 = 0; i8 < 8; ++i8) gv[bj][i8] = g[32 * bj + 8 * fq + i8] * sc;
#pragma unroll
            for (int ai = 0; ai < 2; ++ai)
#pragma unroll
                for (int m = 0; m < 4; ++m) { const int row = row0 + ai * HALF + m * 16; const float f = rstd[row];
                    float ss = 0.f;
#pragma unroll
                    for (int bj = 0; bj < 2; ++bj)
#pragma unroll
                        for (int i8 = 0; i8 < 8; ++i8) { const float v = acc[ai][bj][m][i8 >> 2][i8 & 3] * f; ss += v * v; }
                    ss = xsum16(ss); ss = xsum32(ss);
                    const float rr = f * rsqrtf(ss * (1.0f / 64.0f) + EPS_RMS);
#pragma unroll
                    for (int bj = 0; bj < 2; ++bj) { float v[8];
#pragma unroll
                        for (int i8 = 0; i8 < 8; ++i8) v[i8] = acc[ai][bj][m][i8 >> 2][i8 & 3] * rr * gv[bj][i8];
                        *(u32x4*)(O + (size_t)row * 2560 + pn * 256 + wc * 64 + bj * 32 + 8 * fq) = pack8(v); } }
        }
    }
};

struct EpiTR {
    static constexpr bool PERM = true, AFTER_DRAIN = false;
    bf16_t* O; const float* rstd; const float* cs;
    __device__ __forceinline__ void operator()(const f32x4 (&acc)[2][2][4][2], const Unit& u, int wr, int wc, int fr, int fq) const {
        const int pm = u.pm; const int col0 = u.pn * BM + wc * 32 + 8 * fq;
        float rs[2][8];
#pragma unroll
        for (int bj = 0; bj < 2; ++bj) { const f32x4 a = *(const f32x4*)(rstd + col0 + bj * HALF), b = *(const f32x4*)(rstd + col0 + bj * HALF + 4);
            rs[bj][0] = a[0]; rs[bj][1] = a[1]; rs[bj][2] = a[2]; rs[bj][3] = a[3]; rs[bj][4] = b[0]; rs[bj][5] = b[1]; rs[bj][6] = b[2]; rs[bj][7] = b[3]; }
        if (pm < 2) {
#pragma unroll
            for (int m = 0; m < 4; ++m) { const int hl = 2 * wr + (m >> 1), i = 16 * (m & 1) + fr, head = 4 * pm + hl;
                const float l2g = log1pf(-exp2f(-5.0f - (float)head)) * 1.4426950408889634f;
                const int rown = pm * 256 + 64 * hl + i;
#pragma unroll
                for (int bj = 0; bj < 2; ++bj) { float o1[8], o2[8];
#pragma unroll
                    for (int i8 = 0; i8 < 8; ++i8) { const int col = col0 + bj * HALF + i8; const int pos = col & 8191;
                        const float2 c = *(const float2*)(cs + ((size_t)pos * 32 + i) * 2);
                        const float f = rs[bj][i8] * 0.125f * __builtin_amdgcn_exp2f(l2g * (float)(127 - (col & 127)));
                        const float x1 = acc[0][bj][m][i8 >> 2][i8 & 3], x2 = acc[1][bj][m][i8 >> 2][i8 & 3];
                        o1[i8] = (x1 * c.x - x2 * c.y) * f; o2[i8] = (x2 * c.x + x1 * c.y) * f; }
                    *(u32x4*)(O + (size_t)rown * 16384 + col0 + bj * HALF) = pack8(o1);
                    *(u32x4*)(O + (size_t)(rown + 32) * 16384 + col0 + bj * HALF) = pack8(o2); } }
        } else {
#pragma unroll
            for (int ai = 0; ai < 2; ++ai)
#pragma unroll
                for (int m = 0; m < 4; ++m) { const int row = pm * BM + ai * HALF + wr * 64 + m * 16 + fr;
#pragma unroll
                    for (int bj = 0; bj < 2; ++bj) { float v[8];
#pragma unroll
                        for (int i8 = 0; i8 < 8; ++i8) v[i8] = acc[ai][bj][m][i8 >> 2][i8 & 3] * rs[bj][i8];
                        *(u32x4*)(O + (size_t)row * 16384 + col0 + bj * HALF) = pack8(v); } }
        }
    }
};

template <bool SSQ> struct EpiRowScale {
    static constexpr bool PERM = true, AFTER_DRAIN = false;
    bf16_t* O; int ldc; const float* rs;
    __device__ __forceinline__ void operator()(const f32x4 (&acc)[2][2][4][2], const Unit& u, int wr, int wc, int fr, int fq) const {
        const int row0 = u.pm * BM + wr * 64 + fr, col0 = u.pn * BM + wc * 32 + 8 * fq;
#pragma unroll
        for (int ai = 0; ai < 2; ++ai)
#pragma unroll
            for (int m = 0; m < 4; ++m) { const int row = row0 + ai * HALF + m * 16; float f = rs[row]; if (SSQ) f = rsqrtf(f * (1.0f / 1024.0f) + EPS_RMS);
#pragma unroll
                for (int bj = 0; bj < 2; ++bj) { float v[8];
#pragma unroll
                    for (int i8 = 0; i8 < 8; ++i8) v[i8] = acc[ai][bj][m][i8 >> 2][i8 & 3] * f;
                    *(u32x4*)(O + (size_t)row * ldc + col0 + bj * HALF) = pack8(v); } }
    }
};
struct EpiColScale {
    static constexpr bool PERM = true, AFTER_DRAIN = false;
    bf16_t* O; int ldc; const float* rs;
    __device__ __forceinline__ void operator()(const f32x4 (&acc)[2][2][4][2], const Unit& u, int wr, int wc, int fr, int fq) const {
        const int row0 = u.pm * BM + wr * 64 + fr, col0 = u.pn * BM + wc * 32 + 8 * fq;
        float rsv[2][8];
#pragma unroll
        for (int bj = 0; bj < 2; ++bj)
#pragma unroll
            for (int i8 = 0; i8 < 8; ++i8) rsv[bj][i8] = rs[col0 + bj * HALF + i8];
#pragma unroll
        for (int ai = 0; ai < 2; ++ai)
#pragma unroll
            for (int m = 0; m < 4; ++m) { const int row = row0 + ai * HALF + m * 16;
#pragma unroll
                for (int bj = 0; bj < 2; ++bj) { float v[8];
#pragma unroll
                    for (int i8 = 0; i8 < 8; ++i8) v[i8] = acc[ai][bj][m][i8 >> 2][i8 & 3] * rsv[bj][i8];
                    *(u32x4*)(O + (size_t)row * ldc + col0 + bj * HALF) = pack8(v); } }
    }
};
template <bool AUX> struct EpiResid {
    static constexpr bool PERM = true, AFTER_DRAIN = false;
    const float* base; float* out; bf16_t* xb; float* ssq;
    __device__ __forceinline__ void operator()(const f32x4 (&acc)[2][2][4][2], const Unit& u, int wr, int wc, int fr, int fq) const {
        const int row0 = u.pm * BM + wr * 64 + fr, col0 = u.pn * BM + wc * 32 + 8 * fq;
#pragma unroll
        for (int ai = 0; ai < 2; ++ai) {
            f32x4 bv[4][2][2];
#pragma unroll
            for (int m = 0; m < 4; ++m)
#pragma unroll
                for (int bj = 0; bj < 2; ++bj) { const size_t off = (size_t)(row0 + ai * HALF + m * 16) * 1024 + col0 + bj * HALF;
                    bv[m][bj][0] = __builtin_nontemporal_load((const f32x4*)(base + off)); bv[m][bj][1] = __builtin_nontemporal_load((const f32x4*)(base + off + 4)); }
#pragma unroll
            for (int m = 0; m < 4; ++m) { const int row = row0 + ai * HALF + m * 16; float ss = 0.f;
#pragma unroll
                for (int bj = 0; bj < 2; ++bj) { const size_t off = (size_t)row * 1024 + col0 + bj * HALF;
                    const f32x4 v0 = bv[m][bj][0] + acc[ai][bj][m][0], v1 = bv[m][bj][1] + acc[ai][bj][m][1];
                    *(f32x4*)(out + off) = v0; *(f32x4*)(out + off + 4) = v1;
                    if (AUX) { u32x4 w; w.x = cvt_pk_bf16(v0[0], v0[1]); w.y = cvt_pk_bf16(v0[2], v0[3]); w.z = cvt_pk_bf16(v1[0], v1[1]); w.w = cvt_pk_bf16(v1[2], v1[3]);
                        *(u32x4*)(xb + off) = w;
                        ss += (v0[0] * v0[0] + v0[1] * v0[1]) + (v0[2] * v0[2] + v0[3] * v0[3]) + (v1[0] * v1[0] + v1[1] * v1[1]) + (v1[2] * v1[2] + v1[3] * v1[3]); } }
                if (AUX) { ss = xsum16(ss); ss = xsum32(ss); if (fq == 0) atomicAdd(ssq + row, ss); } }
        }
    }
};
struct EpiResidF {
    static constexpr bool PERM = false, AFTER_DRAIN = false;
    const float* base; float* out;
    __device__ __forceinline__ void operator()(const f32x4 (&acc)[2][2][4][2], const Unit& u, int wr, int wc, int fr, int fq) const {
        const int row0 = u.pm * BM + wr * 64 + fr, col0 = u.pn * BM + wc * 32 + 4 * fq;
#pragma unroll
        for (int ai = 0; ai < 2; ++ai) {
            f32x4 bv[4][2][2];
#pragma unroll
            for (int m = 0; m < 4; ++m)
#pragma unroll
                for (int bj = 0; bj < 2; ++bj) { const size_t off = (size_t)(row0 + ai * HALF + m * 16) * 1024 + col0 + bj * HALF;
                    bv[m][bj][0] = __builtin_nontemporal_load((const f32x4*)(base + off)); bv[m][bj][1] = __builtin_nontemporal_load((const f32x4*)(base + off + 16)); }
#pragma unroll
            for (int m = 0; m < 4; ++m)
#pragma unroll
                for (int bj = 0; bj < 2; ++bj) { const size_t off = (size_t)(row0 + ai * HALF + m * 16) * 1024 + col0 + bj * HALF;
                    __builtin_nontemporal_store(bv[m][bj][0] + acc[ai][bj][m][0], (f32x4*)(out + off)); __builtin_nontemporal_store(bv[m][bj][1] + acc[ai][bj][m][1], (f32x4*)(out + off + 16)); }
        }
    }
};
struct EpiSwiglu {
    static constexpr bool PERM = true, AFTER_DRAIN = false;
    bf16_t* O; const float* ssq;
    __device__ __forceinline__ void operator()(const f32x4 (&acc)[2][2][4][2], const Unit& u, int wr, int wc, int fr, int fq) const {
        const int row0 = u.pm * BM + wr * 64 + fr, col0 = u.pn * HALF + wc * 32 + 8 * fq;
#pragma unroll
        for (int ai = 0; ai < 2; ++ai)
#pragma unroll
            for (int m = 0; m < 4; ++m) { const int row = row0 + ai * HALF + m * 16; const float f = rsqrtf(ssq[row] * (1.0f / 1024.0f) + EPS_RMS);
                float v[8];
#pragma unroll
                for (int i8 = 0; i8 < 8; ++i8) v[i8] = silu_f(acc[ai][0][m][i8 >> 2][i8 & 3] * f) * (acc[ai][1][m][i8 >> 2][i8 & 3] * f);
                *(u32x4*)(O + (size_t)row * 2816 + col0) = pack8(v); }
    }
};
template <class Epi, class Sched, bool ALIGN_EPI = false, bool SP2 = false>
__device__ __forceinline__ void gemm_phase(PG8_LAS unsigned char* lds, const Gemm g, const Sched& S, const Epi& E, int wid_s) {
    const int lane = lane_id_asm(), wid = wid_s, tid = wid * 64 + lane, wr = wid >> 2, wc = wid & 3, fr = lane & 15, fq = lane >> 4;
    const int K = g.K, nt = K / BK;
    unsigned voffA[2], voffB[2];
#pragma unroll
    for (int i = 0; i < 2; ++i) { int R, C; stage_rc(tid * 16 + i * 8192, R, C); const int Rb = Epi::PERM ? ((R & ~31) + perm32(R & 31)) : R;
        voffA[i] = (unsigned)(R * K + C) * 2u; voffB[i] = (unsigned)(Rb * K + C) * 2u; }
    const size_t kstep = (size_t)(BK * 2);
    const size_t hstep = (size_t)HALF * K * 2;
    const size_t tstep = 2 * hstep;
    const unsigned ldsw = (unsigned)wid * 1024u;
    const int aoff = lds_byte(wr * 64 + fr, fq * 8), boff = lds_byte(wc * 32 + fr, fq * 8);
#define PG8_SA(b, h) (((b) * 2 + (h)) * HTB)
#define PG8_SB(b, h) ((4 + (b) * 2 + (h)) * HTB)
#define PG8_STAGE(bufoff, gbase, voff) do { _Pragma("unroll") for (int _i = 0; _i < 2; ++_i) \
        __builtin_amdgcn_global_load_lds((const unsigned*)((const char*)(gbase) + (voff)[_i]), (PG8_LAS unsigned*)(lds + (bufoff) + ldsw + _i * 8192), 16, 0, 0); } while (0)
#define PG8_LDA(dst, b, h) do { _Pragma("unroll") for (int m = 0; m < 4; ++m) _Pragma("unroll") for (int k = 0; k < 2; ++k) dst[m][k] = *(const PG8_LAS bf16x8*)(lds + PG8_SA(b, h) + aoff + m * 2048 + k * 1024); } while (0)
#define PG8_LDB(dst, b, h) do { _Pragma("unroll") for (int n = 0; n < 2; ++n) _Pragma("unroll") for (int k = 0; k < 2; ++k) dst[n][k] = *(const PG8_LAS bf16x8*)(lds + PG8_SB(b, h) + boff + n * 2048 + k * 1024); } while (0)
#define PG8_MMA(ai, bj, At, Bt) do { __builtin_amdgcn_s_setprio(1); _Pragma("unroll") for (int m = 0; m < 4; ++m) _Pragma("unroll") for (int n = 0; n < 2; ++n) _Pragma("unroll") for (int k = 0; k < 2; ++k) \
        acc[ai][bj][m][n] = __builtin_amdgcn_mfma_f32_16x16x32_bf16(Bt[n][k], At[m][k], acc[ai][bj][m][n], 0, 0, 0); __builtin_amdgcn_s_setprio(0); } while (0)
#define PG8_WAIT_V(n) asm volatile("s_waitcnt vmcnt(" #n ")" ::: "memory")
#define PG8_WAIT_L(n) asm volatile("s_waitcnt lgkmcnt(" #n ")" ::: "memory")
#define PG8_BAR __builtin_amdgcn_s_barrier()
#define PG8_SCHED __builtin_amdgcn_sched_barrier(0)
    Unit cur, nxt; int ui = 0;
    if (!S.next(0, cur)) return;
    f32x4 acc[2][2][4][2];
#pragma unroll
    for (int a = 0; a < 2; ++a)
#pragma unroll
        for (int b = 0; b < 2; ++b)
#pragma unroll
            for (int m = 0; m < 4; ++m)
#pragma unroll
                for (int n = 0; n < 2; ++n) acc[a][b][m][n] = (f32x4){0.f, 0.f, 0.f, 0.f};
    bf16x8 At[4][2], B0[2][2], B1[2][2];
    const char* cA = (const char*)g.A + (size_t)cur.pm * tstep; const char* cB = (const char*)g.Bt + (size_t)cur.pn * tstep;
    S.a_ready(cur);
    if constexpr (SP2) {
        PG8_STAGE(PG8_SB(0, 0), cB, voffB); PG8_STAGE(PG8_SB(0, 1), cB + hstep, voffB); PG8_STAGE(PG8_SA(0, 0), cA, voffA); PG8_STAGE(PG8_SA(0, 1), cA + hstep, voffA);
        if (wr == 1) PG8_BAR;
        PG8_WAIT_V(2); PG8_BAR;
        PG8_STAGE(PG8_SB(1, 0), cB + kstep, voffB); PG8_STAGE(PG8_SA(1, 0), cA + kstep, voffA); PG8_STAGE(PG8_SB(1, 1), cB + hstep + kstep, voffB);
        PG8_WAIT_V(6); PG8_BAR;
    } else {
        PG8_STAGE(PG8_SB(0, 0), cB, voffB); PG8_STAGE(PG8_SA(0, 0), cA, voffA); PG8_STAGE(PG8_SB(0, 1), cB + hstep, voffB); PG8_STAGE(PG8_SA(0, 1), cA + hstep, voffA);
        if (wr == 1) PG8_BAR;
        PG8_WAIT_V(4); PG8_BAR;
        PG8_STAGE(PG8_SB(1, 0), cB + kstep, voffB); PG8_STAGE(PG8_SA(1, 0), cA + kstep, voffA); PG8_STAGE(PG8_SB(1, 1), cB + hstep + kstep, voffB);
        PG8_WAIT_V(6); PG8_BAR;
    }
    for (;;) {
        const bool has_next = S.next(ui + 1, nxt);
        const char* nA = has_next ? (const char*)g.A + (size_t)nxt.pm * tstep : cA; const char* nB = has_next ? (const char*)g.Bt + (size_t)nxt.pn * tstep : cB;
        for (int t = 0; t < nt; t += 2) {
            const bool last = (t == nt - 2);
            const char* a1 = cA + (size_t)(t + 1) * kstep;
            const char* a2 = last ? nA : cA + (size_t)(t + 2) * kstep; const char* b2 = last ? nB : cB + (size_t)(t + 2) * kstep;
            const char* a3 = a2 + kstep; const char* b3 = b2 + kstep;
            if (last && has_next) S.a_ready(nxt);
            if constexpr (SP2) {
            PG8_LDB(B0, 0, 0); PG8_LDB(B1, 0, 1); PG8_SCHED; PG8_LDA(At, 0, 0); PG8_STAGE(PG8_SA(1, 1), a1 + hstep, voffA);
            PG8_WAIT_V(8); PG8_WAIT_L(0); PG8_BAR; PG8_MMA(0, 0, At, B0); PG8_MMA(0, 1, At, B1); PG8_BAR; PG8_SCHED;
            PG8_LDA(At, 0, 1); PG8_STAGE(PG8_SB(0, 0), b2, voffB); PG8_STAGE(PG8_SB(0, 1), b2 + hstep, voffB); PG8_STAGE(PG8_SA(0, 0), a2, voffA);
            PG8_WAIT_V(8); PG8_WAIT_L(0); PG8_BAR; PG8_MMA(1, 0, At, B0); PG8_MMA(1, 1, At, B1); PG8_BAR; PG8_SCHED;
            PG8_LDB(B0, 1, 0); PG8_LDB(B1, 1, 1); PG8_SCHED; PG8_LDA(At, 1, 0); PG8_STAGE(PG8_SA(0, 1), a2 + hstep, voffA);
            PG8_WAIT_V(8); PG8_WAIT_L(0); PG8_BAR; PG8_MMA(0, 0, At, B0); PG8_MMA(0, 1, At, B1); PG8_BAR; PG8_SCHED;
            PG8_LDA(At, 1, 1); PG8_STAGE(PG8_SB(1, 0), b3, voffB); PG8_STAGE(PG8_SB(1, 1), b3 + hstep, voffB); PG8_STAGE(PG8_SA(1, 0), a3, voffA);
            PG8_WAIT_V(8); PG8_WAIT_L(0); PG8_BAR; PG8_MMA(1, 0, At, B0); PG8_MMA(1, 1, At, B1); PG8_BAR; PG8_SCHED;
            } else {
            PG8_LDB(B0, 0, 0); PG8_SCHED; PG8_LDA(At, 0, 0); PG8_STAGE(PG8_SA(1, 1), a1 + hstep, voffA);
            PG8_WAIT_L(8); PG8_BAR; PG8_WAIT_L(0); PG8_MMA(0, 0, At, B0); PG8_BAR; PG8_SCHED;
            PG8_LDB(B1, 0, 1); PG8_STAGE(PG8_SB(0, 0), b2, voffB);
            PG8_BAR; PG8_WAIT_L(0); PG8_MMA(0, 1, At, B1); PG8_BAR;
            PG8_LDA(At, 0, 1); PG8_STAGE(PG8_SA(0, 0), a2, voffA);
            PG8_BAR; PG8_WAIT_L(0); PG8_MMA(1, 0, At, B0); PG8_BAR; PG8_SCHED;
            PG8_STAGE(PG8_SB(0, 1), b2 + hstep, voffB);
            PG8_WAIT_V(6); PG8_BAR; PG8_MMA(1, 1, At, B1); PG8_BAR;
            PG8_LDB(B0, 1, 0); PG8_SCHED; PG8_LDA(At, 1, 0); PG8_STAGE(PG8_SA(0, 1), a2 + hstep, voffA);
            PG8_WAIT_L(8); PG8_BAR; PG8_WAIT_L(0); PG8_MMA(0, 0, At, B0); PG8_BAR; PG8_SCHED;
            PG8_LDB(B1, 1, 1); PG8_STAGE(PG8_SB(1, 0), b3, voffB);
            PG8_BAR; PG8_WAIT_L(0); PG8_MMA(0, 1, At, B1); PG8_BAR;
            PG8_LDA(At, 1, 1); PG8_STAGE(PG8_SA(1, 0), a3, voffA);
            PG8_BAR; PG8_WAIT_L(0); PG8_MMA(1, 0, At, B0); PG8_BAR; PG8_SCHED;
            PG8_STAGE(PG8_SB(1, 1), b3 + hstep, voffB);
            PG8_WAIT_V(6); PG8_BAR; PG8_MMA(1, 1, At, B1); PG8_BAR;
            }
        }
        if constexpr (ALIGN_EPI) { if (wr == 0) PG8_BAR; }
        if constexpr (!Epi::AFTER_DRAIN) { E(acc, cur, wr, wc, fr, fq); S.done(cur); }
        if (!has_next) break;
#pragma unroll
        for (int a = 0; a < 2; ++a)
#pragma unroll
            for (int b = 0; b < 2; ++b)
#pragma unroll
                for (int m = 0; m < 4; ++m)
#pragma unroll
                    for (int n = 0; n < 2; ++n) acc[a][b][m][n] = (f32x4){0.f, 0.f, 0.f, 0.f};
        cur = nxt; cA = nA; cB = nB; ++ui;
        if constexpr (ALIGN_EPI) { if (wr == 1) PG8_BAR; }
    }
    PG8_WAIT_V(0);
    if constexpr (!ALIGN_EPI) { if (wr == 0) PG8_BAR; }
    PG8_BAR;
    if constexpr (Epi::AFTER_DRAIN) { E.fused(acc, cur, wr, wc, fr, fq, lds, wid, lane); S.done(cur); }
#undef PG8_SA
#undef PG8_SB
#undef PG8_STAGE
#undef PG8_LDA
#undef PG8_LDB
#undef PG8_MMA
#undef PG8_WAIT_V
#undef PG8_WAIT_L
#undef PG8_BAR
#undef PG8_SCHED
}
}

#define LAS __attribute__((address_space(3)))
typedef unsigned short bf16;
typedef short bf16x8 __attribute__((ext_vector_type(8)));
typedef float f32x4 __attribute__((ext_vector_type(4)));
typedef float f32x16 __attribute__((ext_vector_type(16)));
typedef unsigned u32x4 __attribute__((ext_vector_type(4)));
typedef unsigned u32x2 __attribute__((ext_vector_type(2)));
typedef float f32x2_t __attribute__((ext_vector_type(2)));
typedef __bf16 bf16x2_t __attribute__((ext_vector_type(2)));
#define MFMA32(a, b, c) __builtin_amdgcn_mfma_f32_32x32x16_bf16((a), (b), (c), 0, 0, 0)
__device__ __forceinline__ unsigned cvtpk(float lo, float hi) { f32x2_t v = {lo, hi}; bf16x2_t b = __builtin_convertvector(v, bf16x2_t); return __builtin_bit_cast(unsigned, b); }
__device__ __forceinline__ float bflo(unsigned w) { return __uint_as_float(w << 16); }
__device__ __forceinline__ float bfhi(unsigned w) { return __uint_as_float(w & 0xffff0000u); }
__device__ __forceinline__ int crow(int i, int hh) { return (i & 3) + 8 * (i >> 2) + 4 * hh; }
__device__ __forceinline__ int pi32(int r) { return (r & ~12) | ((r & 4) << 1) | ((r & 8) >> 1); }
__device__ __forceinline__ bf16x8 packf(const f32x16& s, int half) {
    u32x4 w;
    if (half == 0) { w.x = cvtpk(s[0], s[1]); w.y = cvtpk(s[2], s[3]); w.z = cvtpk(s[4], s[5]); w.w = cvtpk(s[6], s[7]); }
    else { w.x = cvtpk(s[8], s[9]); w.y = cvtpk(s[10], s[11]); w.z = cvtpk(s[12], s[13]); w.w = cvtpk(s[14], s[15]); }
    return __builtin_bit_cast(bf16x8, w);
}
__device__ __forceinline__ float wave_sum(float v) { v = XSUM_SWZ(v, 1); v = XSUM_SWZ(v, 2); v = XSUM_SWZ(v, 4); v = XSUM_SWZ(v, 8); v = XSUM_SWZ(v, 16); return xsum32(v); }
__device__ __forceinline__ float wave_max(float v) { v = XMAX_SWZ(v, 1); v = XMAX_SWZ(v, 2); v = XMAX_SWZ(v, 4); v = XMAX_SWZ(v, 8); v = XMAX_SWZ(v, 16); return xmax32(v); }
__device__ __forceinline__ void glds16(const void* g, LAS unsigned char* l) { __builtin_amdgcn_global_load_lds((const unsigned*)g, (LAS unsigned*)l, 16, 0, 0); }

constexpr int NTOK = 16384, SEQ = 8192, DM = 1024, FFH = 2816, MEML = 256;
constexpr float EPS = 1e-6f;
constexpr float LOG2E = 1.4426950408889634f;
constexpr size_t MiB = 1u << 20;
constexpr size_t WS_SSQ1 = 0, WS_SSQ2 = 65536, WS_RSTD1 = 131072, WS_RSTDM = 196608;
constexpr size_t WS_CS = 1 * MiB;
constexpr size_t WS_WN = 3 * MiB;
constexpr size_t WS_WTR = 8 * MiB;
constexpr size_t WS_WOUT = 11 * MiB, WS_XQ = 13 * MiB, WS_XKV = 15 * MiB, WS_XO = 19 * MiB;
constexpr size_t WS_WGU = 21 * MiB;
constexpr size_t WS_WD = 32 * MiB;
constexpr size_t WS_XB = 38 * MiB;
constexpr size_t WS_PROJ = 70 * MiB;
constexpr size_t WS_TR = 150 * MiB;
constexpr size_t WS_MIX = 198 * MiB;
constexpr size_t WS_KVS = 230 * MiB;
constexpr size_t WS_K2 = 246 * MiB, WS_V2T = 247 * MiB, WS_MEMB = 248 * MiB, WS_PARTL = 249 * MiB;
constexpr size_t WS_BAR = 250 * MiB;
constexpr size_t WS_END = 256 * MiB;
constexpr int LDS_BYTES = 147456;

struct Params { const float* in[21]; float* out; unsigned char* ws; int use_cg; int pad; };

template <int NCH> __device__ __forceinline__ void otile_put(LAS unsigned char* stg, int r, int hh, int chunk, u32x2 w) { *(LAS u32x2*)(stg + r * (NCH * 16) + ((chunk ^ (r & (NCH - 1))) << 4) + hh * 8) = w; }
template <int NCH> __device__ __forceinline__ void otile_flush(const LAS unsigned char* stg, bf16* g, int ld, int lane_) {
    int lane = lane_; asm volatile("" : "+v"(lane));
#pragma unroll
    for (int i = 0; i < NCH / 2; ++i) { const int row = i * (64 / NCH) + lane / NCH, chunk = lane % NCH;
        const u32x4 v = *(const LAS u32x4*)(stg + row * (NCH * 16) + ((chunk ^ (row & (NCH - 1))) << 4));
        *(u32x4*)(g + (size_t)row * ld + chunk * 8) = v; }
}

__device__ __forceinline__ int rperm32(int c) { return 256 * (c >> 8) + 128 * ((c & 63) >> 5) + 32 * ((c & 255) >> 6); }
struct TrDesc { const float* W; const float* gain; bf16* D0; bf16* D1; int K, N, d0, d1, item; };
__device__ __forceinline__ void tr_load(const TrDesc& t, float (&wv)[32], int lane) {
    const int nblk = t.N / 32, kb = t.item / nblk, nb = t.item % nblk, k0 = 64 * kb, n0 = 32 * nb;
#pragma unroll
    for (int i = 0; i < 32; ++i) { const int kk = 2 * i + (lane >> 5); wv[i] = __builtin_nontemporal_load(t.W + (size_t)(k0 + kk) * t.N + n0 + (lane & 31)); }
}
__device__ __forceinline__ void tr_store(const TrDesc& t, const float (&wv)[32], LAS float* scr, int lane) {
    const int nblk = t.N / 32, kb = t.item / nblk, k0 = 64 * kb;
#pragma unroll
    for (int i = 0; i < 32; ++i) { const int kk = 2 * i + (lane >> 5); const float g = t.gain ? t.gain[k0 + kk] : 1.0f; scr[kk * 33 + (lane & 31)] = wv[i] * g; }
    asm volatile("s_waitcnt lgkmcnt(0)" ::: "memory");
    const int c = lane & 7;
#pragma unroll
    for (int j = 0; j < 4; ++j) { const int n = (lane >> 3) + 8 * j; const LAS float* s = scr + (8 * c) * 33 + n;
        u32x4 o; o.x = cvtpk(s[0 * 33], s[1 * 33]); o.y = cvtpk(s[2 * 33], s[3 * 33]); o.z = cvtpk(s[4 * 33], s[5 * 33]); o.w = cvtpk(s[6 * 33], s[7 * 33]);
        if (t.D0) *(u32x4*)(t.D0 + (size_t)(t.d0 + n) * t.K + k0 + 8 * c) = o;
        if (t.D1) *(u32x4*)(t.D1 + (size_t)(t.d1 + n) * t.K + k0 + 8 * c) = o; }
    asm volatile("s_waitcnt lgkmcnt(0)" ::: "memory");
}
__device__ __forceinline__ TrDesc tr_decode(const Params& P, int it) {
    unsigned char* ws = P.ws; bf16* WN = (bf16*)(ws + WS_WN); bf16* WTR = (bf16*)(ws + WS_WTR);
    constexpr int I0 = 16 * 112, I1 = 512, I2 = 512, I3 = 16 * 64, I4 = 512, I5 = 16 * 88, I6 = 16 * 88;
    TrDesc t; t.D1 = nullptr; t.d1 = 0; t.K = 1024; int r = it;
    if (r < I0) { const int n0 = 32 * (r % 112), seg = n0 >> 9, wi = n0 & 511;
        t.W = P.in[3]; t.N = 3584; t.gain = P.in[2]; t.D0 = nullptr; t.d0 = 0; t.item = r;
        if (seg == 0) { t.D0 = WN; t.d0 = rperm32(wi); }
        else if (seg == 1) { t.D0 = WN; t.d0 = 512 + rperm32(wi); t.D1 = WTR; t.d1 = rperm32(wi); }
        else if (seg == 2) { t.D1 = WTR; t.d1 = 512 + wi; }
        else if (seg == 3) { t.D0 = WN; t.d0 = 1024 + wi; }
        else if (seg == 4) { t.D0 = WN; t.d0 = 1536 + rperm32(wi); }
        else if (seg == 5) { t.D0 = WN; t.d0 = 2048 + rperm32(wi); }
        else { t.D1 = WTR; t.d1 = 1024 + wi; }
        return t; }
    r -= I0;
    if (r < I1) { t.W = P.in[9]; t.N = 1024; t.gain = P.in[8]; t.D0 = (bf16*)(ws + WS_WOUT); t.d0 = 32 * (r % 32); t.item = r; return t; } r -= I1;
    if (r < I2) { t.W = P.in[12]; t.N = 1024; t.gain = P.in[10]; t.D0 = (bf16*)(ws + WS_XQ); t.d0 = 32 * (r % 32); t.item = r; return t; } r -= I2;
    if (r < I3) { t.W = P.in[13]; t.N = 2048; t.gain = P.in[11]; t.D0 = (bf16*)(ws + WS_XKV); t.d0 = 32 * (r % 64); t.item = r; return t; } r -= I3;
    if (r < I4) { t.W = P.in[16]; t.N = 1024; t.gain = nullptr; t.D0 = (bf16*)(ws + WS_XO); t.d0 = 32 * (r % 32); t.item = r; return t; } r -= I4;
    if (r < I5) { const int n0 = 32 * (r % 88); t.W = P.in[18]; t.N = 2816; t.gain = P.in[17]; t.D0 = (bf16*)(ws + WS_WGU); t.d0 = (n0 >> 7) * 256 + (n0 & 127); t.item = r; return t; } r -= I5;
    if (r < I6) { const int n0 = 32 * (r % 88); t.W = P.in[19]; t.N = 2816; t.gain = P.in[17]; t.D0 = (bf16*)(ws + WS_WGU); t.d0 = (n0 >> 7) * 256 + 128 + (n0 & 127); t.item = r; return t; } r -= I6;
    t.W = P.in[20]; t.K = 2816; t.N = 1024; t.gain = nullptr; t.D0 = (bf16*)(ws + WS_WD); t.d0 = 32 * (r % 32); t.item = r; return t;
}
template <int NR> __device__ __forceinline__ void rows_to_bf16(const float* x, bf16* o, float* rstd_out, int m0, int mstride, int lane) {
    f32x4 v[NR][4]; float s[NR];
#pragma unroll
    for (int q = 0; q < NR; ++q) { const f32x4* xr = (const f32x4*)(x + (size_t)(m0 + q * mstride) * DM) + lane;
#pragma unroll
        for (int j = 0; j < 4; ++j) v[q][j] = __builtin_nontemporal_load(xr + 64 * j); }
#pragma unroll
    for (int q = 0; q < NR; ++q) { float a = 0.f;
#pragma unroll
        for (int j = 0; j < 4; ++j) a += (v[q][j][0] * v[q][j][0] + v[q][j][1] * v[q][j][1]) + (v[q][j][2] * v[q][j][2] + v[q][j][3] * v[q][j][3]);
        s[q] = wave_sum(a); }
#pragma unroll
    for (int q = 0; q < NR; ++q) { u32x2* o8 = (u32x2*)(o + (size_t)(m0 + q * mstride) * DM) + lane;
#pragma unroll
        for (int j = 0; j < 4; ++j) { u32x2 w; w.x = cvtpk(v[q][j][0], v[q][j][1]); w.y = cvtpk(v[q][j][2], v[q][j][3]); o8[64 * j] = w; }
        if (lane == 0) rstd_out[m0 + q * mstride] = rsqrtf(s[q] * (1.0f / 1024.0f) + EPS); }
}
__device__ __forceinline__ void p0_prologue(const Params& P, LAS unsigned char* lds, int wid_s) {
    const int lane = lane_id_asm(), wid = wid_s, tid = wid * 64 + lane;
    const int gw = blockIdx.x * 8 + wid, NGW = gridDim.x * 8;
    unsigned char* ws = P.ws;
    LAS float* scr = (LAS float*)(lds + wid * 16384);
    constexpr int NIT = 16 * 112 + 512 + 512 + 16 * 64 + 512 + 16 * 88 + 16 * 88 + 44 * 32;
    if (gw < NIT) {
        int it = gw; TrDesc cur = tr_decode(P, it); float a[32]; tr_load(cur, a, lane);
        for (;;) {
            const int nx = it + NGW; const bool has = nx < NIT; TrDesc nxt = cur; float bnx[32];
            if (has) { nxt = tr_decode(P, nx); tr_load(nxt, bnx, lane); }
            tr_store(cur, a, scr, lane);
            if (!has) break;
            cur = nxt; it = nx;
#pragma unroll
            for (int i = 0; i < 32; ++i) a[i] = bnx[i];
        }
    }
    {   int m = gw;
        for (; m + 3 * NGW < NTOK; m += 4 * NGW) rows_to_bf16<4>(P.in[0], (bf16*)(ws + WS_XB), (float*)(ws + WS_RSTD1), m, NGW, lane);
        for (; m < NTOK; m += NGW) rows_to_bf16<1>(P.in[0], (bf16*)(ws + WS_XB), (float*)(ws + WS_RSTD1), m, NGW, lane); }
    for (int m = gw; m < 2 * MEML; m += NGW) rows_to_bf16<1>(P.in[1], (bf16*)(ws + WS_MEMB), (float*)(ws + WS_RSTDM), m, NGW, lane);
    const int gt = blockIdx.x * 512 + tid, NGT = gridDim.x * 512;
    for (int e = gt; e < SEQ * 32; e += NGT) {
        const int pos = e >> 5, i = e & 31;
        const float inv = 1.0f / exp2f((float)i * (1.0f / 31.0f) * 13.287712379549449f);
        const float ang = (float)pos * inv;
        double t = (double)ang * 0.15915494309189535; t -= floor(t);
        const float tf = (float)t;
        float2 v; v.x = __builtin_amdgcn_cosf(tf); v.y = __builtin_amdgcn_sinf(tf);
        ((float2*)(ws + WS_CS))[e] = v;
    }
    for (int e = gt; e < NTOK; e += NGT) { ((float*)(ws + WS_SSQ1))[e] = 0.f; ((float*)(ws + WS_SSQ2))[e] = 0.f; }
}

__device__ __forceinline__ float ret_l2g(int h) { return log1pf(-exp2f(-5.0f - (float)h)) * LOG2E; }
__device__ __forceinline__ void ret_kv_phase(const Params& P, int wid_s) {
    const int lane = lane_id_asm(), wid = wid_s, tid = wid * 64 + lane, r = lane & 31, hh = lane >> 5;
    const bf16* TR = (const bf16*)(P.ws + WS_TR); float* KVS = (float*)(P.ws + WS_KVS);
    for (int pair = blockIdx.x; pair < 512; pair += gridDim.x) {
        const int chunk = pair * 2 + (wid >> 2), j = wid & 3, bh = chunk >> 6, n = chunk & 63, b = bh >> 3, h = bh & 7, a = j >> 1, bb = j & 1;
        const size_t tok0 = (size_t)b * SEQ + n * 128;
        const bf16* vt = TR + (size_t)(512 + h * 64 + 32 * a + r) * NTOK + tok0 + 8 * hh;
        const bf16* kt = TR + (size_t)(h * 64 + 32 * bb + r) * NTOK + tok0 + 8 * hh;
        f32x16 acc = {};
#pragma unroll
        for (int s = 0; s < 8; ++s) acc = MFMA32(*(const bf16x8*)(vt + 16 * s), *(const bf16x8*)(kt + 16 * s), acc);
        float* dst = KVS + (size_t)chunk * 4096 + (32 * a) * 64 + 32 * bb + r;
#pragma unroll
        for (int i = 0; i < 16; ++i) dst[crow(i, hh) * 64] = acc[i];
    }
}
__device__ __forceinline__ void ret_scan_phase(const Params& P, int wid_s) {
    float* KVS = (float*)(P.ws + WS_KVS);
    if (wid_s >= 4) return;
    for (int e = blockIdx.x * 256 + wid_s * 64 + lane_id_asm(); e < 16 * 4096; e += gridDim.x * 256) {
        const int bh = e >> 12, el = e & 4095, h = bh & 7;
        const float gC = exp2f(128.0f * ret_l2g(h));
        unsigned idx = (unsigned)(bh * 64 * 4096 + el); float R = 0.f;
        for (int n0 = 0; n0 < 64; n0 += 16) { float t[16];
#pragma unroll
            for (int k = 0; k < 16; ++k) t[k] = __builtin_nontemporal_load(KVS + idx + (unsigned)(k * 4096));
#pragma unroll
            for (int k = 0; k < 16; ++k) { KVS[idx + (unsigned)(k * 4096)] = R; R = R * gC + t[k]; }
            idx += 16 * 4096; }
    }
}
template <int MODE = 0> __device__ __forceinline__ void ret_out_phase(const Params& P, LAS unsigned char* lds, int wid_s) {
    const int lane = lane_id_asm(), wid = wid_s, r = lane & 31, hh = lane >> 5;
    const bf16* PROJ = (const bf16*)(P.ws + WS_PROJ); const bf16* TR = (const bf16*)(P.ws + WS_TR); const float* KVS = (const float*)(P.ws + WS_KVS); bf16* MIX = (bf16*)(P.ws + WS_MIX);
    const int cg = wid >> 2, j = wid & 3, tl = j * 64 + lane;
    LAS unsigned char* base = lds + cg * 65536;
    for (int pair = blockIdx.x; pair < 512; pair += gridDim.x) {
        const int chunk = pair * 2 + cg, bh = chunk >> 6, n = chunk & 63, b = bh >> 3, h = bh & 7;
        const size_t tok0 = (size_t)b * SEQ + n * 128; const int c0 = 32 * j;
        const float l2g = ret_l2g(h);
        __syncthreads();
        {   u32x4 t0_[4], t1_[4], t2_[4], t3_[4];
#pragma unroll
            for (int k = 0; k < 4; ++k) { const int idx = tl + 256 * k, row = idx >> 3, piece = idx & 7; const bf16* src = PROJ + (tok0 + row) * 2560 + h * 64 + piece * 8;
                t0_[k] = __builtin_nontemporal_load((const u32x4*)(src)); t1_[k] = __builtin_nontemporal_load((const u32x4*)(src + 512)); t2_[k] = __builtin_nontemporal_load((const u32x4*)(src + 1024));
                const int vrow = idx >> 4, vpiece = idx & 15; t3_[k] = __builtin_nontemporal_load((const u32x4*)(TR + (size_t)(512 + h * 64 + vrow) * NTOK + tok0 + vpiece * 8)); }
#pragma unroll
            for (int k = 0; k < 4; ++k) { const int idx = tl + 256 * k, row = idx >> 3, piece = idx & 7; const int off = row * 128 + ((piece ^ ((row >> 1) & 7)) << 4);
                *(LAS u32x4*)(base + off) = t0_[k]; *(LAS u32x4*)(base + 16384 + off) = t1_[k]; *(LAS u32x4*)(base + 32768 + off) = t2_[k];
                const int vrow = idx >> 4, vpiece = idx & 15; *(LAS u32x4*)(base + 49152 + vrow * 256 + ((vpiece ^ (vrow & 15)) << 4)) = t3_[k]; }
        }
        __syncthreads();
        bf16x8 qf[4];
        { const int row = c0 + r;
#pragma unroll
          for (int d0 = 0; d0 < 4; ++d0) qf[d0] = *(const LAS bf16x8*)(base + row * 128 + (((2 * d0 + hh) ^ ((row >> 1) & 7)) << 4)); }
        f32x16 o[2]; o[0] = f32x16{}; o[1] = f32x16{};
        for (int jb = 0; jb <= j; ++jb) {
            const int krow = 32 * jb + pi32(r);
            f32x16 S = {};
#pragma unroll
            for (int d0 = 0; d0 < 4; ++d0) S = MFMA32(*(const LAS bf16x8*)(base + 16384 + krow * 128 + (((2 * d0 + hh) ^ ((krow >> 1) & 7)) << 4)), qf[d0], S);
#pragma unroll
            for (int i = 0; i < 16; ++i) { const int kvi = 32 * jb + 16 * (i >> 3) + 8 * hh + (i & 7); const int rel = (c0 + r) - kvi;
                S[i] = rel >= 0 ? S[i] * __builtin_amdgcn_exp2f(l2g * (float)rel) : 0.f; }
            const bf16x8 pk0 = packf(S, 0), pk1 = packf(S, 1);
#pragma unroll
            for (int a = 0; a < 2; ++a) { const int vrow = 32 * a + r;
                o[a] = MFMA32(*(const LAS bf16x8*)(base + 49152 + vrow * 256 + (((4 * jb + hh) ^ (vrow & 15)) << 4)), pk0, o[a]);
                o[a] = MFMA32(*(const LAS bf16x8*)(base + 49152 + vrow * 256 + (((4 * jb + 2 + hh) ^ (vrow & 15)) << 4)), pk1, o[a]); }
        }
        const float xi = exp2f(l2g * (float)(c0 + r + 1));
#pragma unroll
        for (int a = 0; a < 2; ++a) { f32x16 t = {}; const float* rp = KVS + (size_t)chunk * 4096 + (32 * a + r) * 64 + 8 * hh;
#pragma unroll
            for (int d0 = 0; d0 < 4; ++d0) { const f32x4 lo = __builtin_nontemporal_load((const f32x4*)(rp + 16 * d0)), hi4 = __builtin_nontemporal_load((const f32x4*)(rp + 16 * d0 + 4));
                u32x4 w; w.x = cvtpk(lo[0], lo[1]); w.y = cvtpk(lo[2], lo[3]); w.z = cvtpk(hi4[0], hi4[1]); w.w = cvtpk(hi4[2], hi4[3]);
                t = MFMA32(__builtin_bit_cast(bf16x8, w), qf[d0], t); }
#pragma unroll
            for (int i = 0; i < 16; ++i) o[a][i] += t[i] * xi; }
        float ss = 0.f;
#pragma unroll
        for (int a = 0; a < 2; ++a)
#pragma unroll
            for (int i = 0; i < 16; ++i) ss += o[a][i] * o[a][i];
        ss = xsum32(ss);
        const float rr = rsqrtf(ss * (1.0f / 64.0f) + EPS);
        LAS unsigned char* stg = base + c0 * 128;
        { const int row = c0 + r;
#pragma unroll
          for (int a = 0; a < 2; ++a)
#pragma unroll
              for (int g = 0; g < 4; ++g) {
                  const u32x2 gw = *(const LAS u32x2*)(base + 32768 + row * 128 + (((4 * a + g) ^ ((row >> 1) & 7)) << 4) + hh * 8);
                  u32x2 w; w.x = cvtpk(o[a][4 * g] * rr * bflo(gw.x), o[a][4 * g + 1] * rr * bfhi(gw.x)); w.y = cvtpk(o[a][4 * g + 2] * rr * bflo(gw.y), o[a][4 * g + 3] * rr * bfhi(gw.y));
                  otile_put<8>(stg, r, hh, 4 * a + g, w); } }
        otile_flush<8>(stg, MIX + (tok0 + c0) * 1024 + h * 64, 1024, lane);
    }
    __syncthreads();
}

struct DiffCtx { const bf16* PROJ; const bf16* TR; bf16* MIX; float* partO0; float* partO1; float* partL0; float* partL1; unsigned* flags; const float* subln; float lam; float shift; };
__device__ __forceinline__ void diff_epilogue(f32x16 (&o)[4], const DiffCtx& C, size_t tokw, int h, int lane, LAS unsigned char* stg) {
    const int r = lane & 31, hh = lane >> 5;
    float ss = 0.f;
#pragma unroll
    for (int db = 0; db < 4; ++db)
#pragma unroll
        for (int i = 0; i < 16; ++i) ss += o[db][i] * o[db][i];
    ss = xsum32(ss);
    const float rr = rsqrtf(ss * (1.0f / 128.0f) + EPS) * 0.8f;
#pragma unroll
    for (int db = 0; db < 4; ++db)
#pragma unroll
        for (int g = 0; g < 4; ++g) { const int d = 32 * db + 8 * g + 4 * hh; const f32x4 sg = *(const f32x4*)(C.subln + d);
            u32x2 w; w.x = cvtpk(o[db][4 * g] * rr * sg[0], o[db][4 * g + 1] * rr * sg[1]); w.y = cvtpk(o[db][4 * g + 2] * rr * sg[2], o[db][4 * g + 3] * rr * sg[3]);
            otile_put<16>(stg, r, hh, 4 * db + g, w); }
    otile_flush<16>(stg, C.MIX + tokw * 1024 + 512 + h * 128, 1024, lane);
}
template <bool SHIFT, int MODE = 0> __device__ __forceinline__ void diff_segment(const DiffCtx& C, LAS unsigned char* lds, int b, int h, int qb, int t0, int t1, int outmode, int unitidx, int wid_s) {
    const int lane = lane_id_asm(), wid = wid_s, r = lane & 31, hh = lane >> 5;
    const int q0 = 256 * qb + 32 * wid; const size_t tokbase = (size_t)b * SEQ;
    bf16x8 qf[2][4];
    { const bf16* qp = C.PROJ + (tokbase + q0 + r) * 2560 + 1536 + h * 128 + 8 * hh;
#pragma unroll
      for (int mp = 0; mp < 2; ++mp)
#pragma unroll
          for (int d0 = 0; d0 < 4; ++d0) qf[mp][d0] = *(const bf16x8*)(qp + mp * 64 + d0 * 16); }
    f32x16 o[2][4];
#pragma unroll
    for (int mp = 0; mp < 2; ++mp)
#pragma unroll
        for (int db = 0; db < 4; ++db) o[mp][db] = f32x16{};
    float l0 = 0.f, l1 = 0.f;
    unsigned kg[4], vg[4];
    const bf16* kbase = C.PROJ + tokbase * 2560 + 2048 + h * 128; const bf16* vbase = C.TR + (size_t)(1024 + h * 128) * NTOK + tokbase;
#pragma unroll
    for (int j = 0; j < 4; ++j) { const int c = wid * 4 + j, row = 4 * c + (lane >> 4), pc = (lane & 15) ^ (row & 15);
        kg[j] = (unsigned)(row * 2560 + pc * 8); vg[j] = (unsigned)(row * NTOK + pc * 8); }
#define DIFF_STAGE(t, buf) do { _Pragma("unroll") for (int j_ = 0; j_ < 4; ++j_) { \
        glds16(kbase + (size_t)(t) * 128 * 2560 + kg[j_], lds + (buf) * 65536 + (wid * 4 + j_) * 1024); \
        glds16(vbase + (size_t)(t) * 128 + vg[j_], lds + (buf) * 65536 + 32768 + (wid * 4 + j_) * 1024); } } while (0)
    DIFF_STAGE(t0, 0);
    for (int t = t0; t < t1; ++t) {
        const int buf = (t - t0) & 1;
        asm volatile("s_waitcnt vmcnt(0)" ::: "memory"); __syncthreads();
        if (t + 1 < t1) DIFF_STAGE(t + 1, buf ^ 1);
        const int k0 = 128 * t;
        if (k0 <= q0 + 31) {
            const LAS unsigned char* Kb = lds + buf * 65536; const LAS unsigned char* Vb = Kb + 32768;
            const bool needmask = (k0 + 127 > q0);
#pragma unroll
            for (int kb = 0; kb < 4; ++kb) {
                if (k0 + 32 * kb <= q0 + 31) {
                const int krow = 32 * kb + pi32(r);
                bf16x8 pk[2][2];
#pragma unroll
                for (int mp = 0; mp < 2; ++mp) {
                    f32x16 S = {};
#pragma unroll
                    for (int d0 = 0; d0 < 4; ++d0) { const int piece = mp * 8 + 2 * d0 + hh;
                        const bf16x8 kf = *(const LAS bf16x8*)(Kb + krow * 256 + ((piece ^ (krow & 15)) << 4));
                        S = MFMA32(kf, qf[mp][d0], S); }
                    float ls = 0.f;
#pragma unroll
                    for (int i = 0; i < 16; ++i) { float p = __builtin_amdgcn_exp2f(SHIFT ? S[i] - C.shift : S[i]);
                        if (needmask) { const int kv = k0 + 32 * kb + 16 * (i >> 3) + 8 * hh + (i & 7); if (kv > q0 + r) p = 0.f; }
                        S[i] = p; ls += p; }
                    if (mp == 0) l0 += ls; else l1 += ls;
                    pk[mp][0] = packf(S, 0); pk[mp][1] = packf(S, 1);
                }
#pragma unroll
                for (int db = 0; db < 4; ++db) { const int vrow = 32 * db + r;
#pragma unroll
                    for (int s2 = 0; s2 < 2; ++s2) { const int piece = 2 * (2 * kb + s2) + hh;
                        const bf16x8 vf = *(const LAS bf16x8*)(Vb + vrow * 256 + ((piece ^ (vrow & 15)) << 4));
                        o[0][db] = MFMA32(vf, pk[0][s2], o[0][db]); o[1][db] = MFMA32(vf, pk[1][s2], o[1][db]); } }
                }
            }
        }
    }
#undef DIFF_STAGE
    __syncthreads();
    l0 = xsum32(l0); l1 = xsum32(l1);
    if (outmode == 2) {
        if (wid == 0 && lane == 0) { unsigned sp = 0; while (__hip_atomic_load(C.flags + 64 * unitidx, __ATOMIC_RELAXED, __HIP_MEMORY_SCOPE_AGENT) == 0u && ++sp < (1u << 22)) __builtin_amdgcn_s_sleep(1);
            __builtin_amdgcn_fence(__ATOMIC_ACQUIRE, "agent"); asm volatile("s_waitcnt vmcnt(0)" ::: "memory"); }
        __syncthreads();
        const float* po = C.partO0 + (size_t)(unitidx * 8 + wid) * 8192 + lane;
#pragma unroll
        for (int mp = 0; mp < 2; ++mp)
#pragma unroll
            for (int db = 0; db < 4; ++db) { const float* pp = po + (mp * 4 + db) * 1024; asm volatile("" : "+v"(pp));
#pragma unroll
                for (int i = 0; i < 16; ++i) o[mp][db][i] += __builtin_nontemporal_load(pp + i * 64); }
        const float* pl = C.partL0 + (size_t)(unitidx * 8 + wid) * 128 + lane; l0 += pl[0]; l1 += pl[64];
    }
    if (outmode != 1) { const float i0 = 1.0f / l0, i1 = C.lam / l1;
#pragma unroll
        for (int db = 0; db < 4; ++db)
#pragma unroll
            for (int i = 0; i < 16; ++i) o[0][db][i] = o[0][db][i] * i0 - o[1][db][i] * i1;
        diff_epilogue(o[0], C, tokbase + q0, h, lane, lds + wid * 8192); }
    else {
        float* po = C.partO0 + (size_t)(unitidx * 8 + wid) * 8192 + lane;
#pragma unroll
        for (int mp = 0; mp < 2; ++mp)
#pragma unroll
            for (int db = 0; db < 4; ++db) { float* pp = po + (mp * 4 + db) * 1024; asm volatile("" : "+v"(pp));
#pragma unroll
                for (int i = 0; i < 16; ++i) __builtin_nontemporal_store(o[mp][db][i], pp + i * 64); }
        float* pl = C.partL0 + (size_t)(unitidx * 8 + wid) * 128 + lane; pl[0] = l0; pl[64] = l1;
    }
    asm volatile("s_waitcnt vmcnt(0)" ::: "memory");
    __syncthreads();
    if (outmode == 1 && wid == 0 && lane == 0) { __builtin_amdgcn_fence(__ATOMIC_RELEASE, "agent"); asm volatile("s_waitcnt vmcnt(0)" ::: "memory");
        (void)__hip_atomic_fetch_add(C.flags + 64 * unitidx, 1u, __ATOMIC_RELAXED, __HIP_MEMORY_SCOPE_AGENT); }
}
__device__ __forceinline__ DiffCtx diff_ctx(const Params& P) {
    const int lane = lane_id_asm();
    DiffCtx C; C.PROJ = (const bf16*)(P.ws + WS_PROJ); C.TR = (const bf16*)(P.ws + WS_TR); C.MIX = (bf16*)(P.ws + WS_MIX);
    C.partO0 = P.out; C.partO1 = (float*)(P.ws + WS_XB); C.partL0 = (float*)(P.ws + WS_PARTL); C.partL1 = (float*)(P.ws + WS_PARTL + 512 * 1024);
    C.subln = P.in[7]; C.flags = (unsigned*)(P.ws + WS_BAR + 16384);
    const float* lv = P.in[6];
    const float s01 = wave_sum(lv[lane] * lv[64 + lane]), s23 = wave_sum(lv[128 + lane] * lv[192 + lane]);
    C.lam = __uint_as_float(__builtin_amdgcn_readfirstlane(__float_as_uint(expf(s01) - expf(s23) + 0.2f)));
    const float mq = wave_max(fabsf(P.in[4][lane])), mk = wave_max(fabsf(P.in[5][lane]));
    C.shift = __uint_as_float(__builtin_amdgcn_readfirstlane(__float_as_uint(fmaxf(mq * mk * 64.0f * (0.125f * LOG2E) - 60.0f, 0.f))));
    return C;
}
__device__ __forceinline__ void diff_phase(const Params& P, LAS unsigned char* lds, int wid_s) {
    const DiffCtx C = diff_ctx(P);
    for (int pass = 0; pass < 2; ++pass)
    for (int v = blockIdx.x; v < 256; v += gridDim.x) {
        const int bh = v & 7, s = v >> 3, b = bh >> 2, h = bh & 3;
        if ((s < 16) != (pass == 0)) continue;
        const int q = s & 15, nseg = s < 16 ? 1 : 2;
        for (int sg = 0; sg < nseg; ++sg) {
            const bool small_ = (s >= 16) && sg == 0;
            const int a_qb = small_ ? q : 31 - q, a_t0 = small_ ? 0 : (s < 16 ? 0 : 33), a_t1 = small_ ? 2 * q + 2 : (s < 16 ? 33 : 64 - 2 * q), a_om = small_ ? 0 : (s < 16 ? 1 : 2), a_ui = bh * 16 + (15 - q);
            if (C.shift == 0.f) diff_segment<false>(C, lds, b, h, a_qb, a_t0, a_t1, a_om, a_ui, wid_s);
            else diff_segment<true>(C, lds, b, h, a_qb, a_t0, a_t1, a_om, a_ui, wid_s);
        }
    }
}
template <int MODE> __device__ __forceinline__ void diff_probe_phase(const Params& P, LAS unsigned char* lds, int wid_s) {
    const DiffCtx C = diff_ctx(P);
    for (int v = blockIdx.x; v < 256; v += gridDim.x) {
        const int bh = v & 7, s = v >> 3, b = bh >> 2, h = bh & 3;
        const int q = s & 15, nseg = s < 16 ? 1 : 2;
        for (int sg = 0; sg < nseg; ++sg) {
            const bool small_ = sg == 1;
            const int a_qb = small_ ? q : 31 - q, a_t0 = small_ ? 0 : (s < 16 ? 0 : 33), a_t1 = small_ ? 2 * q + 2 : (s < 16 ? 33 : 64 - 2 * q), a_om = small_ ? 0 : (s < 16 ? 1 : 2), a_ui = bh * 16 + (15 - q);
            diff_segment<false, MODE>(C, lds, b, h, a_qb, a_t0, a_t1, a_om, a_ui, wid_s);
        }
    }
}
__device__ __forceinline__ void diff_combine_phase(const Params& P, LAS unsigned char* lds, int wid_s) {
    const DiffCtx C = diff_ctx(P);
    const int lane = lane_id_asm(), wid = wid_s, tid = wid * 64 + lane, r = lane & 31, hh = lane >> 5;
    const float* A = C.partO0; const float* B = C.partO1;
    for (int it = blockIdx.x * 8 + wid; it < 1024; it += gridDim.x * 8) {
        const int unitidx = it >> 3, w = it & 7, bh = unitidx >> 4, qb = 16 + (unitidx & 15), b = bh >> 2, h = bh & 3;
        const unsigned base = (unsigned)it * 8192u + (unsigned)lane;
        const float l0 = C.partL0[it * 128 + lane] + C.partL1[it * 128 + lane], l1 = C.partL0[it * 128 + 64 + lane] + C.partL1[it * 128 + 64 + lane];
        const float i0 = 1.0f / l0, i1 = C.lam / l1;
        float ss = 0.f;
#pragma unroll
        for (int db = 0; db < 4; ++db) { unsigned o0 = base + db * 1024, o1 = base + 4096 + db * 1024; asm volatile("" : "+v"(o0), "+v"(o1));
#pragma unroll
            for (int i = 0; i < 16; ++i) { const float v = (A[o0 + i * 64] + B[o0 + i * 64]) * i0 - (A[o1 + i * 64] + B[o1 + i * 64]) * i1; ss += v * v; } }
        ss = xsum32(ss);
        const float rr = rsqrtf(ss * (1.0f / 128.0f) + EPS) * 0.8f;
        LAS unsigned char* stg = lds + wid * 8192;
#pragma unroll
        for (int db = 0; db < 4; ++db) { unsigned o0 = base + db * 1024, o1 = base + 4096 + db * 1024; asm volatile("" : "+v"(o0), "+v"(o1));
#pragma unroll
            for (int g = 0; g < 4; ++g) { const int d = 32 * db + 8 * g + 4 * hh; const f32x4 sg = *(const f32x4*)(C.subln + d); float v[4];
#pragma unroll
                for (int e = 0; e < 4; ++e) { const int i = 4 * g + e; v[e] = ((A[o0 + i * 64] + B[o0 + i * 64]) * i0 - (A[o1 + i * 64] + B[o1 + i * 64]) * i1) * rr * sg[e]; }
                u32x2 wv; wv.x = cvtpk(v[0], v[1]); wv.y = cvtpk(v[2], v[3]); otile_put<16>(stg, r, hh, 4 * db + g, wv); } }
        otile_flush<16>(stg, C.MIX + ((size_t)b * SEQ + 256 * qb + 32 * w) * 1024 + 512 + h * 128, 1024, lane);
    }
    __syncthreads();
}

__device__ __forceinline__ void kv2_phase(const Params& P, int wid_s) {
    const int lane = lane_id_asm(), r = lane & 31, hh = lane >> 5;
    const bf16* MEMB = (const bf16*)(P.ws + WS_MEMB); const bf16* XKV = (const bf16*)(P.ws + WS_XKV); const float* RSTDM = (const float*)(P.ws + WS_RSTDM);
    bf16* K2 = (bf16*)(P.ws + WS_K2); bf16* V2T = (bf16*)(P.ws + WS_V2T);
    if (wid_s < 4) return;
    for (int blk = (wid_s - 4) * gridDim.x + blockIdx.x; blk < 1024; blk += gridDim.x * 4) {
        const bool isv = blk >= 512; const int bb = blk & 511;
        const int rb = isv ? (bb >> 4) : (bb >> 5), cb = isv ? (bb & 15) : (bb & 31);
        const bf16* ap = (isv ? XKV + (size_t)(1024 + 32 * rb + r) * 1024 : MEMB + (size_t)(32 * rb + r) * 1024) + 8 * hh;
        const bf16* bp = (isv ? MEMB + (size_t)(32 * cb + r) * 1024 : XKV + (size_t)(32 * cb + r) * 1024) + 8 * hh;
        f32x16 acc = {};
#pragma unroll 16
        for (int s = 0; s < 64; ++s) acc = MFMA32(*(const bf16x8*)(ap + 16 * s), *(const bf16x8*)(bp + 16 * s), acc);
        if (!isv) {
#pragma unroll
            for (int i = 0; i < 16; ++i) { const int m = 32 * rb + crow(i, hh); const unsigned w = cvtpk(acc[i] * RSTDM[m], 0.f);
                *(unsigned short*)(K2 + (size_t)m * 1024 + 32 * cb + r) = (unsigned short)w; }
        } else { const float rs = RSTDM[32 * cb + r];
#pragma unroll
            for (int i = 0; i < 16; ++i) { const int n = 32 * rb + crow(i, hh); const unsigned w = cvtpk(acc[i] * rs, 0.f);
                *(unsigned short*)(V2T + (size_t)n * 512 + 32 * cb + r) = (unsigned short)w; }
        }
    }
}

__device__ __forceinline__ void knorm_phase(const Params& P, int wid_s) {
    const int lane = lane_id_asm(); bf16* K2 = (bf16*)(P.ws + WS_K2); const float* gk = P.in[15];
    for (int t = blockIdx.x * 8 + wid_s; t < 2 * MEML * 4; t += gridDim.x * 8) {
        bf16* p = K2 + (size_t)(t >> 2) * 1024 + (t & 3) * 256 + 4 * lane;
        const u32x2 raw = *(const u32x2*)p; const f32x4 g = *(const f32x4*)(gk + 4 * lane);
        const float a0 = bflo(raw.x), a1 = bfhi(raw.x), a2 = bflo(raw.y), a3 = bfhi(raw.y);
        const float ss = wave_sum((a0 * a0 + a1 * a1) + (a2 * a2 + a3 * a3));
        const float rk = rsqrtf(ss * (1.0f / 256.0f) + EPS) * (0.0625f * LOG2E);
        u32x2 w; w.x = cvtpk(a0 * rk * g[0], a1 * rk * g[1]); w.y = cvtpk(a2 * rk * g[2], a3 * rk * g[3]);
        *(u32x2*)p = w;
    }
}

template <int MODE = 0> __device__ __forceinline__ void xattn_phase(const Params& P, LAS unsigned char* lds, int wid_s) {
    const int lane = lane_id_asm(), wid = wid_s, tid = wid * 64 + lane, r = lane & 31, hh = lane >> 5;
    const bf16* Q2 = (const bf16*)(P.ws + WS_PROJ); const bf16* K2 = (const bf16*)(P.ws + WS_K2); const bf16* V2T = (const bf16*)(P.ws + WS_V2T); bf16* O2 = (bf16*)(P.ws + WS_PROJ + 32 * MiB);
    const float* gq = P.in[14]; const float* gk = P.in[15];
    float mq = 0.f, mk = 0.f;
#pragma unroll
    for (int j = 0; j < 4; ++j) { mq = fmaxf(mq, fabsf(gq[lane + 64 * j])); mk = fmaxf(mk, fabsf(gk[lane + 64 * j])); }
    mq = wave_max(mq); mk = wave_max(mk);
    const float M2 = __uint_as_float(__builtin_amdgcn_readfirstlane(__float_as_uint(fmaxf(mq * mk * 256.0f * (0.0625f * LOG2E) - 60.0f, 0.f))));
    LAS unsigned char* Kb = lds; LAS unsigned char* Vb = lds + 32768; LAS unsigned char* Qb = lds + 65536;
    const int dh = wid >> 2;
    for (int item = blockIdx.x; item < 512; item += gridDim.x) {
        const int bhd = item >> 6, qblk = item & 63, b = bhd >> 2, head = bhd & 3;
        const size_t tokb = (size_t)b * SEQ + 128 * qblk; const size_t tok = tokb + 32 * (wid & 3) + r;
        __syncthreads();
        {
            const int sub = tid & 7; u32x4 raw[2][4];
#pragma unroll
            for (int p = 0; p < 2; ++p) { const bf16* qp = Q2 + (tokb + 64 * p + (tid >> 3)) * 1024 + head * 256 + 8 * sub;
#pragma unroll
                for (int k = 0; k < 4; ++k) raw[p][k] = __builtin_nontemporal_load((const u32x4*)(qp + 64 * k)); }
#pragma unroll
            for (int p = 0; p < 2; ++p) { const int row = 64 * p + (tid >> 3); float ss = 0.f;
#pragma unroll
                for (int k = 0; k < 4; ++k)
#pragma unroll
                    for (int e = 0; e < 4; ++e) { const float a = bflo(raw[p][k][e]), c = bfhi(raw[p][k][e]); ss += a * a + c * c; }
                ss = XSUM_SWZ(ss, 1); ss = XSUM_SWZ(ss, 2); ss = XSUM_SWZ(ss, 4);
                const float rq = rsqrtf(ss * (1.0f / 256.0f) + EPS);
                LAS unsigned char* qdst = Qb + (row >> 5) * 16384 + (row & 31) * 512;
#pragma unroll
                for (int k = 0; k < 4; ++k) { const int piece = sub + 8 * k; const f32x4 g0 = *(const f32x4*)(gq + 8 * piece), g1 = *(const f32x4*)(gq + 8 * piece + 4); u32x4 w;
                    w.x = cvtpk(bflo(raw[p][k].x) * rq * g0[0], bfhi(raw[p][k].x) * rq * g0[1]); w.y = cvtpk(bflo(raw[p][k].y) * rq * g0[2], bfhi(raw[p][k].y) * rq * g0[3]);
                    w.z = cvtpk(bflo(raw[p][k].z) * rq * g1[0], bfhi(raw[p][k].z) * rq * g1[1]); w.w = cvtpk(bflo(raw[p][k].w) * rq * g1[2], bfhi(raw[p][k].w) * rq * g1[3]);
                    *(LAS u32x4*)(qdst + ((piece ^ (row & 15)) << 4)) = w; } }
        }
        const LAS unsigned char* Qg = Qb + (wid & 3) * 16384 + r * 512;
        f32x16 o[8];
#pragma unroll
        for (int db = 0; db < 8; ++db) o[db] = f32x16{};
        float l = 0.f;
        const int krow_ = tid >> 3, ksub_ = tid & 7;
        const bf16* kp_ = K2 + (size_t)(b * MEML + krow_) * 1024 + head * 256 + 8 * ksub_;
        const bf16* vp_ = V2T + (size_t)(head * 256 + (tid >> 3)) * 512 + b * MEML + 8 * (tid & 7);
        for (int mt = 0; mt < 4; ++mt) {
            if (mt > 0) __syncthreads();
            if (MODE != 2) {   u32x4 kraw[4], vraw[4];
#pragma unroll
                for (int k = 0; k < 4; ++k) { kraw[k] = *(const u32x4*)(kp_ + (size_t)(64 * mt) * 1024 + 64 * k); vraw[k] = *(const u32x4*)(vp_ + (size_t)(64 * k) * 512 + 64 * mt); }
#pragma unroll
                for (int k = 0; k < 4; ++k) { const int piece = ksub_ + 8 * k; *(LAS u32x4*)(Kb + krow_ * 512 + ((piece ^ (krow_ & 15)) << 4)) = kraw[k]; }
#pragma unroll
                for (int k = 0; k < 4; ++k) { const int row = (tid >> 3) + 64 * k, piece = tid & 7;
                    *(LAS u32x4*)(Vb + row * 128 + ((piece ^ ((row >> 1) & 7)) << 4)) = vraw[k]; }
            }
            __syncthreads();
            if (MODE == 1) continue;
            bf16x8 pk[2];
            {   const int krow = 32 * dh + pi32(r); f32x16 S = {};
#pragma unroll 4
                for (int d0 = 0; d0 < 16; ++d0) { const int piece = 2 * d0 + hh;
                    const bf16x8 kf = *(const LAS bf16x8*)(Kb + krow * 512 + ((piece ^ (krow & 15)) << 4));
                    const bf16x8 qfr = *(const LAS bf16x8*)(Qg + ((piece ^ (r & 15)) << 4));
                    S = MFMA32(kf, qfr, S); }
#pragma unroll
                for (int i = 0; i < 16; ++i) { const float p = __builtin_amdgcn_exp2f(S[i] - M2); S[i] = p; l += p; }
                pk[0] = packf(S, 0); pk[1] = packf(S, 1); }
#pragma unroll
            for (int db = 0; db < 8; ++db) { const int vrow = 32 * db + r;
#pragma unroll
                for (int s2 = 0; s2 < 2; ++s2) { const int piece = 2 * (2 * dh + s2) + hh;
                    const bf16x8 vf = *(const LAS bf16x8*)(Vb + vrow * 128 + ((piece ^ ((vrow >> 1) & 7)) << 4));
                    o[db] = MFMA32(vf, pk[s2], o[db]); }
                if (db & 1) asm volatile("" ::: "memory"); }
        }
        l = xsum32(l);
        if (MODE != 0) { if (l + o[0][0] + o[7][7] == 123.456f) O2[0] = 0; continue; }
        __syncthreads();
        LAS float* xch = (LAS float*)(lds + (wid & 3) * 32768) + lane;
        if (dh == 1) {
#pragma unroll
            for (int db = 0; db < 8; ++db) {
#pragma unroll
                for (int i = 0; i < 16; ++i) xch[(db * 16 + i) * 64] = o[db][i];
                asm volatile("" ::: "memory"); }
            ((LAS float*)(lds + 131072))[(wid & 3) * 64 + lane] = l;
        }
        __syncthreads();
        if (dh == 0) {
            const float inv = 1.0f / (l + ((LAS float*)(lds + 131072))[(wid & 3) * 64 + lane]);
#pragma unroll
            for (int db = 0; db < 8; ++db) {
#pragma unroll
                for (int i = 0; i < 16; ++i) o[db][i] = (o[db][i] + xch[(db * 16 + i) * 64]) * inv;
                asm volatile("" ::: "memory"); }
            LAS unsigned char* stg = lds + (wid & 3) * 32768;
#pragma unroll
            for (int db = 0; db < 8; ++db)
#pragma unroll
                for (int g = 0; g < 4; ++g) {
                    u32x2 w; w.x = cvtpk(o[db][4 * g], o[db][4 * g + 1]); w.y = cvtpk(o[db][4 * g + 2], o[db][4 * g + 3]);
                    otile_put<32>(stg, r, hh, 4 * db + g, w); }
            otile_flush<32>(stg, O2 + (tokb + 32 * (wid & 3)) * 1024 + head * 256, 1024, lane);
        }
    }
    __syncthreads();
}

#define XB_TMO      128
#define XB_XCNT(j)  (256  + 64 * (j))
#define XB_XSUB(j)  (1280 + 64 * (j))
#define XB_XGEN(j)  (2304 + 64 * (j))
#define XB_TOP      3328
#define XB_TOPGEN   3392
#define XCD_BAR_WORDS 3456
#define XB_SPIN_CAP (1u << 18)

__device__ __forceinline__ unsigned xb_ld(unsigned* p)              { return __hip_atomic_load(p, __ATOMIC_RELAXED, __HIP_MEMORY_SCOPE_AGENT); }
__device__ __forceinline__ unsigned xb_add(unsigned* p, unsigned v) { return __hip_atomic_fetch_add(p, v, __ATOMIC_RELAXED, __HIP_MEMORY_SCOPE_AGENT); }
__device__ __forceinline__ unsigned xb_xcc_id() { return (unsigned)__builtin_amdgcn_s_getreg((3 << 11) | 20) & 0xFu; }
#define XB_SPIN(cond, bar) do { unsigned _sp = 0; while (cond) { __builtin_amdgcn_s_sleep(1); \
    if ((++_sp & 255u) == 0u) { if (xb_ld(&(bar)[XB_TMO])) break; if (_sp > XB_SPIN_CAP) { atomicAdd(&(bar)[XB_TMO], 1u); break; } } } } while (0)

struct XcdBarrier {
    unsigned* bar; unsigned x;
    volatile LAS unsigned* st;
};

__device__ __forceinline__ XcdBarrier xcd_barrier_post(unsigned* bar, volatile LAS unsigned* st, int wid_s) {
    XcdBarrier b; b.bar = bar; b.x = xb_xcc_id(); b.st = st;
    if (wid_s == 0 && lane_id_asm() == 0) (void)xb_add(&bar[XB_XCNT(b.x)], 1u);
    return b;
}
__device__ __forceinline__ void xcd_barrier_complete(unsigned* bar, unsigned x, unsigned& nloc, unsigned& nx) {
    const unsigned G = gridDim.x * gridDim.y * gridDim.z;
    unsigned sum, cnt, mine, sp = 0u;
    for (;;) {
        sum = 0u; cnt = 0u; mine = 0u;
#pragma unroll
        for (unsigned j = 0; j < 16; ++j) { const unsigned c = xb_ld(&bar[XB_XCNT(j)]); sum += c; cnt += (c > 0u) ? 1u : 0u; mine = (j == x) ? c : mine; }
        if (sum == G) break;
        __builtin_amdgcn_s_sleep(1);
        if ((++sp & 255u) == 0u) { if (xb_ld(&bar[XB_TMO])) break; if (sp > XB_SPIN_CAP) { atomicAdd(&bar[XB_TMO], 1u); break; } }
    }
    nloc = mine > 0u ? mine : 1u; nx = cnt > 0u ? cnt : 1u;
}

__device__ __forceinline__ void xcd_barrier(const XcdBarrier& b, int wid_s) {
    asm volatile("s_waitcnt vmcnt(0)" ::: "memory");
    __syncthreads();
    if (wid_s == 0 && lane_id_asm() == 0) {
        unsigned* bar = b.bar;
        __builtin_amdgcn_s_waitcnt(0);
        unsigned nloc = b.st[0], nx = b.st[1];
        if (nloc == 0u) { xcd_barrier_complete(bar, b.x, nloc, nx); b.st[0] = nloc; b.st[1] = nx; }
        const unsigned old = xb_add(&bar[XB_XSUB(b.x)], 1u);
        const unsigned gen = old / nloc;
        if (old + 1u == (gen + 1u) * nloc) {
            __builtin_amdgcn_fence(__ATOMIC_RELEASE, "agent");
            asm volatile("s_waitcnt vmcnt(0)" ::: "memory");
            const unsigned og = xb_add(&bar[XB_TOP], 1u);
            const unsigned tg = og / nx;
            if (og + 1u == (tg + 1u) * nx) xb_add(&bar[XB_TOPGEN], 1u);
            else XB_SPIN(xb_ld(&bar[XB_TOPGEN]) == tg, bar);
            __builtin_amdgcn_fence(__ATOMIC_ACQUIRE, "agent");
            xb_add(&bar[XB_XGEN(b.x)], 1u);
            asm volatile("s_waitcnt vmcnt(0)" ::: "memory");
        } else {
            XB_SPIN(xb_ld(&bar[XB_XGEN(b.x)]) == gen, bar);
            __builtin_amdgcn_fence(__ATOMIC_ACQUIRE, "agent");
            asm volatile("s_waitcnt vmcnt(0)" ::: "memory");
        }
    }
    __syncthreads();
}

__global__ void __launch_bounds__(512) hymba_fwd(Params P) {
    extern __shared__ __attribute__((aligned(16))) unsigned char lds_raw[];
    LAS unsigned char* lds = (LAS unsigned char*)lds_raw;
    cg::grid_group grid = cg::this_grid();
    unsigned char* ws = P.ws;
    const int G = gridDim.x, c = blockIdx.x;
    float* SSQ1 = (float*)(ws + WS_SSQ1); float* SSQ2 = (float*)(ws + WS_SSQ2); const float* RSTD1 = (const float*)(ws + WS_RSTD1); const float* RSTDM = (const float*)(ws + WS_RSTDM);
    bf16* XB = (bf16*)(ws + WS_XB); bf16* PROJ = (bf16*)(ws + WS_PROJ); bf16* TR = (bf16*)(ws + WS_TR); bf16* MIX = (bf16*)(ws + WS_MIX);
    bf16* Q2 = (bf16*)(ws + WS_PROJ); bf16* O2 = (bf16*)(ws + WS_PROJ + 32 * MiB); bf16* ACT = (bf16*)(ws + WS_TR);

    volatile LAS unsigned* st = (volatile LAS unsigned*)(lds + 135168);
    unsigned* barw = (unsigned*)(ws + WS_BAR);
    const int wid_s = __builtin_amdgcn_readfirstlane(threadIdx.x >> 6);
    if (wid_s == 0 && lane_id_asm() < 2) st[lane_id_asm()] = 0u;
    __syncthreads();
    const XcdBarrier xb = xcd_barrier_post(barw, st, wid_s);
#ifndef NO_P0
    p0_prologue(P, lds, wid_s);
#endif
#ifdef REP_P0
    p0_prologue(P, lds, wid_s);
#endif
    if (P.use_cg) grid.sync();
    xcd_barrier(xb, wid_s);
#ifdef REP_G1
    for (int rep_ = 0; rep_ < 2; ++rep_) {
#else
    {
#endif
    {   pg8::Gemm g{XB, (const bf16*)(ws + WS_WN), NTOK, 2560, DM}; pg8::StaticOrder S; S.init(NTOK, 2560, G, c);
        pg8::EpiG1 E{PROJ, RSTD1, (const float*)(ws + WS_CS), P.in[4], P.in[5], 0.125f * LOG2E};
        pg8::gemm_phase<pg8::EpiG1, pg8::StaticOrder, true, true>(lds, g, S, E, wid_s); }
    {   pg8::Gemm g{(const bf16*)(ws + WS_WTR), XB, 1536, NTOK, DM}; pg8::StaticOrder S; S.init(1536, NTOK, G, (c + G / 2) % G);
        pg8::EpiTR E{TR, RSTD1, (const float*)(ws + WS_CS)};
        pg8::gemm_phase<pg8::EpiTR, pg8::StaticOrder, true, true>(lds, g, S, E, wid_s); }
    }
    xcd_barrier(xb, wid_s);
#ifndef NO_RETKV
    ret_kv_phase(P, wid_s);
#endif
#ifdef REP_RETKV
    ret_kv_phase(P, wid_s);
#endif
#ifndef NO_DIFF
    diff_phase(P, lds, wid_s);
#endif
#ifdef REP_DIFF
    diff_phase(P, lds, wid_s);
#endif
#ifdef REP_DIFF_SKEL
    diff_probe_phase<1>(P, lds, wid_s);
#endif
#ifdef REP_DIFF_COMP
    diff_probe_phase<2>(P, lds, wid_s);
#endif
    xcd_barrier(xb, wid_s);
    ret_scan_phase(P, wid_s);

    kv2_phase(P, wid_s);
    xcd_barrier(xb, wid_s);
#ifdef REP_SYNC
    for (int rep_ = 0; rep_ < 20; ++rep_) xcd_barrier(xb, wid_s);
#endif
#ifndef NO_RETOUT
    ret_out_phase(P, lds, wid_s);
#endif
    knorm_phase(P, wid_s);
#ifdef REP_RETOUT
    ret_out_phase(P, lds, wid_s);
#endif
#ifdef REP_RETOUT_NOST
    ret_out_phase<1>(P, lds, wid_s);
#endif
    xcd_barrier(xb, wid_s);
    {   pg8::Gemm g{MIX, (const bf16*)(ws + WS_WOUT), NTOK, DM, DM}; pg8::StaticOrder S; S.init(NTOK, DM, G, c);
        pg8::EpiResid<true> E{P.in[0], P.out, XB, SSQ1};
        pg8::gemm_phase<pg8::EpiResid<true>, pg8::StaticOrder, true, true>(lds, g, S, E, wid_s); }
#ifdef REP_G2
    {   pg8::Gemm g{MIX, (const bf16*)(ws + WS_WOUT), NTOK, DM, DM}; pg8::StaticOrder S; S.init(NTOK, DM, G, c);
        pg8::EpiResid<false> E{P.in[0], (float*)(ws + WS_PROJ), nullptr, nullptr};
        pg8::gemm_phase<pg8::EpiResid<false>, pg8::StaticOrder, true, true>(lds, g, S, E, wid_s); }
#endif
    xcd_barrier(xb, wid_s);
#ifdef REP_G3
    for (int rep_ = 0; rep_ < 2; ++rep_) {
#else
    {
#endif
    {   pg8::Gemm g{XB, (const bf16*)(ws + WS_XQ), NTOK, DM, DM}; pg8::StaticOrder S; S.init(NTOK, DM, G, c);
        pg8::EpiRowScale<true> E{Q2, 1024, SSQ1};
        pg8::gemm_phase<pg8::EpiRowScale<true>, pg8::StaticOrder, true, true>(lds, g, S, E, wid_s); }
    }
    xcd_barrier(xb, wid_s);
#ifndef NO_XATTN
    xattn_phase(P, lds, wid_s);
#endif
#ifdef REP_XATTN
    xattn_phase(P, lds, wid_s);
#endif
#ifdef REP_XATTN_SKEL
    xattn_phase<1>(P, lds, wid_s);
#endif
#ifdef REP_XATTN_COMP
    xattn_phase<2>(P, lds, wid_s);
#endif
    xcd_barrier(xb, wid_s);
    {   pg8::Gemm g{O2, (const bf16*)(ws + WS_XO), NTOK, DM, DM}; pg8::StaticOrder S; S.init(NTOK, DM, G, c);
#ifdef REP_G4
    {   pg8::Gemm g2{O2, (const bf16*)(ws + WS_XO), NTOK, DM, DM}; pg8::StaticOrder S2; S2.init(NTOK, DM, G, c);
        pg8::EpiResid<false> E2{P.out, (float*)(ws + WS_TR), nullptr, nullptr};
        pg8::gemm_phase<pg8::EpiResid<false>, pg8::StaticOrder, true, true>(lds, g2, S2, E2, wid_s); }
#endif
        pg8::EpiResid<true> E{P.out, P.out, XB, SSQ2};
        pg8::gemm_phase<pg8::EpiResid<true>, pg8::StaticOrder, true, true>(lds, g, S, E, wid_s); }
    xcd_barrier(xb, wid_s);
#ifdef REP_G5
    for (int rep_ = 0; rep_ < 2; ++rep_) {
#else
    {
#endif
    {   pg8::Gemm g{XB, (const bf16*)(ws + WS_WGU), NTOK, 2 * FFH, DM}; pg8::StaticOrder S; S.init(NTOK, 2 * FFH, G, c);
        pg8::EpiSwiglu E{ACT, SSQ2};
        pg8::gemm_phase<pg8::EpiSwiglu, pg8::StaticOrder, true, true>(lds, g, S, E, wid_s); }
    }
    xcd_barrier(xb, wid_s);
    {   pg8::Gemm g{ACT, (const bf16*)(ws + WS_WD), NTOK, DM, FFH}; pg8::StaticOrder S; S.init(NTOK, DM, G, c);
#ifdef REP_G6
    {   pg8::Gemm g2{ACT, (const bf16*)(ws + WS_WD), NTOK, DM, FFH}; pg8::StaticOrder S2; S2.init(NTOK, DM, G, c);
        pg8::EpiResid<false> E2{P.out, (float*)(ws + WS_PROJ), nullptr, nullptr};
        pg8::gemm_phase<pg8::EpiResid<false>, pg8::StaticOrder, true, true>(lds, g2, S2, E2, wid_s); }
#endif
        pg8::EpiResidF E{P.out, P.out};
        pg8::gemm_phase<pg8::EpiResidF, pg8::StaticOrder, true, true>(lds, g, S, E, wid_s); }
}

extern "C" void kernel_launch(void* const* d_in, const int* in_sizes, int n_in, void* d_out, int out_size, void* d_ws, size_t ws_size, hipStream_t stream) {
    static int grid = 0;
    if (grid == 0) {
        if (n_in != 21 || out_size != NTOK * DM || ws_size < WS_END) { fprintf(stderr, "kernel_launch: unexpected shapes (n_in %d, out %d, ws %zu)\n", n_in, out_size, ws_size); grid = -1; return; }
        int dev = 0, cus = 0, per_cu = 0;
        (void)hipGetDevice(&dev); (void)hipDeviceGetAttribute(&cus, hipDeviceAttributeMultiprocessorCount, dev);
        if (hipFuncSetAttribute((const void*)hymba_fwd, hipFuncAttributeMaxDynamicSharedMemorySize, LDS_BYTES) != hipSuccess) { fprintf(stderr, "kernel_launch: hipFuncSetAttribute failed\n"); grid = -1; return; }
        if (hipOccupancyMaxActiveBlocksPerMultiprocessor(&per_cu, (const void*)hymba_fwd, 512, LDS_BYTES) != hipSuccess || per_cu < 1) { fprintf(stderr, "kernel_launch: occupancy query failed (%d)\n", per_cu); (void)hipGetLastError(); per_cu = 1; }
        grid = cus * (per_cu > 1 ? 1 : per_cu);
        if (grid > 256) grid = 256;
    }
    if (grid < 0) return;
    if (hipMemsetAsync((char*)d_ws + WS_BAR, 0, 65536, stream) != hipSuccess) { fprintf(stderr, "kernel_launch: memset of the barrier words failed\n"); return; }
    Params p{};
    for (int i = 0; i < 21; ++i) p.in[i] = (const float*)d_in[i];
    p.out = (float*)d_out; p.ws = (unsigned char*)d_ws;
    void* args[] = {&p};
    hipError_t e = hipLaunchCooperativeKernel((const void*)hymba_fwd, dim3(grid), dim3(512), args, LDS_BYTES, stream);
    if (e != hipSuccess) fprintf(stderr, "cooperative launch failed: %s (grid %d)\n", hipGetErrorString(e), grid);
}
```

```cpp
#include <hip/hip_runtime.h>
#include <hip/hip_cooperative_groups.h>
#include <cstdio>
#include <cstdint>
namespace cg = cooperative_groups;
#define XSUM_SWZ(v, m) ((v) + __uint_as_float((unsigned)__builtin_amdgcn_ds_swizzle((int)__float_as_uint(v), ((m) << 10) | 0x1f)))
#define XMAX_SWZ(v, m) fmaxf((v), __uint_as_float((unsigned)__builtin_amdgcn_ds_swizzle((int)__float_as_uint(v), ((m) << 10) | 0x1f)))
__device__ __forceinline__ float xsum32(float v) { auto rr = __builtin_amdgcn_permlane32_swap(__float_as_uint(v), __float_as_uint(v), false, false); return __uint_as_float(rr[0]) + __uint_as_float(rr[1]); }
__device__ __forceinline__ float xmax32(float v) { auto rr = __builtin_amdgcn_permlane32_swap(__float_as_uint(v), __float_as_uint(v), false, false); return fmaxf(__uint_as_float(rr[0]), __uint_as_float(rr[1])); }
__device__ __forceinline__ float xsum16(float v) { return XSUM_SWZ(v, 16); }
__device__ __forceinline__ int lane_id_asm() { int l; asm volatile("v_mbcnt_lo_u32_b32 %0, -1, 0\n\tv_mbcnt_hi_u32_b32 %0, -1, %0" : "=v"(l)); return l; }
namespace pg8 {
#define PG8_LAS __attribute__((address_space(3)))
typedef unsigned short bf16_t;
typedef short bf16x8 __attribute__((ext_vector_type(8)));
typedef float f32x4 __attribute__((ext_vector_type(4)));
typedef unsigned u32x4 __attribute__((ext_vector_type(4)));
constexpr int BM = 256, BK = 64, HALF = 128, HTB = HALF * BK * 2  , STAGE_BYTES = 8 * HTB, NXCD = 8, WGM = 8;

__host__ __device__ __forceinline__ int lds_byte(int r, int c) { const int st = (r >> 4) * 2 + (c >> 5), rr = r & 15, cc = c & 31, ob = rr * 64 + cc * 2; return st * 1024 + (ob ^ (((ob >> 9) & 1) << 5)); }
__host__ __device__ __forceinline__ void stage_rc(int b, int& R, int& C) { const int st = b / 1024, sb = b % 1024, swz = sb ^ (((sb >> 9) & 1) << 5); R = (st >> 1) * 16 + swz / 64; C = (st & 1) * 32 + (swz % 64) / 2; }
__host__ __device__ __forceinline__ int perm32(int rho) { const int n = rho >> 4, i = rho & 15; return 8 * (i >> 2) + 4 * n + (i & 3); }

struct Unit { int pm, pn; };
struct Gemm { const bf16_t* A; const bf16_t* Bt; int M, N, K; };

struct StaticOrder {
    int nM, nN, nwg, G, c;
    __host__ __device__ void init(int M, int N, int G_, int c_) { nM = M / BM; nN = N / BM; nwg = nM * nN; G = G_; c = c_; }
    __host__ __device__ bool next(int i, Unit& u) const {
        const long L = (long)i * G + c; if (L >= nwg) return false;
        int wgid = (int)L; { const int q = nwg / NXCD, r = nwg % NXCD, xcd = wgid % NXCD, off = wgid / NXCD; wgid = (xcd < r ? xcd * (q + 1) : r * (q + 1) + (xcd - r) * q) + off; }
        const int nig = WGM * nN, gid = wgid / nig, fm = gid * WGM, gsz = (nM - fm) < WGM ? (nM - fm) : WGM;
        u.pm = fm + ((wgid % nig) % gsz); u.pn = (wgid % nig) / gsz; return true;
    }
    __device__ __forceinline__ void a_ready(const Unit&) const {}
    __device__ __forceinline__ void done(const Unit&) const {}
};

__device__ __forceinline__ unsigned cvt_pk_bf16(float lo, float hi) { unsigned r; asm volatile("v_cvt_pk_bf16_f32 %0, %1, %2" : "=v"(r) : "v"(lo), "v"(hi)); return r; }
typedef float f32x2 __attribute__((ext_vector_type(2)));
typedef unsigned u32x2 __attribute__((ext_vector_type(2)));
constexpr float EPS_RMS = 1e-6f;
__device__ __forceinline__ u32x4 pack8(const float (&v)[8]) { u32x4 w; w.x = cvt_pk_bf16(v[0], v[1]); w.y = cvt_pk_bf16(v[2], v[3]); w.z = cvt_pk_bf16(v[4], v[5]); w.w = cvt_pk_bf16(v[6], v[7]); return w; }
__device__ __forceinline__ float silu_f(float v) { return v * __builtin_amdgcn_rcpf(1.0f + __builtin_amdgcn_exp2f(v * -1.4426950408889634f)); }

struct EpiG1 {
    static constexpr bool PERM = true, AFTER_DRAIN = false;
    bf16_t* O; const float* rstd; const float* cs; const float* gq; const float* gk; float c2;
    __device__ __forceinline__ void operator()(const f32x4 (&acc)[2][2][4][2], const Unit& u, int wr, int wc, int fr, int fq) const {
        const int pn = u.pn; const int row0 = u.pm * BM + wr * 64 + fr;
        if (pn < 4) {
            const float sc = pn >= 2 ? 0.125f : 1.0f;
#pragma unroll
            for (int ai = 0; ai < 2; ++ai)
#pragma unroll
                for (int m = 0; m < 4; ++m) { const int row = row0 + ai * HALF + m * 16; const float f = rstd[row] * sc;
                    const f32x4* c4 = (const f32x4*)(cs + ((size_t)(row & 8191) * 32 + 8 * fq) * 2);
                    float o1[8], o2[8];
#pragma unroll
                    for (int k = 0; k < 4; ++k) { const f32x4 c = c4[k];
#pragma unroll
                        for (int z = 0; z < 2; ++z) { const int i8 = 2 * k + z; const float co = z ? c[2] : c[0], si = z ? c[3] : c[1];
                            const float x1 = acc[ai][0][m][i8 >> 2][i8 & 3], x2 = acc[ai][1][m][i8 >> 2][i8 & 3];
                            o1[i8] = (x1 * co - x2 * si) * f; o2[i8] = (x2 * co + x1 * si) * f; } }
                    bf16_t* p = O + (size_t)row * 2560 + pn * 256 + wc * 64 + 8 * fq;
                    *(u32x4*)p = pack8(o1); *(u32x4*)(p + 32) = pack8(o2); }
        } else if (pn < 6) {
#pragma unroll
            for (int ai = 0; ai < 2; ++ai)
#pragma unroll
                for (int m = 0; m < 4; ++m) { const int row = row0 + ai * HALF + m * 16; const float f = rstd[row];
#pragma unroll
                    for (int bj = 0; bj < 2; ++bj) { float v[8];
#pragma unroll
                        for (int i8 = 0; i8 < 8; ++i8) v[i8] = silu_f(acc[ai][bj][m][i8 >> 2][i8 & 3] * f);
                        *(u32x4*)(O + (size_t)row * 2560 + pn * 256 + bj * HALF + wc * 32 + 8 * fq) = pack8(v); } }
        } else {
            const float* g = pn < 8 ? gq : gk; const float sc = pn < 8 ? c2 : 1.0f;
            float gv[2][8];
#pragma unroll
            for (int bj = 0; bj < 2; ++bj)
#pragma unroll
                for (int i8 = 0; i8 < 8; ++i8) gv[bj][i8] = g[32 * bj + 8 * fq + i8] * sc;
#pragma unroll
            for (int ai = 0; ai < 2; ++ai)
#pragma unroll
                for (int m = 0; m < 4; ++m) { const int row = row0 + ai * HALF + m * 16; const float f = rstd[row];
                    float ss = 0.f;
#pragma unroll
                    for (int bj = 0; bj < 2; ++bj)
#pragma unroll
                        for (int i8 = 0; i8 < 8; ++i8) { const float v = acc[ai][bj][m][i8 >> 2][i8 & 3] * f; ss += v * v; }
                    ss = xsum16(ss); ss = xsum32(ss);
                    const float rr = f * rsqrtf(ss * (1.0f / 64.0f) + EPS_RMS);
#pragma unroll
                    for (int bj = 0; bj < 2; ++bj) { float v[8];
#pragma unroll
                        for (int i8 = 0; i8 < 8; ++i8) v[i8] = acc[ai][bj][m][i8 >> 2][i8 & 3] * rr * gv[bj][i8];
                        *(u32x4*)(O + (size_t)row * 2560 + pn * 256 + wc * 64 + bj * 32 + 8 * fq) = pack8(v); } }
        }
    }
};

struct EpiTR {
    static constexpr bool PERM = true, AFTER_DRAIN = false;
    bf16_t* O; const float* rstd; const float* cs;
    __device__ __forceinline__ void operator()(const f32x4 (&acc)[2][2][4][2], const Unit& u, int wr, int wc, int fr, int fq) const {
        const int pm = u.pm; const int col0 = u.pn * BM + wc * 32 + 8 * fq;
        float rs[2][8];
#pragma unroll
        for (int bj = 0; bj < 2; ++bj) { const f32x4 a = *(const f32x4*)(rstd + col0 + bj * HALF), b = *(const f32x4*)(rstd + col0 + bj * HALF + 4);
            rs[bj][0] = a[0]; rs[bj][1] = a[1]; rs[bj][2] = a[2]; rs[bj][3] = a[3]; rs[bj][4] = b[0]; rs[bj][5] = b[1]; rs[bj][6] = b[2]; rs[bj][7] = b[3]; }
        if (pm < 2) {
#pragma unroll
            for (int m = 0; m < 4; ++m) { const int hl = 2 * wr + (m >> 1), i = 16 * (m & 1) + fr, head = 4 * pm + hl;
                const float l2g = log1pf(-exp2f(-5.0f - (float)head)) * 1.4426950408889634f;
                const int rown = pm * 256 + 64 * hl + i;
#pragma unroll
                for (int bj = 0; bj < 2; ++bj) { float o1[8], o2[8];
#pragma unroll
                    for (int i8 = 0; i8 < 8; ++i8) { const int col = col0 + bj * HALF + i8; const int pos = col & 8191;
                        const float2 c = *(const float2*)(cs + ((size_t)pos * 32 + i) * 2);
                        const float f = rs[bj][i8] * 0.125f * __builtin_amdgcn_exp2f(l2g * (float)(127 - (col & 127)));
                        const float x1 = acc[0][bj][m][i8 >> 2][i8 & 3], x2 = acc[1][bj][m][i8 >> 2][i8 & 3];
                        o1[i8] = (x1 * c.x - x2 * c.y) * f; o2[i8] = (x2 * c.x + x1 * c.y) * f; }
                    *(u32x4*)(O + (size_t)rown * 16384 + col0 + bj * HALF) = pack8(o1);
                    *(u32x4*)(O + (size_t)(rown + 32) * 16384 + col0 + bj * HALF) = pack8(o2); } }
        } else {
#pragma unroll
            for (int ai = 0; ai < 2; ++ai)
#pragma unroll
                for (int m = 0; m < 4; ++m) { const int row = pm * BM + ai * HALF + wr * 64 + m * 16 + fr;
#pragma unroll
                    for (int bj = 0; bj < 2; ++bj) { float v[8];
#pragma unroll
                        for (int i8 = 0; i8 < 8; ++i8) v[i8] = acc[ai][bj][m][i8 >> 2][i8 & 3] * rs[bj][i8];
                        *(u32x4*)(O + (size_t)row * 16384 + col0 + bj * HALF) = pack8(v); } }
        }
    }
};

template <bool SSQ> struct EpiRowScale {
    static constexpr bool PERM = true, AFTER_DRAIN = false;
    bf16_t* O; int ldc; const float* rs;
    __device__ __forceinline__ void operator()(const f32x4 (&acc)[2][2][4][2], const Unit& u, int wr, int wc, int fr, int fq) const {
        const int row0 = u.pm * BM + wr * 64 + fr, col0 = u.pn * BM + wc * 32 + 8 * fq;
#pragma unroll
        for (int ai = 0; ai < 2; ++ai)
#pragma unroll
            for (int m = 0; m < 4; ++m) { const int row = row0 + ai * HALF + m * 16; float f = rs[row]; if (SSQ) f = rsqrtf(f * (1.0f / 1024.0f) + EPS_RMS);
#pragma unroll
                for (int bj = 0; bj < 2; ++bj) { float v[8];
#pragma unroll
                    for (int i8 = 0; i8 < 8; ++i8) v[i8] = acc[ai][bj][m][i8 >> 2][i8 & 3] * f;
                    *(u32x4*)(O + (size_t)row * ldc + col0 + bj * HALF) = pack8(v); } }
    }
};
struct EpiColScale {
    static constexpr bool PERM = true, AFTER_DRAIN = false;
    bf16_t* O; int ldc; const float* rs;
    __device__ __forceinline__ void operator()(const f32x4 (&acc)[2][2][4][2], const Unit& u, int wr, int wc, int fr, int fq) const {
        const int row0 = u.pm * BM + wr * 64 + fr, col0 = u.pn * BM + wc * 32 + 8 * fq;
        float rsv[2][8];
#pragma unroll
        for (int bj = 0; bj < 2; ++bj)
#pragma unroll
            for (int i8 = 0; i8 < 8; ++i8) rsv[bj][i8] = rs[col0 + bj * HALF + i8];
#pragma unroll
        for (int ai = 0; ai < 2; ++ai)
#pragma unroll
            for (int m = 0; m < 4; ++m) { const int row = row0 + ai * HALF + m * 16;
#pragma unroll
                for (int bj = 0; bj < 2; ++bj) { float v[8];
#pragma unroll
                    for (int i8 = 0; i8 < 8; ++i8) v[i8] = acc[ai][bj][m][i8 >> 2][i8 & 3] * rsv[bj][i8];
                    *(u32x4*)(O + (size_t)row * ldc + col0 + bj * HALF) = pack8(v); } }
    }
};
template <bool AUX> struct EpiResid {
    static constexpr bool PERM = true, AFTER_DRAIN = false;
    const float* base; float* out; bf16_t* xb; float* ssq;
    __device__ __forceinline__ void operator()(const f32x4 (&acc)[2][2][4][2], const Unit& u, int wr, int wc, int fr, int fq) const {
        const int row0 = u.pm * BM + wr * 64 + fr, col0 = u.pn * BM + wc * 32 + 8 * fq;
#pragma unroll
        for (int ai = 0; ai < 2; ++ai) {
            f32x4 bv[4][2][2];
#pragma unroll
            for (int m = 0; m < 4; ++m)
#pragma unroll
                for (int bj = 0; bj < 2; ++bj) { const size_t off = (size_t)(row0 + ai * HALF + m * 16) * 1024 + col0 + bj * HALF;
                    bv[m][bj][0] = __builtin_nontemporal_load((const f32x4*)(base + off)); bv[m][bj][1] = __builtin_nontemporal_load((const f32x4*)(base + off + 4)); }
#pragma unroll
            for (int m = 0; m < 4; ++m) { const int row = row0 + ai * HALF + m * 16; float ss = 0.f;
#pragma unroll
                for (int bj = 0; bj < 2; ++bj) { const size_t off = (size_t)row * 1024 + col0 + bj * HALF;
                    const f32x4 v0 = bv[m][bj][0] + acc[ai][bj][m][0], v1 = bv[m][bj][1] + acc[ai][bj][m][1];
                    *(f32x4*)(out + off) = v0; *(f32x4*)(out + off + 4) = v1;
                    if (AUX) { u32x4 w; w.x = cvt_pk_bf16(v0[0], v0[1]); w.y = cvt_pk_bf16(v0[2], v0[3]); w.z = cvt_pk_bf16(v1[0], v1[1]); w.w = cvt_pk_bf16(v1[2], v1[3]);
                        *(u32x4*)(xb + off) = w;
                        ss += (v0[0] * v0[0] + v0[1] * v0[1]) + (v0[2] * v0[2] + v0[3] * v0[3]) + (v1[0] * v1[0] + v1[1] * v1[1]) + (v1[2] * v1[2] + v1[3] * v1[3]); } }
                if (AUX) { ss = xsum16(ss); ss = xsum32(ss); if (fq == 0) atomicAdd(ssq + row, ss); } }
        }
    }
};
struct EpiResidF {
    static constexpr bool PERM = false, AFTER_DRAIN = false;
    const float* base; float* out;
    __device__ __forceinline__ void operator()(const f32x4 (&acc)[2][2][4][2], const Unit& u, int wr, int wc, int fr, int fq) const {
        const int row0 = u.pm * BM + wr * 64 + fr, col0 = u.pn * BM + wc * 32 + 4 * fq;
#pragma unroll
        for (int ai = 0; ai < 2; ++ai) {
            f32x4 bv[4][2][2];
#pragma unroll
            for (int m = 0; m < 4; ++m)
#pragma unroll
                for (int bj = 0; bj < 2; ++bj) { const size_t off = (size_t)(row0 + ai * HALF + m * 16) * 1024 + col0 + bj * HALF;
                    bv[m][bj][0] = __builtin_nontemporal_load((const f32x4*)(base + off)); bv[m][bj][1] = __builtin_nontemporal_load((const f32x4*)(base + off + 16)); }
#pragma unroll
            for (int m = 0; m < 4; ++m)
#pragma unroll
                for (int bj = 0; bj < 2; ++bj) { const size_t off = (size_t)(row0 + ai * HALF + m * 16) * 1024 + col0 + bj * HALF;
                    __builtin_nontemporal_store(bv[m][bj][0] + acc[ai][bj][m][0], (f32x4*)(out + off)); __builtin_nontemporal_store(bv[m][bj][1] + acc[ai][bj][m][1], (f32x4*)(out + off + 16)); }
        }
    }
};
struct EpiSwiglu {
    static constexpr bool PERM = true, AFTER_DRAIN = false;
    bf16_t* O; const float* ssq;
    __device__ __forceinline__ void operator()(const f32x4 (&acc)[2][2][4][2], const Unit& u, int wr, int wc, int fr, int fq) const {
        const int row0 = u.pm * BM + wr * 64 + fr, col0 = u.pn * HALF + wc * 32 + 8 * fq;
#pragma unroll
        for (int ai = 0; ai < 2; ++ai)
#pragma unroll
            for (int m = 0; m < 4; ++m) { const int row = row0 + ai * HALF + m * 16; const float f = rsqrtf(ssq[row] * (1.0f / 1024.0f) + EPS_RMS);
                float v[8];
#pragma unroll
                for (int i8 = 0; i8 < 8; ++i8) v[i8] = silu_f(acc[ai][0][m][i8 >> 2][i8 & 3] * f) * (acc[ai][1][m][i8 >> 2][i8 & 3] * f);
                *(u32x4*)(O + (size_t)row * 2816 + col0) = pack8(v); }
    }
};
template <class Epi, class Sched, bool ALIGN_EPI = false, bool SP2 = false>
__device__ __forceinline__ void gemm_phase(PG8_LAS unsigned char* lds, const Gemm g, const Sched& S, const Epi& E, int wid_s) {
    const int lane = lane_id_asm(), wid = wid_s, tid = wid * 64 + lane, wr = wid >> 2, wc = wid & 3, fr = lane & 15, fq = lane >> 4;
    const int K = g.K, nt = K / BK;
    unsigned voffA[2], voffB[2];
#pragma unroll
    for (int i = 0; i < 2; ++i) { int R, C; stage_rc(tid * 16 + i * 8192, R, C); const int Rb = Epi::PERM ? ((R & ~31) + perm32(R & 31)) : R;
        voffA[i] = (unsigned)(R * K + C) * 2u; voffB[i] = (unsigned)(Rb * K + C) * 2u; }
    const size_t kstep = (size_t)(BK * 2);
    const size_t hstep = (size_t)HALF * K * 2;
    const size_t tstep = 2 * hstep;
    const unsigned ldsw = (unsigned)wid * 1024u;
    const int aoff = lds_byte(wr * 64 + fr, fq * 8), boff = lds_byte(wc * 32 + fr, fq * 8);
#define PG8_SA(b, h) (((b) * 2 + (h)) * HTB)
#define PG8_SB(b, h) ((4 + (b) * 2 + (h)) * HTB)
#define PG8_STAGE(bufoff, gbase, voff) do { _Pragma("unroll") for (int _i = 0; _i < 2; ++_i) \
        __builtin_amdgcn_global_load_lds((const unsigned*)((const char*)(gbase) + (voff)[_i]), (PG8_LAS unsigned*)(lds + (bufoff) + ldsw + _i * 8192), 16, 0, 0); } while (0)
#define PG8_LDA(dst, b, h) do { _Pragma("unroll") for (int m = 0; m < 4; ++m) _Pragma("unroll") for (int k = 0; k < 2; ++k) dst[m][k] = *(const PG8_LAS bf16x8*)(lds + PG8_SA(b, h) + aoff + m * 2048 + k * 1024); } while (0)
#define PG8_LDB(dst, b, h) do { _Pragma("unroll") for (int n = 0; n < 2; ++n) _Pragma("unroll") for (int k = 0; k < 2; ++k) dst[n][k] = *(const PG8_LAS bf16x8*)(lds + PG8_SB(b, h) + boff + n * 2048 + k * 1024); } while (0)
#define PG8_MMA(ai, bj, At, Bt) do { __builtin_amdgcn_s_setprio(1); _Pragma("unroll") for (int m = 0; m < 4; ++m) _Pragma("unroll") for (int n = 0; n < 2; ++n) _Pragma("unroll") for (int k = 0; k < 2; ++k) \
        acc[ai][bj][m][n] = __builtin_amdgcn_mfma_f32_16x16x32_bf16(Bt[n][k], At[m][k], acc[ai][bj][m][n], 0, 0, 0); __builtin_amdgcn_s_setprio(0); } while (0)
#define PG8_WAIT_V(n) asm volatile("s_waitcnt vmcnt(" #n ")" ::: "memory")
#define PG8_WAIT_L(n) asm volatile("s_waitcnt lgkmcnt(" #n ")" ::: "memory")
#define PG8_BAR __builtin_amdgcn_s_barrier()
#define PG8_SCHED __builtin_amdgcn_sched_barrier(0)
    Unit cur, nxt; int ui = 0;
    if (!S.next(0, cur)) return;
    f32x4 acc[2][2][4][2];
#pragma unroll
    for (int a = 0; a < 2; ++a)
#pragma unroll
        for (int b = 0; b < 2; ++b)
#pragma unroll
            for (int m = 0; m < 4; ++m)
#pragma unroll
                for (int n = 0; n < 2; ++n) acc[a][b][m][n] = (f32x4){0.f, 0.f, 0.f, 0.f};
    bf16x8 At[4][2], B0[2][2], B1[2][2];
    const char* cA = (const char*)g.A + (size_t)cur.pm * tstep; const char* cB = (const char*)g.Bt + (size_t)cur.pn * tstep;
    S.a_ready(cur);
    if constexpr (SP2) {
        PG8_STAGE(PG8_SB(0, 0), cB, voffB); PG8_STAGE(PG8_SB(0, 1), cB + hstep, voffB); PG8_STAGE(PG8_SA(0, 0), cA, voffA); PG8_STAGE(PG8_SA(0, 1), cA + hstep, voffA);
        if (wr == 1) PG8_BAR;
        PG8_WAIT_V(2); PG8_BAR;
        PG8_STAGE(PG8_SB(1, 0), cB + kstep, voffB); PG8_STAGE(PG8_SA(1, 0), cA + kstep, voffA); PG8_STAGE(PG8_SB(1, 1), cB + hstep + kstep, voffB);
        PG8_WAIT_V(6); PG8_BAR;
    } else {
        PG8_STAGE(PG8_SB(0, 0), cB, voffB); PG8_STAGE(PG8_SA(0, 0), cA, voffA); PG8_STAGE(PG8_SB(0, 1), cB + hstep, voffB); PG8_STAGE(PG8_SA(0, 1), cA + hstep, voffA);
        if (wr == 1) PG8_BAR;
        PG8_WAIT_V(4); PG8_BAR;
        PG8_STAGE(PG8_SB(1, 0), cB + kstep, voffB); PG8_STAGE(PG8_SA(1, 0), cA + kstep, voffA); PG8_STAGE(PG8_SB(1, 1), cB + hstep + kstep, voffB);
        PG8_WAIT_V(6); PG8_BAR;
    }
    for (;;) {
        const bool has_next = S.next(ui + 1, nxt);
        const char* nA = has_next ? (const char*)g.A + (size_t)nxt.pm * tstep : cA; const char* nB = has_next ? (const char*)g.Bt + (size_t)nxt.pn * tstep : cB;
        for (int t = 0; t < nt; t += 2) {
            const bool last = (t == nt - 2);
            const char* a1 = cA + (size_t)(t + 1) * kstep;
            const char* a2 = last ? nA : cA + (size_t)(t + 2) * kstep; const char* b2 = last ? nB : cB + (size_t)(t + 2) * kstep;
            const char* a3 = a2 + kstep; const char* b3 = b2 + kstep;
            if (last && has_next) S.a_ready(nxt);
            if constexpr (SP2) {
            PG8_LDB(B0, 0, 0); PG8_LDB(B1, 0, 1); PG8_SCHED; PG8_LDA(At, 0, 0); PG8_STAGE(PG8_SA(1, 1), a1 + hstep, voffA);
            PG8_WAIT_V(8); PG8_WAIT_L(0); PG8_BAR; PG8_MMA(0, 0, At, B0); PG8_MMA(0, 1, At, B1); PG8_BAR; PG8_SCHED;
            PG8_LDA(At, 0, 1); PG8_STAGE(PG8_SB(0, 0), b2, voffB); PG8_STAGE(PG8_SB(0, 1), b2 + hstep, voffB); PG8_STAGE(PG8_SA(0, 0), a2, voffA);
            PG8_WAIT_V(8); PG8_WAIT_L(0); PG8_BAR; PG8_MMA(1, 0, At, B0); PG8_MMA(1, 1, At, B1); PG8_BAR; PG8_SCHED;
            PG8_LDB(B0, 1, 0); PG8_LDB(B1, 1, 1); PG8_SCHED; PG8_LDA(At, 1, 0); PG8_STAGE(PG8_SA(0, 1), a2 + hstep, voffA);
            PG8_WAIT_V(8); PG8_WAIT_L(0); PG8_BAR; PG8_MMA(0, 0, At, B0); PG8_MMA(0, 1, At, B1); PG8_BAR; PG8_SCHED;
            PG8_LDA(At, 1, 1); PG8_STAGE(PG8_SB(1, 0), b3, voffB); PG8_STAGE(PG8_SB(1, 1), b3 + hstep, voffB); PG8_STAGE(PG8_SA(1, 0), a3, voffA);
            PG8_WAIT_V(8); PG8_WAIT_L(0); PG8_BAR; PG8_MMA(1, 0, At, B0); PG8_MMA(1, 1, At, B1); PG8_BAR; PG8_SCHED;
            } else {
            PG8_LDB(B0, 0, 0); PG8_SCHED; PG8_LDA(At, 0, 0); PG8_STAGE(PG8_SA(1, 1), a1 + hstep, voffA);
            PG8_WAIT_L(8); PG8_BAR; PG8_WAIT_L(0); PG8_MMA(0, 0, At, B0); PG8_BAR; PG8_SCHED;
            PG8_LDB(B1, 0, 1); PG8_STAGE(PG8_SB(0, 0), b2, voffB);
            PG8_BAR; PG8_WAIT_L(0); PG8_MMA(0, 1, At, B1); PG8_BAR;
            PG8_LDA(At, 0, 1); PG8_STAGE(PG8_SA(0, 0), a2, voffA);
            PG8_BAR; PG8_WAIT_L(0); PG8_MMA(1, 0, At, B0); PG8_BAR; PG8_SCHED;
            PG8_STAGE(PG8_SB(0, 1), b2 + hstep, voffB);
            PG8_WAIT_V(6); PG8_BAR; PG8_MMA(1, 1, At, B1); PG8_BAR;
            PG8_LDB(B0, 1, 0); PG8_SCHED; PG8_LDA(At, 1, 0); PG8_STAGE(PG8_SA(0, 1), a2 + hstep, voffA);
            PG8_WAIT_L(8); PG8_BAR; PG8_WAIT_L(0); PG8_MMA(0, 0, At, B0); PG8_BAR; PG8_SCHED;
            PG8_LDB(B1, 1, 1); PG8_STAGE(PG8_SB(1, 0), b3, voffB);
            PG8_BAR; PG8_WAIT_L(0); PG8_MMA(0, 1, At, B1); PG8_BAR;
            PG8_LDA(At, 1, 1); PG8_STAGE(PG8_SA(1, 0), a3, voffA);
            PG8_BAR; PG8_WAIT_L(0); PG8_MMA(1, 0, At, B0); PG8_BAR; PG8_SCHED;
            PG8_STAGE(PG8_SB(1, 1), b3 + hstep, voffB);
            PG8_WAIT_V(6); PG8_BAR; PG8_MMA(1, 1, At, B1); PG8_BAR;
            }
        }
        if constexpr (ALIGN_EPI) { if (wr == 0) PG8_BAR; }
        if constexpr (!Epi::AFTER_DRAIN) { E(acc, cur, wr, wc, fr, fq); S.done(cur); }
        if (!has_next) break;
#pragma unroll
        for (int a = 0; a < 2; ++a)
#pragma unroll
            for (int b = 0; b < 2; ++b)
#pragma unroll
                for (int m = 0; m < 4; ++m)
#pragma unroll
                    for (int n = 0; n < 2; ++n) acc[a][b][m][n] = (f32x4){0.f, 0.f, 0.f, 0.f};
        cur = nxt; cA = nA; cB = nB; ++ui;
        if constexpr (ALIGN_EPI) { if (wr == 1) PG8_BAR; }
    }
    PG8_WAIT_V(0);
    if constexpr (!ALIGN_EPI) { if (wr == 0) PG8_BAR; }
    PG8_BAR;
    if constexpr (Epi::AFTER_DRAIN) { E.fused(acc, cur, wr, wc, fr, fq, lds, wid, lane); S.done(cur); }
#undef PG8_SA
#undef PG8_SB
#undef PG8_STAGE
#undef PG8_LDA
#undef PG8_LDB
#undef PG8_MMA
#undef PG8_WAIT_V
#undef PG8_WAIT_L
#undef PG8_BAR
#undef PG8_SCHED
}
}

#define LAS __attribute__((address_space(3)))
typedef unsigned short bf16;
typedef short bf16x8 __attribute__((ext_vector_type(8)));
typedef float f32x4 __attribute__((ext_vector_type(4)));
typedef float f32x16 __attribute__((ext_vector_type(16)));
typedef unsigned u32x4 __attribute__((ext_vector_type(4)));
typedef unsigned u32x2 __attribute__((ext_vector_type(2)));
typedef float f32x2_t __attribute__((ext_vector_type(2)));
typedef __bf16 bf16x2_t __attribute__((ext_vector_type(2)));
#define MFMA32(a, b, c) __builtin_amdgcn_mfma_f32_32x32x16_bf16((a), (b), (c), 0, 0, 0)
__device__ __forceinline__ unsigned cvtpk(float lo, float hi) { f32x2_t v = {lo, hi}; bf16x2_t b = __builtin_convertvector(v, bf16x2_t); return __builtin_bit_cast(unsigned, b); }
__device__ __forceinline__ float bflo(unsigned w) { return __uint_as_float(w << 16); }
__device__ __forceinline__ float bfhi(unsigned w) { return __uint_as_float(w & 0xffff0000u); }
__device__ __forceinline__ int crow(int i, int hh) { return (i & 3) + 8 * (i >> 2) + 4 * hh; }
__device__ __forceinline__ int pi32(int r) { return (r & ~12) | ((r & 4) << 1) | ((r & 8) >> 1); }
__device__ __forceinline__ bf16x8 packf(const f32x16& s, int half) {
    u32x4 w;
    if (half == 0) { w.x = cvtpk(s[0], s[1]); w.y = cvtpk(s[2], s[3]); w.z = cvtpk(s[4], s[5]); w.w = cvtpk(s[6], s[7]); }
    else { w.x = cvtpk(s[8], s[9]); w.y = cvtpk(s[10], s[11]); w.z = cvtpk(s[12], s[13]); w.w = cvtpk(s[14], s[15]); }
    return __builtin_bit_cast(bf16x8, w);
}
__device__ __forceinline__ float wave_sum(float v) { v = XSUM_SWZ(v, 1); v = XSUM_SWZ(v, 2); v = XSUM_SWZ(v, 4); v = XSUM_SWZ(v, 8); v = XSUM_SWZ(v, 16); return xsum32(v); }
__device__ __forceinline__ float wave_max(float v) { v = XMAX_SWZ(v, 1); v = XMAX_SWZ(v, 2); v = XMAX_SWZ(v, 4); v = XMAX_SWZ(v, 8); v = XMAX_SWZ(v, 16); return xmax32(v); }
__device__ __forceinline__ void glds16(const void* g, LAS unsigned char* l) { __builtin_amdgcn_global_load_lds((const unsigned*)g, (LAS unsigned*)l, 16, 0, 0); }

constexpr int NTOK = 16384, SEQ = 8192, DM = 1024, FFH = 2816, MEML = 256;
constexpr float EPS = 1e-6f;
constexpr float LOG2E = 1.4426950408889634f;
constexpr size_t MiB = 1u << 20;
constexpr size_t WS_SSQ1 = 0, WS_SSQ2 = 65536, WS_RSTD1 = 131072, WS_RSTDM = 196608;
constexpr size_t WS_CS = 1 * MiB;
constexpr size_t WS_WN = 3 * MiB;
constexpr size_t WS_WTR = 8 * MiB;
constexpr size_t WS_WOUT = 11 * MiB, WS_XQ = 13 * MiB, WS_XKV = 15 * MiB, WS_XO = 19 * MiB;
constexpr size_t WS_WGU = 21 * MiB;
constexpr size_t WS_WD = 32 * MiB;
constexpr size_t WS_XB = 38 * MiB;
constexpr size_t WS_PROJ = 70 * MiB;
constexpr size_t WS_TR = 150 * MiB;
constexpr size_t WS_MIX = 198 * MiB;
constexpr size_t WS_KVS = 230 * MiB;
constexpr size_t WS_K2 = 246 * MiB, WS_V2T = 247 * MiB, WS_MEMB = 248 * MiB, WS_PARTL = 249 * MiB;
constexpr size_t WS_BAR = 250 * MiB;
constexpr size_t WS_END = 256 * MiB;
constexpr int LDS_BYTES = 147456;

struct Params { const float* in[21]; float* out; unsigned char* ws; int use_cg; int pad; };

template <int NCH> __device__ __forceinline__ void otile_put(LAS unsigned char* stg, int r, int hh, int chunk, u32x2 w) { *(LAS u32x2*)(stg + r * (NCH * 16) + ((chunk ^ (r & (NCH - 1))) << 4) + hh * 8) = w; }
template <int NCH> __device__ __forceinline__ void otile_flush(const LAS unsigned char* stg, bf16* g, int ld, int lane_) {
    int lane = lane_; asm volatile("" : "+v"(lane));
#pragma unroll
    for (int i = 0; i < NCH / 2; ++i) { const int row = i * (64 / NCH) + lane / NCH, chunk = lane % NCH;
        const u32x4 v = *(const LAS u32x4*)(stg + row * (NCH * 16) + ((chunk ^ (row & (NCH - 1))) << 4));
        *(u32x4*)(g + (size_t)row * ld + chunk * 8) = v; }
}

__device__ __forceinline__ int rperm32(int c) { return 256 * (c >> 8) + 128 * ((c & 63) >> 5) + 32 * ((c & 255) >> 6); }
struct TrDesc { const float* W; const float* gain; bf16* D0; bf16* D1; int K, N, d0, d1, item; };
__device__ __forceinline__ void tr_load(const TrDesc& t, float (&wv)[32], int lane) {
    const int nblk = t.N / 32, kb = t.item / nblk, nb = t.item % nblk, k0 = 64 * kb, n0 = 32 * nb;
#pragma unroll
    for (int i = 0; i < 32; ++i) { const int kk = 2 * i + (lane >> 5); wv[i] = __builtin_nontemporal_load(t.W + (size_t)(k0 + kk) * t.N + n0 + (lane & 31)); }
}
__device__ __forceinline__ void tr_store(const TrDesc& t, const float (&wv)[32], LAS float* scr, int lane) {
    const int nblk = t.N / 32, kb = t.item / nblk, k0 = 64 * kb;
#pragma unroll
    for (int i = 0; i < 32; ++i) { const int kk = 2 * i + (lane >> 5); const float g = t.gain ? t.gain[k0 + kk] : 1.0f; scr[kk * 33 + (lane & 31)] = wv[i] * g; }
    asm volatile("s_waitcnt lgkmcnt(0)" ::: "memory");
    const int c = lane & 7;
#pragma unroll
    for (int j = 0; j < 4; ++j) { const int n = (lane >> 3) + 8 * j; const LAS float* s = scr + (8 * c) * 33 + n;
        u32x4 o; o.x = cvtpk(s[0 * 33], s[1 * 33]); o.y = cvtpk(s[2 * 33], s[3 * 33]); o.z = cvtpk(s[4 * 33], s[5 * 33]); o.w = cvtpk(s[6 * 33], s[7 * 33]);
        if (t.D0) *(u32x4*)(t.D0 + (size_t)(t.d0 + n) * t.K + k0 + 8 * c) = o;
        if (t.D1) *(u32x4*)(t.D1 + (size_t)(t.d1 + n) * t.K + k0 + 8 * c) = o; }
    asm volatile("s_waitcnt lgkmcnt(0)" ::: "memory");
}
__device__ __forceinline__ TrDesc tr_decode(const Params& P, int it) {
    unsigned char* ws = P.ws; bf16* WN = (bf16*)(ws + WS_WN); bf16* WTR = (bf16*)(ws + WS_WTR);
    constexpr int I0 = 16 * 112, I1 = 512, I2 = 512, I3 = 16 * 64, I4 = 512, I5 = 16 * 88, I6 = 16 * 88;
    TrDesc t; t.D1 = nullptr; t.d1 = 0; t.K = 1024; int r = it;
    if (r < I0) { const int n0 = 32 * (r % 112), seg = n0 >> 9, wi = n0 & 511;
        t.W = P.in[3]; t.N = 3584; t.gain = P.in[2]; t.D0 = nullptr; t.d0 = 0; t.item = r;
        if (seg == 0) { t.D0 = WN; t.d0 = rperm32(wi); }
        else if (seg == 1) { t.D0 = WN; t.d0 = 512 + rperm32(wi); t.D1 = WTR; t.d1 = rperm32(wi); }
        else if (seg == 2) { t.D1 = WTR; t.d1 = 512 + wi; }
        else if (seg == 3) { t.D0 = WN; t.d0 = 1024 + wi; }
        else if (seg == 4) { t.D0 = WN; t.d0 = 1536 + rperm32(wi); }
        else if (seg == 5) { t.D0 = WN; t.d0 = 2048 + rperm32(wi); }
        else { t.D1 = WTR; t.d1 = 1024 + wi; }
        return t; }
    r -= I0;
    if (r < I1) { t.W = P.in[9]; t.N = 1024; t.gain = P.in[8]; t.D0 = (bf16*)(ws + WS_WOUT); t.d0 = 32 * (r % 32); t.item = r; return t; } r -= I1;
    if (r < I2) { t.W = P.in[12]; t.N = 1024; t.gain = P.in[10]; t.D0 = (bf16*)(ws + WS_XQ); t.d0 = 32 * (r % 32); t.item = r; return t; } r -= I2;
    if (r < I3) { t.W = P.in[13]; t.N = 2048; t.gain = P.in[11]; t.D0 = (bf16*)(ws + WS_XKV); t.d0 = 32 * (r % 64); t.item = r; return t; } r -= I3;
    if (r < I4) { t.W = P.in[16]; t.N = 1024; t.gain = nullptr; t.D0 = (bf16*)(ws + WS_XO); t.d0 = 32 * (r % 32); t.item = r; return t; } r -= I4;
    if (r < I5) { const int n0 = 32 * (r % 88); t.W = P.in[18]; t.N = 2816; t.gain = P.in[17]; t.D0 = (bf16*)(ws + WS_WGU); t.d0 = (n0 >> 7) * 256 + (n0 & 127); t.item = r; return t; } r -= I5;
    if (r < I6) { const int n0 = 32 * (r % 88); t.W = P.in[19]; t.N = 2816; t.gain = P.in[17]; t.D0 = (bf16*)(ws + WS_WGU); t.d0 = (n0 >> 7) * 256 + 128 + (n0 & 127); t.item = r; return t; } r -= I6;
    t.W = P.in[20]; t.K = 2816; t.N = 1024; t.gain = nullptr; t.D0 = (bf16*)(ws + WS_WD); t.d0 = 32 * (r % 32); t.item = r; return t;
}
template <int NR> __device__ __forceinline__ void rows_to_bf16(const float* x, bf16* o, float* rstd_out, int m0, int mstride, int lane) {
    f32x4 v[NR][4]; float s[NR];
#pragma unroll
    for (int q = 0; q < NR; ++q) { const f32x4* xr = (const f32x4*)(x + (size_t)(m0 + q * mstride) * DM) + lane;
#pragma unroll
        for (int j = 0; j < 4; ++j) v[q][j] = __builtin_nontemporal_load(xr + 64 * j); }
#pragma unroll
    for (int q = 0; q < NR; ++q) { float a = 0.f;
#pragma unroll
        for (int j = 0; j < 4; ++j) a += (v[q][j][0] * v[q][j][0] + v[q][j][1] * v[q][j][1]) + (v[q][j][2] * v[q][j][2] + v[q][j][3] * v[q][j][3]);
        s[q] = wave_sum(a); }
#pragma unroll
    for (int q = 0; q < NR; ++q) { u32x2* o8 = (u32x2*)(o + (size_t)(m0 + q * mstride) * DM) + lane;
#pragma unroll
        for (int j = 0; j < 4; ++j) { u32x2 w; w.x = cvtpk(v[q][j][0], v[q][j][1]); w.y = cvtpk(v[q][j][2], v[q][j][3]); o8[64 * j] = w; }
        if (lane == 0) rstd_out[m0 + q * mstride] = rsqrtf(s[q] * (1.0f / 1024.0f) + EPS); }
}
__device__ __forceinline__ void p0_prologue(const Params& P, LAS unsigned char* lds, int wid_s) {
    const int lane = lane_id_asm(), wid = wid_s, tid = wid * 64 + lane;
    const int gw = blockIdx.x * 8 + wid, NGW = gridDim.x * 8;
    unsigned char* ws = P.ws;
    LAS float* scr = (LAS float*)(lds + wid * 16384);
    constexpr int NIT = 16 * 112 + 512 + 512 + 16 * 64 + 512 + 16 * 88 + 16 * 88 + 44 * 32;
    if (gw < NIT) {
        int it = gw; TrDesc cur = tr_decode(P, it); float a[32]; tr_load(cur, a, lane);
        for (;;) {
            const int nx = it + NGW; const bool has = nx < NIT; TrDesc nxt = cur; float bnx[32];
            if (has) { nxt = tr_decode(P, nx); tr_load(nxt, bnx, lane); }
            tr_store(cur, a, scr, lane);
            if (!has) break;
            cur = nxt; it = nx;
#pragma unroll
            for (int i = 0; i < 32; ++i) a[i] = bnx[i];
        }
    }
    {   int m = gw;
        for (; m + 7 * NGW < NTOK; m += 8 * NGW) rows_to_bf16<8>(P.in[0], (bf16*)(ws + WS_XB), (float*)(ws + WS_RSTD1), m, NGW, lane);
        for (; m + 3 * NGW < NTOK; m += 4 * NGW) rows_to_bf16<4>(P.in[0], (bf16*)(ws + WS_XB), (float*)(ws + WS_RSTD1), m, NGW, lane);
        for (; m < NTOK; m += NGW) rows_to_bf16<1>(P.in[0], (bf16*)(ws + WS_XB), (float*)(ws + WS_RSTD1), m, NGW, lane); }
    for (int m = gw; m < 2 * MEML; m += NGW) rows_to_bf16<1>(P.in[1], (bf16*)(ws + WS_MEMB), (float*)(ws + WS_RSTDM), m, NGW, lane);
    const int gt = blockIdx.x * 512 + tid, NGT = gridDim.x * 512;
    for (int e = gt; e < SEQ * 32; e += NGT) {
        const int pos = e >> 5, i = e & 31;
        const float inv = 1.0f / exp2f((float)i * (1.0f / 31.0f) * 13.287712379549449f);
        const float ang = (float)pos * inv;
        double t = (double)ang * 0.15915494309189535; t -= floor(t);
        const float tf = (float)t;
        float2 v; v.x = __builtin_amdgcn_cosf(tf); v.y = __builtin_amdgcn_sinf(tf);
        ((float2*)(ws + WS_CS))[e] = v;
    }
    for (int e = gt; e < NTOK; e += NGT) { ((float*)(ws + WS_SSQ1))[e] = 0.f; ((float*)(ws + WS_SSQ2))[e] = 0.f; }
}

__device__ __forceinline__ float ret_l2g(int h) { return log1pf(-exp2f(-5.0f - (float)h)) * LOG2E; }
__device__ __forceinline__ void ret_kv_phase(const Params& P, int wid_s) {
    const int lane = lane_id_asm(), wid = wid_s, tid = wid * 64 + lane, r = lane & 31, hh = lane >> 5;
    const bf16* TR = (const bf16*)(P.ws + WS_TR); float* KVS = (float*)(P.ws + WS_KVS);
    for (int pair = blockIdx.x; pair < 512; pair += gridDim.x) {
        const int chunk = pair * 2 + (wid >> 2), j = wid & 3, bh = chunk >> 6, n = chunk & 63, b = bh >> 3, h = bh & 7, a = j >> 1, bb = j & 1;
        const size_t tok0 = (size_t)b * SEQ + n * 128;
        const bf16* vt = TR + (size_t)(512 + h * 64 + 32 * a + r) * NTOK + tok0 + 8 * hh;
        const bf16* kt = TR + (size_t)(h * 64 + 32 * bb + r) * NTOK + tok0 + 8 * hh;
        f32x16 acc = {};
#pragma unroll
        for (int s = 0; s < 8; ++s) acc = MFMA32(*(const bf16x8*)(vt + 16 * s), *(const bf16x8*)(kt + 16 * s), acc);
        float* dst = KVS + (size_t)chunk * 4096 + (32 * a) * 64 + 32 * bb + r;
#pragma unroll
        for (int i = 0; i < 16; ++i) dst[crow(i, hh) * 64] = acc[i];
    }
}
__device__ __forceinline__ void ret_scan_phase(const Params& P, int wid_s) {
    float* KVS = (float*)(P.ws + WS_KVS);
    if (wid_s >= 4) return;
    for (int e = blockIdx.x * 256 + wid_s * 64 + lane_id_asm(); e < 16 * 4096; e += gridDim.x * 256) {
        const int bh = e >> 12, el = e & 4095, h = bh & 7;
        const float gC = exp2f(128.0f * ret_l2g(h));
        unsigned idx = (unsigned)(bh * 64 * 4096 + el); float R = 0.f;
        for (int n0 = 0; n0 < 64; n0 += 16) { float t[16];
#pragma unroll
            for (int k = 0; k < 16; ++k) t[k] = __builtin_nontemporal_load(KVS + idx + (unsigned)(k * 4096));
#pragma unroll
            for (int k = 0; k < 16; ++k) { KVS[idx + (unsigned)(k * 4096)] = R; R = R * gC + t[k]; }
            idx += 16 * 4096; }
    }
}
template <int MODE = 0> __device__ __forceinline__ void ret_out_phase(const Params& P, LAS unsigned char* lds, int wid_s) {
    const int lane = lane_id_asm(), wid = wid_s, r = lane & 31, hh = lane >> 5;
    const bf16* PROJ = (const bf16*)(P.ws + WS_PROJ); const bf16* TR = (const bf16*)(P.ws + WS_TR); const float* KVS = (const float*)(P.ws + WS_KVS); bf16* MIX = (bf16*)(P.ws + WS_MIX);
    const int cg = wid >> 2, j = wid & 3, tl = j * 64 + lane;
    LAS unsigned char* base = lds + cg * 65536;
    for (int pair = blockIdx.x; pair < 512; pair += gridDim.x) {
        const int chunk = pair * 2 + cg, bh = chunk >> 6, n = chunk & 63, b = bh >> 3, h = bh & 7;
        const size_t tok0 = (size_t)b * SEQ + n * 128; const int c0 = 32 * j;
        const float l2g = ret_l2g(h);
        __syncthreads();
        {   u32x4 t0_[4], t1_[4], t2_[4], t3_[4];
#pragma unroll
            for (int k = 0; k < 4; ++k) { const int idx = tl + 256 * k, row = idx >> 3, piece = idx & 7; const bf16* src = PROJ + (tok0 + row) * 2560 + h * 64 + piece * 8;
                t0_[k] = __builtin_nontemporal_load((const u32x4*)(src)); t1_[k] = __builtin_nontemporal_load((const u32x4*)(src + 512)); t2_[k] = __builtin_nontemporal_load((const u32x4*)(src + 1024));
                const int vrow = idx >> 4, vpiece = idx & 15; t3_[k] = __builtin_nontemporal_load((const u32x4*)(TR + (size_t)(512 + h * 64 + vrow) * NTOK + tok0 + vpiece * 8)); }
#pragma unroll
            for (int k = 0; k < 4; ++k) { const int idx = tl + 256 * k, row = idx >> 3, piece = idx & 7; const int off = row * 128 + ((piece ^ ((row >> 1) & 7)) << 4);
                *(LAS u32x4*)(base + off) = t0_[k]; *(LAS u32x4*)(base + 16384 + off) = t1_[k]; *(LAS u32x4*)(base + 32768 + off) = t2_[k];
                const int vrow = idx >> 4, vpiece = idx & 15; *(LAS u32x4*)(base + 49152 + vrow * 256 + ((vpiece ^ (vrow & 15)) << 4)) = t3_[k]; }
        }
        __syncthreads();
        bf16x8 qf[4];
        { const int row = c0 + r;
#pragma unroll
          for (int d0 = 0; d0 < 4; ++d0) qf[d0] = *(const LAS bf16x8*)(base + row * 128 + (((2 * d0 + hh) ^ ((row >> 1) & 7)) << 4)); }
        f32x16 o[2]; o[0] = f32x16{}; o[1] = f32x16{};
        for (int jb = 0; jb <= j; ++jb) {
            const int krow = 32 * jb + pi32(r);
            f32x16 S = {};
#pragma unroll
            for (int d0 = 0; d0 < 4; ++d0) S = MFMA32(*(const LAS bf16x8*)(base + 16384 + krow * 128 + (((2 * d0 + hh) ^ ((krow >> 1) & 7)) << 4)), qf[d0], S);
#pragma unroll
            for (int i = 0; i < 16; ++i) { const int kvi = 32 * jb + 16 * (i >> 3) + 8 * hh + (i & 7); const int rel = (c0 + r) - kvi;
                S[i] = rel >= 0 ? S[i] * __builtin_amdgcn_exp2f(l2g * (float)rel) : 0.f; }
            const bf16x8 pk0 = packf(S, 0), pk1 = packf(S, 1);
#pragma unroll
            for (int a = 0; a < 2; ++a) { const int vrow = 32 * a + r;
                o[a] = MFMA32(*(const LAS bf16x8*)(base + 49152 + vrow * 256 + (((4 * jb + hh) ^ (vrow & 15)) << 4)), pk0, o[a]);
                o[a] = MFMA32(*(const LAS bf16x8*)(base + 49152 + vrow * 256 + (((4 * jb + 2 + hh) ^ (vrow & 15)) << 4)), pk1, o[a]); }
        }
        const float xi = exp2f(l2g * (float)(c0 + r + 1));
#pragma unroll
        for (int a = 0; a < 2; ++a) { f32x16 t = {}; const float* rp = KVS + (size_t)chunk * 4096 + (32 * a + r) * 64 + 8 * hh;
#pragma unroll
            for (int d0 = 0; d0 < 4; ++d0) { const f32x4 lo = __builtin_nontemporal_load((const f32x4*)(rp + 16 * d0)), hi4 = __builtin_nontemporal_load((const f32x4*)(rp + 16 * d0 + 4));
                u32x4 w; w.x = cvtpk(lo[0], lo[1]); w.y = cvtpk(lo[2], lo[3]); w.z = cvtpk(hi4[0], hi4[1]); w.w = cvtpk(hi4[2], hi4[3]);
                t = MFMA32(__builtin_bit_cast(bf16x8, w), qf[d0], t); }
#pragma unroll
            for (int i = 0; i < 16; ++i) o[a][i] += t[i] * xi; }
        float ss = 0.f;
#pragma unroll
        for (int a = 0; a < 2; ++a)
#pragma unroll
            for (int i = 0; i < 16; ++i) ss += o[a][i] * o[a][i];
        ss = xsum32(ss);
        const float rr = rsqrtf(ss * (1.0f / 64.0f) + EPS);
        LAS unsigned char* stg = base + c0 * 128;
        { const int row = c0 + r;
#pragma unroll
          for (int a = 0; a < 2; ++a)
#pragma unroll
              for (int g = 0; g < 4; ++g) {
                  const u32x2 gw = *(const LAS u32x2*)(base + 32768 + row * 128 + (((4 * a + g) ^ ((row >> 1) & 7)) << 4) + hh * 8);
                  u32x2 w; w.x = cvtpk(o[a][4 * g] * rr * bflo(gw.x), o[a][4 * g + 1] * rr * bfhi(gw.x)); w.y = cvtpk(o[a][4 * g + 2] * rr * bflo(gw.y), o[a][4 * g + 3] * rr * bfhi(gw.y));
                  otile_put<8>(stg, r, hh, 4 * a + g, w); } }
        otile_flush<8>(stg, MIX + (tok0 + c0) * 1024 + h * 64, 1024, lane);
    }
    __syncthreads();
}

struct DiffCtx { const bf16* PROJ; const bf16* TR; bf16* MIX; float* partO0; float* partO1; float* partL0; float* partL1; unsigned* flags; const float* subln; float lam; float shift; };
__device__ __forceinline__ void diff_epilogue(f32x16 (&o)[4], const DiffCtx& C, size_t tokw, int h, int lane, LAS unsigned char* stg) {
    const int r = lane & 31, hh = lane >> 5;
    float ss = 0.f;
#pragma unroll
    for (int db = 0; db < 4; ++db)
#pragma unroll
        for (int i = 0; i < 16; ++i) ss += o[db][i] * o[db][i];
    ss = xsum32(ss);
    const float rr = rsqrtf(ss * (1.0f / 128.0f) + EPS) * 0.8f;
#pragma unroll
    for (int db = 0; db < 4; ++db)
#pragma unroll
        for (int g = 0; g < 4; ++g) { const int d = 32 * db + 8 * g + 4 * hh; const f32x4 sg = *(const f32x4*)(C.subln + d);
            u32x2 w; w.x = cvtpk(o[db][4 * g] * rr * sg[0], o[db][4 * g + 1] * rr * sg[1]); w.y = cvtpk(o[db][4 * g + 2] * rr * sg[2], o[db][4 * g + 3] * rr * sg[3]);
            otile_put<16>(stg, r, hh, 4 * db + g, w); }
    otile_flush<16>(stg, C.MIX + tokw * 1024 + 512 + h * 128, 1024, lane);
}
template <bool SHIFT, int MODE = 0> __device__ __forceinline__ void diff_segment(const DiffCtx& C, LAS unsigned char* lds, int b, int h, int qb, int t0, int t1, int outmode, int unitidx, int wid_s) {
    const int lane = lane_id_asm(), wid = wid_s, r = lane & 31, hh = lane >> 5;
    const int q0 = 256 * qb + 32 * wid; const size_t tokbase = (size_t)b * SEQ;
    bf16x8 qf[2][4];
    { const bf16* qp = C.PROJ + (tokbase + q0 + r) * 2560 + 1536 + h * 128 + 8 * hh;
#pragma unroll
      for (int mp = 0; mp < 2; ++mp)
#pragma unroll
          for (int d0 = 0; d0 < 4; ++d0) qf[mp][d0] = *(const bf16x8*)(qp + mp * 64 + d0 * 16); }
    f32x16 o[2][4];
#pragma unroll
    for (int mp = 0; mp < 2; ++mp)
#pragma unroll
        for (int db = 0; db < 4; ++db) o[mp][db] = f32x16{};
    float l0 = 0.f, l1 = 0.f;
    unsigned kg[4], vg[4];
    const bf16* kbase = C.PROJ + tokbase * 2560 + 2048 + h * 128; const bf16* vbase = C.TR + (size_t)(1024 + h * 128) * NTOK + tokbase;
#pragma unroll
    for (int j = 0; j < 4; ++j) { const int c = wid * 4 + j, row = 4 * c + (lane >> 4), pc = (lane & 15) ^ (row & 15);
        kg[j] = (unsigned)(row * 2560 + pc * 8); vg[j] = (unsigned)(row * NTOK + pc * 8); }
#define DIFF_STAGE(t, buf) do { _Pragma("unroll") for (int j_ = 0; j_ < 4; ++j_) { \
        glds16(kbase + (size_t)(t) * 128 * 2560 + kg[j_], lds + (buf) * 65536 + (wid * 4 + j_) * 1024); \
        glds16(vbase + (size_t)(t) * 128 + vg[j_], lds + (buf) * 65536 + 32768 + (wid * 4 + j_) * 1024); } } while (0)
    DIFF_STAGE(t0, 0);
    for (int t = t0; t < t1; ++t) {
        const int buf = (t - t0) & 1;
        asm volatile("s_waitcnt vmcnt(0)" ::: "memory"); __syncthreads();
        if (t + 1 < t1) DIFF_STAGE(t + 1, buf ^ 1);
        const int k0 = 128 * t;
        if (k0 <= q0 + 31) {
            const LAS unsigned char* Kb = lds + buf * 65536; const LAS unsigned char* Vb = Kb + 32768;
            const bool needmask = (k0 + 127 > q0);
#pragma unroll
            for (int kb = 0; kb < 4; ++kb) {
                if (k0 + 32 * kb <= q0 + 31) {
                const int krow = 32 * kb + pi32(r);
                bf16x8 pk[2][2];
#pragma unroll
                for (int mp = 0; mp < 2; ++mp) {
                    f32x16 S = {};
#pragma unroll
                    for (int d0 = 0; d0 < 4; ++d0) { const int piece = mp * 8 + 2 * d0 + hh;
                        const bf16x8 kf = *(const LAS bf16x8*)(Kb + krow * 256 + ((piece ^ (krow & 15)) << 4));
                        S = MFMA32(kf, qf[mp][d0], S); }
                    float ls = 0.f;
#pragma unroll
                    for (int i = 0; i < 16; ++i) { float p = __builtin_amdgcn_exp2f(SHIFT ? S[i] - C.shift : S[i]);
                        if (needmask) { const int kv = k0 + 32 * kb + 16 * (i >> 3) + 8 * hh + (i & 7); if (kv > q0 + r) p = 0.f; }
                        S[i] = p; ls += p; }
                    if (mp == 0) l0 += ls; else l1 += ls;
                    pk[mp][0] = packf(S, 0); pk[mp][1] = packf(S, 1);
                }
#pragma unroll
                for (int db = 0; db < 4; ++db) { const int vrow = 32 * db + r;
#pragma unroll
                    for (int s2 = 0; s2 < 2; ++s2) { const int piece = 2 * (2 * kb + s2) + hh;
                        const bf16x8 vf = *(const LAS bf16x8*)(Vb + vrow * 256 + ((piece ^ (vrow & 15)) << 4));
                        o[0][db] = MFMA32(vf, pk[0][s2], o[0][db]); o[1][db] = MFMA32(vf, pk[1][s2], o[1][db]); } }
                }
            }
        }
    }
#undef DIFF_STAGE
    __syncthreads();
    l0 = xsum32(l0); l1 = xsum32(l1);
    if (outmode == 2) {
        if (wid == 0 && lane == 0) { unsigned sp = 0; while (__hip_atomic_load(C.flags + 64 * unitidx, __ATOMIC_RELAXED, __HIP_MEMORY_SCOPE_AGENT) == 0u && ++sp < (1u << 22)) __builtin_amdgcn_s_sleep(1);
            __builtin_amdgcn_fence(__ATOMIC_ACQUIRE, "agent"); asm volatile("s_waitcnt vmcnt(0)" ::: "memory"); }
        __syncthreads();
        const float* po = C.partO0 + (size_t)(unitidx * 8 + wid) * 8192 + lane;
#pragma unroll
        for (int mp = 0; mp < 2; ++mp)
#pragma unroll
            for (int db = 0; db < 4; ++db) { const float* pp = po + (mp * 4 + db) * 1024; asm volatile("" : "+v"(pp));
#pragma unroll
                for (int i = 0; i < 16; ++i) o[mp][db][i] += __builtin_nontemporal_load(pp + i * 64); }
        const float* pl = C.partL0 + (size_t)(unitidx * 8 + wid) * 128 + lane; l0 += pl[0]; l1 += pl[64];
    }
    if (outmode != 1) { const float i0 = 1.0f / l0, i1 = C.lam / l1;
#pragma unroll
        for (int db = 0; db < 4; ++db)
#pragma unroll
            for (int i = 0; i < 16; ++i) o[0][db][i] = o[0][db][i] * i0 - o[1][db][i] * i1;
        diff_epilogue(o[0], C, tokbase + q0, h, lane, lds + wid * 8192); }
    else {
        float* po = C.partO0 + (size_t)(unitidx * 8 + wid) * 8192 + lane;
#pragma unroll
        for (int mp = 0; mp < 2; ++mp)
#pragma unroll
            for (int db = 0; db < 4; ++db) { float* pp = po + (mp * 4 + db) * 1024; asm volatile("" : "+v"(pp));
#pragma unroll
                for (int i = 0; i < 16; ++i) __builtin_nontemporal_store(o[mp][db][i], pp + i * 64); }
        float* pl = C.partL0 + (size_t)(unitidx * 8 + wid) * 128 + lane; pl[0] = l0; pl[64] = l1;
    }
    asm volatile("s_waitcnt vmcnt(0)" ::: "memory");
    __syncthreads();
    if (outmode == 1 && wid == 0 && lane == 0) { __builtin_amdgcn_fence(__ATOMIC_RELEASE, "agent"); asm volatile("s_waitcnt vmcnt(0)" ::: "memory");
        (void)__hip_atomic_fetch_add(C.flags + 64 * unitidx, 1u, __ATOMIC_RELAXED, __HIP_MEMORY_SCOPE_AGENT); }
}
__device__ __forceinline__ DiffCtx diff_ctx(const Params& P) {
    const int lane = lane_id_asm();
    DiffCtx C; C.PROJ = (const bf16*)(P.ws + WS_PROJ); C.TR = (const bf16*)(P.ws + WS_TR); C.MIX = (bf16*)(P.ws + WS_MIX);
    C.partO0 = P.out; C.partO1 = (float*)(P.ws + WS_XB); C.partL0 = (float*)(P.ws + WS_PARTL); C.partL1 = (float*)(P.ws + WS_PARTL + 512 * 1024);
    C.subln = P.in[7]; C.flags = (unsigned*)(P.ws + WS_BAR + 16384);
    const float* lv = P.in[6];
    const float s01 = wave_sum(lv[lane] * lv[64 + lane]), s23 = wave_sum(lv[128 + lane] * lv[192 + lane]);
    C.lam = __uint_as_float(__builtin_amdgcn_readfirstlane(__float_as_uint(expf(s01) - expf(s23) + 0.2f)));
    const float mq = wave_max(fabsf(P.in[4][lane])), mk = wave_max(fabsf(P.in[5][lane]));
    C.shift = __uint_as_float(__builtin_amdgcn_readfirstlane(__float_as_uint(fmaxf(mq * mk * 64.0f * (0.125f * LOG2E) - 60.0f, 0.f))));
    return C;
}
__device__ __forceinline__ void diff_phase(const Params& P, LAS unsigned char* lds, int wid_s) {
    const DiffCtx C = diff_ctx(P);
    for (int pass = 0; pass < 2; ++pass)
    for (int v = blockIdx.x; v < 256; v += gridDim.x) {
        const int bh = v & 7, s = v >> 3, b = bh >> 2, h = bh & 3;
        if ((s < 16) != (pass == 0)) continue;
        const int q = s & 15, nseg = s < 16 ? 1 : 2;
        for (int sg = 0; sg < nseg; ++sg) {
            const bool small_ = (s >= 16) && sg == 0;
            const int a_qb = small_ ? q : 31 - q, a_t0 = small_ ? 0 : (s < 16 ? 0 : 33), a_t1 = small_ ? 2 * q + 2 : (s < 16 ? 33 : 64 - 2 * q), a_om = small_ ? 0 : (s < 16 ? 1 : 2), a_ui = bh * 16 + (15 - q);
            if (C.shift == 0.f) diff_segment<false>(C, lds, b, h, a_qb, a_t0, a_t1, a_om, a_ui, wid_s);
            else diff_segment<true>(C, lds, b, h, a_qb, a_t0, a_t1, a_om, a_ui, wid_s);
        }
    }
}
template <int MODE> __device__ __forceinline__ void diff_probe_phase(const Params& P, LAS unsigned char* lds, int wid_s) {
    const DiffCtx C = diff_ctx(P);
    for (int v = blockIdx.x; v < 256; v += gridDim.x) {
        const int bh = v & 7, s = v >> 3, b = bh >> 2, h = bh & 3;
        const int q = s & 15, nseg = s < 16 ? 1 : 2;
        for (int sg = 0; sg < nseg; ++sg) {
            const bool small_ = sg == 1;
            const int a_qb = small_ ? q : 31 - q, a_t0 = small_ ? 0 : (s < 16 ? 0 : 33), a_t1 = small_ ? 2 * q + 2 : (s < 16 ? 33 : 64 - 2 * q), a_om = small_ ? 0 : (s < 16 ? 1 : 2), a_ui = bh * 16 + (15 - q);
            diff_segment<false, MODE>(C, lds, b, h, a_qb, a_t0, a_t1, a_om, a_ui, wid_s);
        }
    }
}
__device__ __forceinline__ void diff_combine_phase(const Params& P, LAS unsigned char* lds, int wid_s) {
    const DiffCtx C = diff_ctx(P);
    const int lane = lane_id_asm(), wid = wid_s, tid = wid * 64 + lane, r = lane & 31, hh = lane >> 5;
    const float* A = C.partO0; const float* B = C.partO1;
    for (int it = blockIdx.x * 8 + wid; it < 1024; it += gridDim.x * 8) {
        const int unitidx = it >> 3, w = it & 7, bh = unitidx >> 4, qb = 16 + (unitidx & 15), b = bh >> 2, h = bh & 3;
        const unsigned base = (unsigned)it * 8192u + (unsigned)lane;
        const float l0 = C.partL0[it * 128 + lane] + C.partL1[it * 128 + lane], l1 = C.partL0[it * 128 + 64 + lane] + C.partL1[it * 128 + 64 + lane];
        const float i0 = 1.0f / l0, i1 = C.lam / l1;
        float ss = 0.f;
#pragma unroll
        for (int db = 0; db < 4; ++db) { unsigned o0 = base + db * 1024, o1 = base + 4096 + db * 1024; asm volatile("" : "+v"(o0), "+v"(o1));
#pragma unroll
            for (int i = 0; i < 16; ++i) { const float v = (A[o0 + i * 64] + B[o0 + i * 64]) * i0 - (A[o1 + i * 64] + B[o1 + i * 64]) * i1; ss += v * v; } }
        ss = xsum32(ss);
        const float rr = rsqrtf(ss * (1.0f / 128.0f) + EPS) * 0.8f;
        LAS unsigned char* stg = lds + wid * 8192;
#pragma unroll
        for (int db = 0; db < 4; ++db) { unsigned o0 = base + db * 1024, o1 = base + 4096 + db * 1024; asm volatile("" : "+v"(o0), "+v"(o1));
#pragma unroll
            for (int g = 0; g < 4; ++g) { const int d = 32 * db + 8 * g + 4 * hh; const f32x4 sg = *(const f32x4*)(C.subln + d); float v[4];
#pragma unroll
                for (int e = 0; e < 4; ++e) { const int i = 4 * g + e; v[e] = ((A[o0 + i * 64] + B[o0 + i * 64]) * i0 - (A[o1 + i * 64] + B[o1 + i * 64]) * i1) * rr * sg[e]; }
                u32x2 wv; wv.x = cvtpk(v[0], v[1]); wv.y = cvtpk(v[2], v[3]); otile_put<16>(stg, r, hh, 4 * db + g, wv); } }
        otile_flush<16>(stg, C.MIX + ((size_t)b * SEQ + 256 * qb + 32 * w) * 1024 + 512 + h * 128, 1024, lane);
    }
    __syncthreads();
}

__device__ __forceinline__ void kv2_phase(const Params& P, int wid_s) {
    const int lane = lane_id_asm(), r = lane & 31, hh = lane >> 5;
    const bf16* MEMB = (const bf16*)(P.ws + WS_MEMB); const bf16* XKV = (const bf16*)(P.ws + WS_XKV); const float* RSTDM = (const float*)(P.ws + WS_RSTDM);
    bf16* K2 = (bf16*)(P.ws + WS_K2); bf16* V2T = (bf16*)(P.ws + WS_V2T);
    if (wid_s < 4) return;
    for (int blk = (wid_s - 4) * gridDim.x + blockIdx.x; blk < 1024; blk += gridDim.x * 4) {
        const bool isv = blk >= 512; const int bb = blk & 511;
        const int rb = isv ? (bb >> 4) : (bb >> 5), cb = isv ? (bb & 15) : (bb & 31);
        const bf16* ap = (isv ? XKV + (size_t)(1024 + 32 * rb + r) * 1024 : MEMB + (size_t)(32 * rb + r) * 1024) + 8 * hh;
        const bf16* bp = (isv ? MEMB + (size_t)(32 * cb + r) * 1024 : XKV + (size_t)(32 * cb + r) * 1024) + 8 * hh;
        f32x16 acc = {};
#pragma unroll 16
        for (int s = 0; s < 64; ++s) acc = MFMA32(*(const bf16x8*)(ap + 16 * s), *(const bf16x8*)(bp + 16 * s), acc);
        if (!isv) {
#pragma unroll
            for (int i = 0; i < 16; ++i) { const int m = 32 * rb + crow(i, hh); const unsigned w = cvtpk(acc[i] * RSTDM[m], 0.f);
                *(unsigned short*)(K2 + (size_t)m * 1024 + 32 * cb + r) = (unsigned short)w; }
        } else { const float rs = RSTDM[32 * cb + r];
#pragma unroll
            for (int i = 0; i < 16; ++i) { const int n = 32 * rb + crow(i, hh); const unsigned w = cvtpk(acc[i] * rs, 0.f);
                *(unsigned short*)(V2T + (size_t)n * 512 + 32 * cb + r) = (unsigned short)w; }
        }
    }
}

__device__ __forceinline__ void knorm_phase(const Params& P, int wid_s) {
    const int lane = lane_id_asm(); bf16* K2 = (bf16*)(P.ws + WS_K2); const float* gk = P.in[15];
    for (int t = blockIdx.x * 8 + wid_s; t < 2 * MEML * 4; t += gridDim.x * 8) {
        bf16* p = K2 + (size_t)(t >> 2) * 1024 + (t & 3) * 256 + 4 * lane;
        const u32x2 raw = *(const u32x2*)p; const f32x4 g = *(const f32x4*)(gk + 4 * lane);
        const float a0 = bflo(raw.x), a1 = bfhi(raw.x), a2 = bflo(raw.y), a3 = bfhi(raw.y);
        const float ss = wave_sum((a0 * a0 + a1 * a1) + (a2 * a2 + a3 * a3));
        const float rk = rsqrtf(ss * (1.0f / 256.0f) + EPS) * (0.0625f * LOG2E);
        u32x2 w; w.x = cvtpk(a0 * rk * g[0], a1 * rk * g[1]); w.y = cvtpk(a2 * rk * g[2], a3 * rk * g[3]);
        *(u32x2*)p = w;
    }
}

template <int MODE = 0> __device__ __forceinline__ void xattn_phase(const Params& P, LAS unsigned char* lds, int wid_s) {
    const int lane = lane_id_asm(), wid = wid_s, tid = wid * 64 + lane, r = lane & 31, hh = lane >> 5;
    const bf16* Q2 = (const bf16*)(P.ws + WS_PROJ); const bf16* K2 = (const bf16*)(P.ws + WS_K2); const bf16* V2T = (const bf16*)(P.ws + WS_V2T); bf16* O2 = (bf16*)(P.ws + WS_PROJ + 32 * MiB);
    const float* gq = P.in[14]; const float* gk = P.in[15];
    float mq = 0.f, mk = 0.f;
#pragma unroll
    for (int j = 0; j < 4; ++j) { mq = fmaxf(mq, fabsf(gq[lane + 64 * j])); mk = fmaxf(mk, fabsf(gk[lane + 64 * j])); }
    mq = wave_max(mq); mk = wave_max(mk);
    const float M2 = __uint_as_float(__builtin_amdgcn_readfirstlane(__float_as_uint(fmaxf(mq * mk * 256.0f * (0.0625f * LOG2E) - 60.0f, 0.f))));
    LAS unsigned char* Kb = lds; LAS unsigned char* Vb = lds + 32768; LAS unsigned char* Qb = lds + 65536;
    const int dh = wid >> 2;
    for (int item = blockIdx.x; item < 512; item += gridDim.x) {
        const int bhd = item >> 6, qblk = item & 63, b = bhd >> 2, head = bhd & 3;
        const size_t tokb = (size_t)b * SEQ + 128 * qblk; const size_t tok = tokb + 32 * (wid & 3) + r;
        __syncthreads();
        {
            const int sub = tid & 7; u32x4 raw[2][4];
#pragma unroll
            for (int p = 0; p < 2; ++p) { const bf16* qp = Q2 + (tokb + 64 * p + (tid >> 3)) * 1024 + head * 256 + 8 * sub;
#pragma unroll
                for (int k = 0; k < 4; ++k) raw[p][k] = __builtin_nontemporal_load((const u32x4*)(qp + 64 * k)); }
#pragma unroll
            for (int p = 0; p < 2; ++p) { const int row = 64 * p + (tid >> 3); float ss = 0.f;
#pragma unroll
                for (int k = 0; k < 4; ++k)
#pragma unroll
                    for (int e = 0; e < 4; ++e) { const float a = bflo(raw[p][k][e]), c = bfhi(raw[p][k][e]); ss += a * a + c * c; }
                ss = XSUM_SWZ(ss, 1); ss = XSUM_SWZ(ss, 2); ss = XSUM_SWZ(ss, 4);
                const float rq = rsqrtf(ss * (1.0f / 256.0f) + EPS);
                LAS unsigned char* qdst = Qb + (row >> 5) * 16384 + (row & 31) * 512;
#pragma unroll
                for (int k = 0; k < 4; ++k) { const int piece = sub + 8 * k; const f32x4 g0 = *(const f32x4*)(gq + 8 * piece), g1 = *(const f32x4*)(gq + 8 * piece + 4); u32x4 w;
                    w.x = cvtpk(bflo(raw[p][k].x) * rq * g0[0], bfhi(raw[p][k].x) * rq * g0[1]); w.y = cvtpk(bflo(raw[p][k].y) * rq * g0[2], bfhi(raw[p][k].y) * rq * g0[3]);
                    w.z = cvtpk(bflo(raw[p][k].z) * rq * g1[0], bfhi(raw[p][k].z) * rq * g1[1]); w.w = cvtpk(bflo(raw[p][k].w) * rq * g1[2], bfhi(raw[p][k].w) * rq * g1[3]);
                    *(LAS u32x4*)(qdst + ((piece ^ (row & 15)) << 4)) = w; } }
        }
        const LAS unsigned char* Qg = Qb + (wid & 3) * 16384 + r * 512;
        f32x16 o[8];
#pragma unroll
        for (int db = 0; db < 8; ++db) o[db] = f32x16{};
        float l = 0.f;
        const int krow_ = tid >> 3, ksub_ = tid & 7;
        const bf16* kp_ = K2 + (size_t)(b * MEML + krow_) * 1024 + head * 256 + 8 * ksub_;
        const bf16* vp_ = V2T + (size_t)(head * 256 + (tid >> 3)) * 512 + b * MEML + 8 * (tid & 7);
        for (int mt = 0; mt < 4; ++mt) {
            if (mt > 0) __syncthreads();
            if (MODE != 2) {   u32x4 kraw[4], vraw[4];
#pragma unroll
                for (int k = 0; k < 4; ++k) { kraw[k] = *(const u32x4*)(kp_ + (size_t)(64 * mt) * 1024 + 64 * k); vraw[k] = *(const u32x4*)(vp_ + (size_t)(64 * k) * 512 + 64 * mt); }
#pragma unroll
                for (int k = 0; k < 4; ++k) { const int piece = ksub_ + 8 * k; *(LAS u32x4*)(Kb + krow_ * 512 + ((piece ^ (krow_ & 15)) << 4)) = kraw[k]; }
#pragma unroll
                for (int k = 0; k < 4; ++k) { const int row = (tid >> 3) + 64 * k, piece = tid & 7;
                    *(LAS u32x4*)(Vb + row * 128 + ((piece ^ ((row >> 1) & 7)) << 4)) = vraw[k]; }
            }
            __syncthreads();
            if (MODE == 1) continue;
            bf16x8 pk[2];
            {   const int krow = 32 * dh + pi32(r); f32x16 S = {};
#pragma unroll 4
                for (int d0 = 0; d0 < 16; ++d0) { const int piece = 2 * d0 + hh;
                    const bf16x8 kf = *(const LAS bf16x8*)(Kb + krow * 512 + ((piece ^ (krow & 15)) << 4));
                    const bf16x8 qfr = *(const LAS bf16x8*)(Qg + ((piece ^ (r & 15)) << 4));
                    S = MFMA32(kf, qfr, S); }
#pragma unroll
                for (int i = 0; i < 16; ++i) { const float p = __builtin_amdgcn_exp2f(S[i] - M2); S[i] = p; l += p; }
                pk[0] = packf(S, 0); pk[1] = packf(S, 1); }
#pragma unroll
            for (int db = 0; db < 8; ++db) { const int vrow = 32 * db + r;
#pragma unroll
                for (int s2 = 0; s2 < 2; ++s2) { const int piece = 2 * (2 * dh + s2) + hh;
                    const bf16x8 vf = *(const LAS bf16x8*)(Vb + vrow * 128 + ((piece ^ ((vrow >> 1) & 7)) << 4));
                    o[db] = MFMA32(vf, pk[s2], o[db]); }
                if (db & 1) asm volatile("" ::: "memory"); }
        }
        l = xsum32(l);
        if (MODE != 0) { if (l + o[0][0] + o[7][7] == 123.456f) O2[0] = 0; continue; }
        __syncthreads();
        LAS float* xch = (LAS float*)(lds + (wid & 3) * 32768) + lane;
        if (dh == 1) {
#pragma unroll
            for (int db = 0; db < 8; ++db) {
#pragma unroll
                for (int i = 0; i < 16; ++i) xch[(db * 16 + i) * 64] = o[db][i];
                asm volatile("" ::: "memory"); }
            ((LAS float*)(lds + 131072))[(wid & 3) * 64 + lane] = l;
        }
        __syncthreads();
        if (dh == 0) {
            const float inv = 1.0f / (l + ((LAS float*)(lds + 131072))[(wid & 3) * 64 + lane]);
#pragma unroll
            for (int db = 0; db < 8; ++db) {
#pragma unroll
                for (int i = 0; i < 16; ++i) o[db][i] = (o[db][i] + xch[(db * 16 + i) * 64]) * inv;
                asm volatile("" ::: "memory"); }
            LAS unsigned char* stg = lds + (wid & 3) * 32768;
#pragma unroll
            for (int db = 0; db < 8; ++db)
#pragma unroll
                for (int g = 0; g < 4; ++g) {
                    u32x2 w; w.x = cvtpk(o[db][4 * g], o[db][4 * g + 1]); w.y = cvtpk(o[db][4 * g + 2], o[db][4 * g + 3]);
                    otile_put<32>(stg, r, hh, 4 * db + g, w); }
            otile_flush<32>(stg, O2 + (tokb + 32 * (wid & 3)) * 1024 + head * 256, 1024, lane);
        }
    }
    __syncthreads();
}

#define XB_TMO      128
#define XB_XCNT(j)  (256  + 64 * (j))
#define XB_XSUB(j)  (1280 + 64 * (j))
#define XB_XGEN(j)  (2304 + 64 * (j))
#define XB_TOP      3328
#define XB_TOPGEN   3392
#define XCD_BAR_WORDS 3456
#define XB_SPIN_CAP (1u << 18)

__device__ __forceinline__ unsigned xb_ld(unsigned* p)              { return __hip_atomic_load(p, __ATOMIC_RELAXED, __HIP_MEMORY_SCOPE_AGENT); }
__device__ __forceinline__ unsigned xb_add(unsigned* p, unsigned v) { return __hip_atomic_fetch_add(p, v, __ATOMIC_RELAXED, __HIP_MEMORY_SCOPE_AGENT); }
__device__ __forceinline__ unsigned xb_xcc_id() { return (unsigned)__builtin_amdgcn_s_getreg((3 << 11) | 20) & 0xFu; }
#define XB_SPIN(cond, bar) do { unsigned _sp = 0; while (cond) { __builtin_amdgcn_s_sleep(1); \
    if ((++_sp & 255u) == 0u) { if (xb_ld(&(bar)[XB_TMO])) break; if (_sp > XB_SPIN_CAP) { atomicAdd(&(bar)[XB_TMO], 1u); break; } } } } while (0)

struct XcdBarrier {
    unsigned* bar; unsigned x;
    volatile LAS unsigned* st;
};

__device__ __forceinline__ XcdBarrier xcd_barrier_post(unsigned* bar, volatile LAS unsigned* st, int wid_s) {
    XcdBarrier b; b.bar = bar; b.x = xb_xcc_id(); b.st = st;
    if (wid_s == 0 && lane_id_asm() == 0) (void)xb_add(&bar[XB_XCNT(b.x)], 1u);
    return b;
}
__device__ __forceinline__ void xcd_barrier_complete(unsigned* bar, unsigned x, unsigned& nloc, unsigned& nx) {
    const unsigned G = gridDim.x * gridDim.y * gridDim.z;
    unsigned sum, cnt, mine, sp = 0u;
    for (;;) {
        sum = 0u; cnt = 0u; mine = 0u;
#pragma unroll
        for (unsigned j = 0; j < 16; ++j) { const unsigned c = xb_ld(&bar[XB_XCNT(j)]); sum += c; cnt += (c > 0u) ? 1u : 0u; mine = (j == x) ? c : mine; }
        if (sum == G) break;
        __builtin_amdgcn_s_sleep(1);
        if ((++sp & 255u) == 0u) { if (xb_ld(&bar[XB_TMO])) break; if (sp > XB_SPIN_CAP) { atomicAdd(&bar[XB_TMO], 1u); break; } }
    }
    nloc = mine > 0u ? mine : 1u; nx = cnt > 0u ? cnt : 1u;
}

__device__ __forceinline__ void xcd_barrier(const XcdBarrier& b, int wid_s) {
    asm volatile("s_waitcnt vmcnt(0)" ::: "memory");
    __syncthreads();
    if (wid_s == 0 && lane_id_asm() == 0) {
        unsigned* bar = b.bar;
        __builtin_amdgcn_s_waitcnt(0);
        unsigned nloc = b.st[0], nx = b.st[1];
        if (nloc == 0u) { xcd_barrier_complete(bar, b.x, nloc, nx); b.st[0] = nloc; b.st[1] = nx; }
        const unsigned old = xb_add(&bar[XB_XSUB(b.x)], 1u);
        const unsigned gen = old / nloc;
        if (old + 1u == (gen + 1u) * nloc) {
            __builtin_amdgcn_fence(__ATOMIC_RELEASE, "agent");
            asm volatile("s_waitcnt vmcnt(0)" ::: "memory");
            const unsigned og = xb_add(&bar[XB_TOP], 1u);
            const unsigned tg = og / nx;
            if (og + 1u == (tg + 1u) * nx) xb_add(&bar[XB_TOPGEN], 1u);
            else XB_SPIN(xb_ld(&bar[XB_TOPGEN]) == tg, bar);
            __builtin_amdgcn_fence(__ATOMIC_ACQUIRE, "agent");
            xb_add(&bar[XB_XGEN(b.x)], 1u);
            asm volatile("s_waitcnt vmcnt(0)" ::: "memory");
        } else {
            XB_SPIN(xb_ld(&bar[XB_XGEN(b.x)]) == gen, bar);
            __builtin_amdgcn_fence(__ATOMIC_ACQUIRE, "agent");
            asm volatile("s_waitcnt vmcnt(0)" ::: "memory");
        }
    }
    __syncthreads();
}

__global__ void __launch_bounds__(512) hymba_fwd(Params P) {
    extern __shared__ __attribute__((aligned(16))) unsigned char lds_raw[];
    LAS unsigned char* lds = (LAS unsigned char*)lds_raw;
    cg::grid_group grid = cg::this_grid();
    unsigned char* ws = P.ws;
    const int G = gridDim.x, c = blockIdx.x;
    float* SSQ1 = (float*)(ws + WS_SSQ1); float* SSQ2 = (float*)(ws + WS_SSQ2); const float* RSTD1 = (const float*)(ws + WS_RSTD1); const float* RSTDM = (const float*)(ws + WS_RSTDM);
    bf16* XB = (bf16*)(ws + WS_XB); bf16* PROJ = (bf16*)(ws + WS_PROJ); bf16* TR = (bf16*)(ws + WS_TR); bf16* MIX = (bf16*)(ws + WS_MIX);
    bf16* Q2 = (bf16*)(ws + WS_PROJ); bf16* O2 = (bf16*)(ws + WS_PROJ + 32 * MiB); bf16* ACT = (bf16*)(ws + WS_TR);

    volatile LAS unsigned* st = (volatile LAS unsigned*)(lds + 135168);
    unsigned* barw = (unsigned*)(ws + WS_BAR);
    const int wid_s = __builtin_amdgcn_readfirstlane(threadIdx.x >> 6);
    if (wid_s == 0 && lane_id_asm() < 2) st[lane_id_asm()] = 0u;
    __syncthreads();
    const XcdBarrier xb = xcd_barrier_post(barw, st, wid_s);
#ifndef NO_P0
    p0_prologue(P, lds, wid_s);
#endif
#ifdef REP_P0
    p0_prologue(P, lds, wid_s);
#endif
    if (P.use_cg) grid.sync();
    xcd_barrier(xb, wid_s);
#ifdef REP_G1
    for (int rep_ = 0; rep_ < 2; ++rep_) {
#else
    {
#endif
    {   pg8::Gemm g{XB, (const bf16*)(ws + WS_WN), NTOK, 2560, DM}; pg8::StaticOrder S; S.init(NTOK, 2560, G, c);
        pg8::EpiG1 E{PROJ, RSTD1, (const float*)(ws + WS_CS), P.in[4], P.in[5], 0.125f * LOG2E};
        pg8::gemm_phase<pg8::EpiG1, pg8::StaticOrder, true, true>(lds, g, S, E, wid_s); }
    {   pg8::Gemm g{(const bf16*)(ws + WS_WTR), XB, 1536, NTOK, DM}; pg8::StaticOrder S; S.init(1536, NTOK, G, (c + G / 2) % G);
        pg8::EpiTR E{TR, RSTD1, (const float*)(ws + WS_CS)};
        pg8::gemm_phase<pg8::EpiTR, pg8::StaticOrder, true, true>(lds, g, S, E, wid_s); }
    }
    xcd_barrier(xb, wid_s);
#ifndef NO_RETKV
    ret_kv_phase(P, wid_s);
#endif
#ifdef REP_RETKV
    ret_kv_phase(P, wid_s);
#endif
#ifndef NO_DIFF
    diff_phase(P, lds, wid_s);
#endif
#ifdef REP_DIFF
    diff_phase(P, lds, wid_s);
#endif
#ifdef REP_DIFF_SKEL
    diff_probe_phase<1>(P, lds, wid_s);
#endif
#ifdef REP_DIFF_COMP
    diff_probe_phase<2>(P, lds, wid_s);
#endif
    xcd_barrier(xb, wid_s);
    ret_scan_phase(P, wid_s);

    kv2_phase(P, wid_s);
    xcd_barrier(xb, wid_s);
#ifdef REP_SYNC
    for (int rep_ = 0; rep_ < 20; ++rep_) xcd_barrier(xb, wid_s);
#endif
#ifndef NO_RETOUT
    ret_out_phase(P, lds, wid_s);
#endif
    knorm_phase(P, wid_s);
#ifdef REP_RETOUT
    ret_out_phase(P, lds, wid_s);
#endif
#ifdef REP_RETOUT_NOST
    ret_out_phase<1>(P, lds, wid_s);
#endif
    xcd_barrier(xb, wid_s);
    {   pg8::Gemm g{MIX, (const bf16*)(ws + WS_WOUT), NTOK, DM, DM}; pg8::StaticOrder S; S.init(NTOK, DM, G, c);
        pg8::EpiResid<true> E{P.in[0], P.out, XB, SSQ1};
        pg8::gemm_phase<pg8::EpiResid<true>, pg8::StaticOrder, true, true>(lds, g, S, E, wid_s); }
#ifdef REP_G2
    {   pg8::Gemm g{MIX, (const bf16*)(ws + WS_WOUT), NTOK, DM, DM}; pg8::StaticOrder S; S.init(NTOK, DM, G, c);
        pg8::EpiResid<false> E{P.in[0], (float*)(ws + WS_PROJ), nullptr, nullptr};
        pg8::gemm_phase<pg8::EpiResid<false>, pg8::StaticOrder, true, true>(lds, g, S, E, wid_s); }
#endif
    xcd_barrier(xb, wid_s);
#ifdef REP_G3
    for (int rep_ = 0; rep_ < 2; ++rep_) {
#else
    {
#endif
    {   pg8::Gemm g{XB, (const bf16*)(ws + WS_XQ), NTOK, DM, DM}; pg8::StaticOrder S; S.init(NTOK, DM, G, c);
        pg8::EpiRowScale<true> E{Q2, 1024, SSQ1};
        pg8::gemm_phase<pg8::EpiRowScale<true>, pg8::StaticOrder, true, true>(lds, g, S, E, wid_s); }
    }
    xcd_barrier(xb, wid_s);
#ifndef NO_XATTN
    xattn_phase(P, lds, wid_s);
#endif
#ifdef REP_XATTN
    xattn_phase(P, lds, wid_s);
#endif
#ifdef REP_XATTN_SKEL
    xattn_phase<1>(P, lds, wid_s);
#endif
#ifdef REP_XATTN_COMP
    xattn_phase<2>(P, lds, wid_s);
#endif
    xcd_barrier(xb, wid_s);
    {   pg8::Gemm g{O2, (const bf16*)(ws + WS_XO), NTOK, DM, DM}; pg8::StaticOrder S; S.init(NTOK, DM, G, c);
#ifdef REP_G4
    {   pg8::Gemm g2{O2, (const bf16*)(ws + WS_XO), NTOK, DM, DM}; pg8::StaticOrder S2; S2.init(NTOK, DM, G, c);
        pg8::EpiResid<false> E2{P.out, (float*)(ws + WS_TR), nullptr, nullptr};
        pg8::gemm_phase<pg8::EpiResid<false>, pg8::StaticOrder, true, true>(lds, g2, S2, E2, wid_s); }
#endif
        pg8::EpiResid<true> E{P.out, P.out, XB, SSQ2};
        pg8::gemm_phase<pg8::EpiResid<true>, pg8::StaticOrder, true, true>(lds, g, S, E, wid_s); }
    xcd_barrier(xb, wid_s);
#ifdef REP_G5
    for (int rep_ = 0; rep_ < 2; ++rep_) {
#else
    {
#endif
    {   pg8::Gemm g{XB, (const bf16*)(ws + WS_WGU), NTOK, 2 * FFH, DM}; pg8::StaticOrder S; S.init(NTOK, 2 * FFH, G, c);
        pg8::EpiSwiglu E{ACT, SSQ2};
        pg8::gemm_phase<pg8::EpiSwiglu, pg8::StaticOrder, true, true>(lds, g, S, E, wid_s); }
    }
    xcd_barrier(xb, wid_s);
    {   pg8::Gemm g{ACT, (const bf16*)(ws + WS_WD), NTOK, DM, FFH}; pg8::StaticOrder S; S.init(NTOK, DM, G, c);
#ifdef REP_G6
    {   pg8::Gemm g2{ACT, (const bf16*)(ws + WS_WD), NTOK, DM, FFH}; pg8::StaticOrder S2; S2.init(NTOK, DM, G, c);
        pg8::EpiResid<false> E2{P.out, (float*)(ws + WS_PROJ), nullptr, nullptr};
        pg8::gemm_phase<pg8::EpiResid<false>, pg8::StaticOrder, true, true>(lds, g2, S2, E2, wid_s); }
#endif
        pg8::EpiResidF E{P.out, P.out};
        pg8::gemm_phase<pg8::EpiResidF, pg8::StaticOrder, true, true>(lds, g, S, E, wid_s); }
}

extern "C" void kernel_launch(void* const* d_in, const int* in_sizes, int n_in, void* d_out, int out_size, void* d_ws, size_t ws_size, hipStream_t stream) {
    static int grid = 0;
    if (grid == 0) {
        if (n_in != 21 || out_size != NTOK * DM || ws_size < WS_END) { fprintf(stderr, "kernel_launch: unexpected shapes (n_in %d, out %d, ws %zu)\n", n_in, out_size, ws_size); grid = -1; return; }
        int dev = 0, cus = 0, per_cu = 0;
        (void)hipGetDevice(&dev); (void)hipDeviceGetAttribute(&cus, hipDeviceAttributeMultiprocessorCount, dev);
        if (hipFuncSetAttribute((const void*)hymba_fwd, hipFuncAttributeMaxDynamicSharedMemorySize, LDS_BYTES) != hipSuccess) { fprintf(stderr, "kernel_launch: hipFuncSetAttribute failed\n"); grid = -1; return; }
        if (hipOccupancyMaxActiveBlocksPerMultiprocessor(&per_cu, (const void*)hymba_fwd, 512, LDS_BYTES) != hipSuccess || per_cu < 1) { fprintf(stderr, "kernel_launch: occupancy query failed (%d)\n", per_cu); (void)hipGetLastError(); per_cu = 1; }
        grid = cus * (per_cu > 1 ? 1 : per_cu);
        if (grid > 256) grid = 256;
    }
    if (grid < 0) return;
    if (hipMemsetAsync((char*)d_ws + WS_BAR, 0, 65536, stream) != hipSuccess) { fprintf(stderr, "kernel_launch: memset of the barrier words failed\n"); return; }
    Params p{};
    for (int i = 0; i < 21; ++i) p.in[i] = (const float*)d_in[i];
    p.out = (float*)d_out; p.ws = (unsigned char*)d_ws;
    void* args[] = {&p};
    hipError_t e = hipLaunchCooperativeKernel((const void*)hymba_fwd, dim3(grid), dim3(512), args, LDS_BYTES, stream);
    if (e != hipSuccess) fprintf(stderr, "cooperative launch failed: %s (grid %d)\n", hipGetErrorString(e), grid);
}
```

```cpp
#include <hip/hip_runtime.h>
#include <hip/hip_cooperative_groups.h>
#include <cstdio>
#include <cstdint>
namespace cg = cooperative_groups;
#define XSUM_SWZ(v, m) ((v) + __uint_as_float((unsigned)__builtin_amdgcn_ds_swizzle((int)__float_as_uint(v), ((m) << 10) | 0x1f)))
#define XMAX_SWZ(v, m) fmaxf((v), __uint_as_float((unsigned)__builtin_amdgcn_ds_swizzle((int)__float_as_uint(v), ((m) << 10) | 0x1f)))
__device__ __forceinline__ float xsum32(float v) { auto rr = __builtin_amdgcn_permlane32_swap(__float_as_uint(v), __float_as_uint(v), false, false); return __uint_as_float(rr[0]) + __uint_as_float(rr[1]); }
__device__ __forceinline__ float xmax32(float v) { auto rr = __builtin_amdgcn_permlane32_swap(__float_as_uint(v), __float_as_uint(v), false, false); return fmaxf(__uint_as_float(rr[0]), __uint_as_float(rr[1])); }
__device__ __forceinline__ float xsum16(float v) { return XSUM_SWZ(v, 16); }
__device__ __forceinline__ int lane_id_asm() { int l; asm volatile("v_mbcnt_lo_u32_b32 %0, -1, 0\n\tv_mbcnt_hi_u32_b32 %0, -1, %0" : "=v"(l)); return l; }
namespace pg8 {
#define PG8_LAS __attribute__((address_space(3)))
typedef unsigned short bf16_t;
typedef short bf16x8 __attribute__((ext_vector_type(8)));
typedef float f32x4 __attribute__((ext_vector_type(4)));
typedef unsigned u32x4 __attribute__((ext_vector_type(4)));
constexpr int BM = 256, BK = 64, HALF = 128, HTB = HALF * BK * 2  , STAGE_BYTES = 8 * HTB, NXCD = 8, WGM = 8;

__host__ __device__ __forceinline__ int lds_byte(int r, int c) { const int st = (r >> 4) * 2 + (c >> 5), rr = r & 15, cc = c & 31, ob = rr * 64 + cc * 2; return st * 1024 + (ob ^ (((ob >> 9) & 1) << 5)); }
__host__ __device__ __forceinline__ void stage_rc(int b, int& R, int& C) { const int st = b / 1024, sb = b % 1024, swz = sb ^ (((sb >> 9) & 1) << 5); R = (st >> 1) * 16 + swz / 64; C = (st & 1) * 32 + (swz % 64) / 2; }
__host__ __device__ __forceinline__ int perm32(int rho) { const int n = rho >> 4, i = rho & 15; return 8 * (i >> 2) + 4 * n + (i & 3); }

struct Unit { int pm, pn; };
struct Gemm { const bf16_t* A; const bf16_t* Bt; int M, N, K; };

struct StaticOrder {
    int nM, nN, nwg, G, c;
    __host__ __device__ void init(int M, int N, int G_, int c_) { nM = M / BM; nN = N / BM; nwg = nM * nN; G = G_; c = c_; }
    __host__ __device__ bool next(int i, Unit& u) const {
        const long L = (long)i * G + c; if (L >= nwg) return false;
        int wgid = (int)L; { const int q = nwg / NXCD, r = nwg % NXCD, xcd = wgid % NXCD, off = wgid / NXCD; wgid = (xcd < r ? xcd * (q + 1) : r * (q + 1) + (xcd - r) * q) + off; }
        const int nig = WGM * nN, gid = wgid / nig, fm = gid * WGM, gsz = (nM - fm) < WGM ? (nM - fm) : WGM;
        u.pm = fm + ((wgid % nig) % gsz); u.pn = (wgid % nig) / gsz; return true;
    }
    __device__ __forceinline__ void a_ready(const Unit&) const {}
    __device__ __forceinline__ void done(const Unit&) const {}
};

__device__ __forceinline__ unsigned cvt_pk_bf16(float lo, float hi) { unsigned r; asm volatile("v_cvt_pk_bf16_f32 %0, %1, %2" : "=v"(r) : "v"(lo), "v"(hi)); return r; }
typedef float f32x2 __attribute__((ext_vector_type(2)));
typedef unsigned u32x2 __attribute__((ext_vector_type(2)));
constexpr float EPS_RMS = 1e-6f;
__device__ __forceinline__ u32x4 pack8(const float (&v)[8]) { u32x4 w; w.x = cvt_pk_bf16(v[0], v[1]); w.y = cvt_pk_bf16(v[2], v[3]); w.z = cvt_pk_bf16(v[4], v[5]); w.w = cvt_pk_bf16(v[6], v[7]); return w; }
__device__ __forceinline__ float silu_f(float v) { return v * __builtin_amdgcn_rcpf(1.0f + __builtin_amdgcn_exp2f(v * -1.4426950408889634f)); }

struct EpiG1 {
    static constexpr bool PERM = true, AFTER_DRAIN = false;
    bf16_t* O; const float* rstd; const float* cs; const float* gq; const float* gk; float c2;
    __device__ __forceinline__ void operator()(const f32x4 (&acc)[2][2][4][2], const Unit& u, int wr, int wc, int fr, int fq) const {
        const int pn = u.pn; const int row0 = u.pm * BM + wr * 64 + fr;
        if (pn < 4) {
            const float sc = pn >= 2 ? 0.125f : 1.0f;
#pragma unroll
            for (int ai = 0; ai < 2; ++ai)
#pragma unroll
                for (int m = 0; m < 4; ++m) { const int row = row0 + ai * HALF + m * 16; const float f = rstd[row] * sc;
                    const f32x4* c4 = (const f32x4*)(cs + ((size_t)(row & 8191) * 32 + 8 * fq) * 2);
                    float o1[8], o2[8];
#pragma unroll
                    for (int k = 0; k < 4; ++k) { const f32x4 c = c4[k];
#pragma unroll
                        for (int z = 0; z < 2; ++z) { const int i8 = 2 * k + z; const float co = z ? c[2] : c[0], si = z ? c[3] : c[1];
                            const float x1 = acc[ai][0][m][i8 >> 2][i8 & 3], x2 = acc[ai][1][m][i8 >> 2][i8 & 3];
                            o1[i8] = (x1 * co - x2 * si) * f; o2[i8] = (x2 * co + x1 * si) * f; } }
                    bf16_t* p = O + (size_t)row * 2560 + pn * 256 + wc * 64 + 8 * fq;
                    *(u32x4*)p = pack8(o1); *(u32x4*)(p + 32) = pack8(o2); }
        } else if (pn < 6) {
#pragma unroll
            for (int ai = 0; ai < 2; ++ai)
#pragma unroll
                for (int m = 0; m < 4; ++m) { const int row = row0 + ai * HALF + m * 16; const float f = rstd[row];
#pragma unroll
                    for (int bj = 0; bj < 2; ++bj) { float v[8];
#pragma unroll
                        for (int i8 = 0; i8 < 8; ++i8) v[i8] = silu_f(acc[ai][bj][m][i8 >> 2][i8 & 3] * f);
                        *(u32x4*)(O + (size_t)row * 2560 + pn * 256 + bj * HALF + wc * 32 + 8 * fq) = pack8(v); } }
        } else {
            const float* g = pn < 8 ? gq : gk; const float sc = pn < 8 ? c2 : 1.0f;
            float gv[2][8];
#pragma unroll
            for (int bj = 0; bj < 2; ++bj)
#pragma unroll
                for (int i8 = 0; i8 < 8; ++i8) gv[bj][i8] = g[32 * bj + 8 * fq + i8] * sc;
#pragma unroll
            for (int ai = 0; ai < 2; ++ai)
#pragma unroll
                for (int m = 0; m < 4; ++m) { const int row = row0 + ai * HALF + m * 16; const float f = rstd[row];
                    float ss = 0.f;
#pragma unroll
                    for (int bj = 0; bj < 2; ++bj)
#pragma unroll
                        for (int i8 = 0; i8 < 8; ++i8) { const float v = acc[ai][bj][m][i8 >> 2][i8 & 3] * f; ss += v * v; }
                    ss = xsum16(ss); ss = xsum32(ss);
                    const float rr = f * rsqrtf(ss * (1.0f / 64.0f) + EPS_RMS);
#pragma unroll
                    for (int bj = 0; bj < 2; ++bj) { float v[8];
#pragma unroll
                        for (int i8 = 0; i8 < 8; ++i8) v[i8] = acc[ai][bj][m][i8 >> 2][i8 & 3] * rr * gv[bj][i8];
                        *(u32x4*)(O + (size_t)row * 2560 + pn * 256 + wc * 64 + bj * 32 + 8 * fq) = pack8(v); } }
        }
    }
};

struct EpiTR {
    static constexpr bool PERM = true, AFTER_DRAIN = false;
    bf16_t* O; const float* rstd; const float* cs;
    __device__ __forceinline__ void operator()(const f32x4 (&acc)[2][2][4][2], const Unit& u, int wr, int wc, int fr, int fq) const {
        const int pm = u.pm; const int col0 = u.pn * BM + wc * 32 + 8 * fq;
        float rs[2][8];
#pragma unroll
        for (int bj = 0; bj < 2; ++bj) { const f32x4 a = *(const f32x4*)(rstd + col0 + bj * HALF), b = *(const f32x4*)(rstd + col0 + bj * HALF + 4);
            rs[bj][0] = a[0]; rs[bj][1] = a[1]; rs[bj][2] = a[2]; rs[bj][3] = a[3]; rs[bj][4] = b[0]; rs[bj][5] = b[1]; rs[bj][6] = b[2]; rs[bj][7] = b[3]; }
        if (pm < 2) {
#pragma unroll
            for (int m = 0; m < 4; ++m) { const int hl = 2 * wr + (m >> 1), i = 16 * (m & 1) + fr, head = 4 * pm + hl;
                const float l2g = log1pf(-exp2f(-5.0f - (float)head)) * 1.4426950408889634f;
                const int rown = pm * 256 + 64 * hl + i;
#pragma unroll
                for (int bj = 0; bj < 2; ++bj) { float o1[8], o2[8];
#pragma unroll
                    for (int i8 = 0; i8 < 8; ++i8) { const int col = col0 + bj * HALF + i8; const int pos = col & 8191;
                        const float2 c = *(const float2*)(cs + ((size_t)pos * 32 + i) * 2);
                        const float f = rs[bj][i8] * 0.125f * __builtin_amdgcn_exp2f(l2g * (float)(127 - (col & 127)));
                        const float x1 = acc[0][bj][m][i8 >> 2][i8 & 3], x2 = acc[1][bj][m][i8 >> 2][i8 & 3];
                        o1[i8] = (x1 * c.x - x2 * c.y) * f; o2[i8] = (x2 * c.x + x1 * c.y) * f; }
                    *(u32x4*)(O + (size_t)rown * 16384 + col0 + bj * HALF) = pack8(o1);
                    *(u32x4*)(O + (size_t)(rown + 32) * 16384 + col0 + bj * HALF) = pack8(o2); } }
        } else {
#pragma unroll
            for (int ai = 0; ai < 2; ++ai)
#pragma unroll
                for (int m = 0; m < 4; ++m) { const int row = pm * BM + ai * HALF + wr * 64 + m * 16 + fr;
#pragma unroll
                    for (int bj = 0; bj < 2; ++bj) { float v[8];
#pragma unroll
                        for (int i8 = 0; i8 < 8; ++i8) v[i8] = acc[ai][bj][m][i8 >> 2][i8 & 3] * rs[bj][i8];
                        *(u32x4*)(O + (size_t)row * 16384 + col0 + bj * HALF) = pack8(v); } }
        }
    }
};

template <bool SSQ> struct EpiRowScale {
    static constexpr bool PERM = true, AFTER_DRAIN = false;
    bf16_t* O; int ldc; const float* rs;
    __device__ __forceinline__ void operator()(const f32x4 (&acc)[2][2][4][2], const Unit& u, int wr, int wc, int fr, int fq) const {
        const int row0 = u.pm * BM + wr * 64 + fr, col0 = u.pn * BM + wc * 32 + 8 * fq;
#pragma unroll
        for (int ai = 0; ai < 2; ++ai)
#pragma unroll
            for (int m = 0; m < 4; ++m) { const int row = row0 + ai * HALF + m * 16; float f = rs[row]; if (SSQ) f = rsqrtf(f * (1.0f / 1024.0f) + EPS_RMS);
#pragma unroll
                for (int bj = 0; bj < 2; ++bj) { float v[8];
#pragma unroll
                    for (int i8 = 0; i8 < 8; ++i8) v[i8] = acc[ai][bj][m][i8 >> 2][i8 & 3] * f;
                    *(u32x4*)(O + (size_t)row * ldc + col0 + bj * HALF) = pack8(v); } }
    }
};
struct EpiColScale {
    static constexpr bool PERM = true, AFTER_DRAIN = false;
    bf16_t* O; int ldc; const float* rs;
    __device__ __forceinline__ void operator()(const f32x4 (&acc)[2][2][4][2], const Unit& u, int wr, int wc, int fr, int fq) const {
        const int row0 = u.pm * BM + wr * 64 + fr, col0 = u.pn * BM + wc * 32 + 8 * fq;
        float rsv[2][8];
#pragma unroll
        for (int bj = 0; bj < 2; ++bj)
#pragma unroll
            for (int i8 = 0; i8 < 8; ++i8) rsv[bj][i8] = rs[col0 + bj * HALF + i8];
#pragma unroll
        for (int ai = 0; ai < 2; ++ai)
#pragma unroll
            for (int m = 0; m < 4; ++m) { const int row = row0 + ai * HALF + m * 16;
#pragma unroll
                for (int bj = 0; bj < 2; ++bj) { float v[8];
#pragma unroll
                    for (int i8 = 0; i8 < 8; ++i8) v[i8] = acc[ai][bj][m][i8 >> 2][i8 & 3] * rsv[bj][i8];
                    *(u32x4*)(O + (size_t)row * ldc + col0 + bj * HALF) = pack8(v); } }
    }
};
template <bool AUX> struct EpiResid {
    static constexpr bool PERM = true, AFTER_DRAIN = false;
    const float* base; float* out; bf16_t* xb; float* ssq;
    __device__ __forceinline__ void operator()(const f32x4 (&acc)[2][2][4][2], const Unit& u, int wr, int wc, int fr, int fq) const {
        const int row0 = u.pm * BM + wr * 64 + fr, col0 = u.pn * BM + wc * 32 + 8 * fq;
#pragma unroll
        for (int ai = 0; ai < 2; ++ai) {
            f32x4 bv[4][2][2];
#pragma unroll
            for (int m = 0; m < 4; ++m)
#pragma unroll
                for (int bj = 0; bj < 2; ++bj) { const size_t off = (size_t)(row0 + ai * HALF + m * 16) * 1024 + col0 + bj * HALF;
                    bv[m][bj][0] = __builtin_nontemporal_load((const f32x4*)(base + off)); bv[m][bj][1] = __builtin_nontemporal_load((const f32x4*)(base + off + 4)); }
#pragma unroll
            for (int m = 0; m < 4; ++m) { const int row = row0 + ai * HALF + m * 16; float ss = 0.f;
#pragma unroll
                for (int bj = 0; bj < 2; ++bj) { const size_t off = (size_t)row * 1024 + col0 + bj * HALF;
                    const f32x4 v0 = bv[m][bj][0] + acc[ai][bj][m][0], v1 = bv[m][bj][1] + acc[ai][bj][m][1];
                    *(f32x4*)(out + off) = v0; *(f32x4*)(out + off + 4) = v1;
                    if (AUX) { u32x4 w; w.x = cvt_pk_bf16(v0[0], v0[1]); w.y = cvt_pk_bf16(v0[2], v0[3]); w.z = cvt_pk_bf16(v1[0], v1[1]); w.w = cvt_pk_bf16(v1[2], v1[3]);
                        *(u32x4*)(xb + off) = w;
                        ss += (v0[0] * v0[0] + v0[1] * v0[1]) + (v0[2] * v0[2] + v0[3] * v0[3]) + (v1[0] * v1[0] + v1[1] * v1[1]) + (v1[2] * v1[2] + v1[3] * v1[3]); } }
                if (AUX) { ss = xsum16(ss); ss = xsum32(ss); if (fq == 0) atomicAdd(ssq + row, ss); } }
        }
    }
};
struct EpiResidF {
    static constexpr bool PERM = false, AFTER_DRAIN = false;
    const float* base; float* out;
    __device__ __forceinline__ void operator()(const f32x4 (&acc)[2][2][4][2], const Unit& u, int wr, int wc, int fr, int fq) const {
        const int row0 = u.pm * BM + wr * 64 + fr, col0 = u.pn * BM + wc * 32 + 4 * fq;
#pragma unroll
        for (int ai = 0; ai < 2; ++ai) {
            f32x4 bv[4][2][2];
#pragma unroll
            for (int m = 0; m < 4; ++m)
#pragma unroll
                for (int bj = 0; bj < 2; ++bj) { const size_t off = (size_t)(row0 + ai * HALF + m * 16) * 1024 + col0 + bj * HALF;
                    bv[m][bj][0] = __builtin_nontemporal_load((const f32x4*)(base + off)); bv[m][bj][1] = __builtin_nontemporal_load((const f32x4*)(base + off + 16)); }
#pragma unroll
            for (int m = 0; m < 4; ++m)
#pragma unroll
                for (int bj = 0; bj < 2; ++bj) { const size_t off = (size_t)(row0 + ai * HALF + m * 16) * 1024 + col0 + bj * HALF;
                    __builtin_nontemporal_store(bv[m][bj][0] + acc[ai][bj][m][0], (f32x4*)(out + off)); __builtin_nontemporal_store(bv[m][bj][1] + acc[ai][bj][m][1], (f32x4*)(out + off + 16)); }
        }
    }
};
struct EpiSwiglu {
    static constexpr bool PERM = true, AFTER_DRAIN = false;
    bf16_t* O; const float* ssq;
    __device__ __forceinline__ void operator()(const f32x4 (&acc)[2][2][4][2], const Unit& u, int wr, int wc, int fr, int fq) const {
        const int row0 = u.pm * BM + wr * 64 + fr, col0 = u.pn * HALF + wc * 32 + 8 * fq;
#pragma unroll
        for (int ai = 0; ai < 2; ++ai)
#pragma unroll
            for (int m = 0; m < 4; ++m) { const int row = row0 + ai * HALF + m * 16; const float f = rsqrtf(ssq[row] * (1.0f / 1024.0f) + EPS_RMS);
                float v[8];
#pragma unroll
                for (int i8 = 0; i8 < 8; ++i8) v[i8] = silu_f(acc[ai][0][m][i8 >> 2][i8 & 3] * f) * (acc[ai][1][m][i8 >> 2][i8 & 3] * f);
                *(u32x4*)(O + (size_t)row * 2816 + col0) = pack8(v); }
    }
};
template <class Epi, class Sched, bool ALIGN_EPI = false, bool SP2 = false>
__device__ __forceinline__ void gemm_phase(PG8_LAS unsigned char* lds, const Gemm g, const Sched& S, const Epi& E, int wid_s) {
    const int lane = lane_id_asm(), wid = wid_s, tid = wid * 64 + lane, wr = wid >> 2, wc = wid & 3, fr = lane & 15, fq = lane >> 4;
    const int K = g.K, nt = K / BK;
    unsigned voffA[2], voffB[2];
#pragma unroll
    for (int i = 0; i < 2; ++i) { int R, C; stage_rc(tid * 16 + i * 8192, R, C); const int Rb = Epi::PERM ? ((R & ~31) + perm32(R & 31)) : R;
        voffA[i] = (unsigned)(R * K + C) * 2u; voffB[i] = (unsigned)(Rb * K + C) * 2u; }
    const size_t kstep = (size_t)(BK * 2);
    const size_t hstep = (size_t)HALF * K * 2;
    const size_t tstep = 2 * hstep;
    const unsigned ldsw = (unsigned)wid * 1024u;
    const int aoff = lds_byte(wr * 64 + fr, fq * 8), boff = lds_byte(wc * 32 + fr, fq * 8);
#define PG8_SA(b, h) (((b) * 2 + (h)) * HTB)
#define PG8_SB(b, h) ((4 + (b) * 2 + (h)) * HTB)
#define PG8_STAGE(bufoff, gbase, voff) do { _Pragma("unroll") for (int _i = 0; _i < 2; ++_i) \
        __builtin_amdgcn_global_load_lds((const unsigned*)((const char*)(gbase) + (voff)[_i]), (PG8_LAS unsigned*)(lds + (bufoff) + ldsw + _i * 8192), 16, 0, 0); } while (0)
#define PG8_LDA(dst, b, h) do { _Pragma("unroll") for (int m = 0; m < 4; ++m) _Pragma("unroll") for (int k = 0; k < 2; ++k) dst[m][k] = *(const PG8_LAS bf16x8*)(lds + PG8_SA(b, h) + aoff + m * 2048 + k * 1024); } while (0)
#define PG8_LDB(dst, b, h) do { _Pragma("unroll") for (int n = 0; n < 2; ++n) _Pragma("unroll") for (int k = 0; k < 2; ++k) dst[n][k] = *(const PG8_LAS bf16x8*)(lds + PG8_SB(b, h) + boff + n * 2048 + k * 1024); } while (0)
#define PG8_MMA(ai, bj, At, Bt) do { __builtin_amdgcn_s_setprio(1); _Pragma("unroll") for (int m = 0; m < 4; ++m) _Pragma("unroll") for (int n = 0; n < 2; ++n) _Pragma("unroll") for (int k = 0; k < 2; ++k) \
        acc[ai][bj][m][n] = __builtin_amdgcn_mfma_f32_16x16x32_bf16(Bt[n][k], At[m][k], acc[ai][bj][m][n], 0, 0, 0); __builtin_amdgcn_s_setprio(0); } while (0)
#define PG8_WAIT_V(n) asm volatile("s_waitcnt vmcnt(" #n ")" ::: "memory")
#define PG8_WAIT_L(n) asm volatile("s_waitcnt lgkmcnt(" #n ")" ::: "memory")
#define PG8_BAR __builtin_amdgcn_s_barrier()
#define PG8_SCHED __builtin_amdgcn_sched_barrier(0)
    Unit cur, nxt; int ui = 0;
    if (!S.next(0, cur)) return;
    f32x4 acc[2][2][4][2];
#pragma unroll
    for (int a = 0; a < 2; ++a)
#pragma unroll
        for (int b = 0; b < 2; ++b)
#pragma unroll
            for (int m = 0; m < 4; ++m)
#pragma unroll
                for (int n = 0; n < 2; ++n) acc[a][b][m][n] = (f32x4){0.f, 0.f, 0.f, 0.f};
    bf16x8 At[4][2], B0[2][2], B1[2][2];
    const char* cA = (const char*)g.A + (size_t)cur.pm * tstep; const char* cB = (const char*)g.Bt + (size_t)cur.pn * tstep;
    S.a_ready(cur);
    if constexpr (SP2) {
        PG8_STAGE(PG8_SB(0, 0), cB, voffB); PG8_STAGE(PG8_SB(0, 1), cB + hstep, voffB); PG8_STAGE(PG8_SA(0, 0), cA, voffA); PG8_STAGE(PG8_SA(0, 1), cA + hstep, voffA);
        if (wr == 1) PG8_BAR;
        PG8_WAIT_V(2); PG8_BAR;
        PG8_STAGE(PG8_SB(1, 0), cB + kstep, voffB); PG8_STAGE(PG8_SA(1, 0), cA + kstep, voffA); PG8_STAGE(PG8_SB(1, 1), cB + hstep + kstep, voffB);
        PG8_WAIT_V(6); PG8_BAR;
    } else {
        PG8_STAGE(PG8_SB(0, 0), cB, voffB); PG8_STAGE(PG8_SA(0, 0), cA, voffA); PG8_STAGE(PG8_SB(0, 1), cB + hstep, voffB); PG8_STAGE(PG8_SA(0, 1), cA + hstep, voffA);
        if (wr == 1) PG8_BAR;
        PG8_WAIT_V(4); PG8_BAR;
        PG8_STAGE(PG8_SB(1, 0), cB + kstep, voffB); PG8_STAGE(PG8_SA(1, 0), cA + kstep, voffA); PG8_STAGE(PG8_SB(1, 1), cB + hstep + kstep, voffB);
        PG8_WAIT_V(6); PG8_BAR;
    }
    for (;;) {
        const bool has_next = S.next(ui + 1, nxt);
        const char* nA = has_next ? (const char*)g.A + (size_t)nxt.pm * tstep : cA; const char* nB = has_next ? (const char*)g.Bt + (size_t)nxt.pn * tstep : cB;
        for (int t = 0; t < nt; t += 2) {
            const bool last = (t == nt - 2);
            const char* a1 = cA + (size_t)(t + 1) * kstep;
            const char* a2 = last ? nA : cA + (size_t)(t + 2) * kstep; const char* b2 = last ? nB : cB + (size_t)(t + 2) * kstep;
            const char* a3 = a2 + kstep; const char* b3 = b2 + kstep;
            if (last && has_next) S.a_ready(nxt);
            if constexpr (SP2) {
            PG8_LDB(B0, 0, 0); PG8_LDB(B1, 0, 1); PG8_SCHED; PG8_LDA(At, 0, 0); PG8_STAGE(PG8_SA(1, 1), a1 + hstep, voffA);
            PG8_WAIT_V(8); PG8_WAIT_L(0); PG8_BAR; PG8_MMA(0, 0, At, B0); PG8_MMA(0, 1, At, B1); PG8_BAR; PG8_SCHED;
            PG8_LDA(At, 0, 1); PG8_STAGE(PG8_SB(0, 0), b2, voffB); PG8_STAGE(PG8_SB(0, 1), b2 + hstep, voffB); PG8_STAGE(PG8_SA(0, 0), a2, voffA);
            PG8_WAIT_V(8); PG8_WAIT_L(0); PG8_BAR; PG8_MMA(1, 0, At, B0); PG8_MMA(1, 1, At, B1); PG8_BAR; PG8_SCHED;
            PG8_LDB(B0, 1, 0); PG8_LDB(B1, 1, 1); PG8_SCHED; PG8_LDA(At, 1, 0); PG8_STAGE(PG8_SA(0, 1), a2 + hstep, voffA);
            PG8_WAIT_V(8); PG8_WAIT_L(0); PG8_BAR; PG8_MMA(0, 0, At, B0); PG8_MMA(0, 1, At, B1); PG8_BAR; PG8_SCHED;
            PG8_LDA(At, 1, 1); PG8_STAGE(PG8_SB(1, 0), b3, voffB); PG8_STAGE(PG8_SB(1, 1), b3 + hstep, voffB); PG8_STAGE(PG8_SA(1, 0), a3, voffA);
            PG8_WAIT_V(8); PG8_WAIT_L(0); PG8_BAR; PG8_MMA(1, 0, At, B0); PG8_MMA(1, 1, At, B1); PG8_BAR; PG8_SCHED;
            } else {
            PG8_LDB(B0, 0, 0); PG8_SCHED; PG8_LDA(At, 0, 0); PG8_STAGE(PG8_SA(1, 1), a1 + hstep, voffA);
            PG8_WAIT_L(8); PG8_BAR; PG8_WAIT_L(0); PG8_MMA(0, 0, At, B0); PG8_BAR; PG8_SCHED;
            PG8_LDB(B1, 0, 1); PG8_STAGE(PG8_SB(0, 0), b2, voffB);
            PG8_BAR; PG8_WAIT_L(0); PG8_MMA(0, 1, At, B1); PG8_BAR;
            PG8_LDA(At, 0, 1); PG8_STAGE(PG8_SA(0, 0), a2, voffA);
            PG8_BAR; PG8_WAIT_L(0); PG8_MMA(1, 0, At, B0); PG8_BAR; PG8_SCHED;
            PG8_STAGE(PG8_SB(0, 1), b2 + hstep, voffB);
            PG8_WAIT_V(6); PG8_BAR; PG8_MMA(1, 1, At, B1); PG8_BAR;
            PG8_LDB(B0, 1, 0); PG8_SCHED; PG8_LDA(At, 1, 0); PG8_STAGE(PG8_SA(0, 1), a2 + hstep, voffA);
            PG8_WAIT_L(8); PG8_BAR; PG8_WAIT_L(0); PG8_MMA(0, 0, At, B0); PG8_BAR; PG8_SCHED;
            PG8_LDB(B1, 1, 1); PG8_STAGE(PG8_SB(1, 0), b3, voffB);
            PG8_BAR; PG8_WAIT_L(0); PG8_MMA(0, 1, At, B1); PG8_BAR;
            PG8_LDA(At, 1, 1); PG8_STAGE(PG8_SA(1, 0), a3, voffA);
            PG8_BAR; PG8_WAIT_L(0); PG8_MMA(1, 0, At, B0); PG8_BAR; PG8_SCHED;
            PG8_STAGE(PG8_SB(1, 1), b3 + hstep, voffB);
            PG8_WAIT_V(6); PG8_BAR; PG8_MMA(1, 1, At, B1); PG8_BAR;
            }
        }
        if constexpr (ALIGN_EPI) { if (wr == 0) PG8_BAR; }
        if constexpr (!Epi::AFTER_DRAIN) { E(acc, cur, wr, wc, fr, fq); S.done(cur); }
        if (!has_next) break;
#pragma unroll
        for (int a = 0; a < 2; ++a)
#pragma unroll
            for (int b = 0; b < 2; ++b)
#pragma unroll
                for (int m = 0; m < 4; ++m)
#pragma unroll
                    for (int n = 0; n < 2; ++n) acc[a][b][m][n] = (f32x4){0.f, 0.f, 0.f, 0.f};
        cur = nxt; cA = nA; cB = nB; ++ui;
        if constexpr (ALIGN_EPI) { if (wr == 1) PG8_BAR; }
    }
    PG8_WAIT_V(0);
    if constexpr (!ALIGN_EPI) { if (wr == 0) PG8_BAR; }
    PG8_BAR;
    if constexpr (Epi::AFTER_DRAIN) { E.fused(acc, cur, wr, wc, fr, fq, lds, wid, lane); S.done(cur); }
#undef PG8_SA
#undef PG8_SB
#undef PG8_STAGE
#undef PG8_LDA
#undef PG8_LDB
#undef PG8_MMA
#undef PG8_WAIT_V
#undef PG8_WAIT_L
#undef PG8_BAR
#undef PG8_SCHED
}
}

#define LAS __attribute__((address_space(3)))
typedef unsigned short bf16;
typedef short bf16x8 __attribute__((ext_vector_type(8)));
typedef float f32x4 __attribute__((ext_vector_type(4)));
typedef float f32x16 __attribute__((ext_vector_type(16)));
typedef unsigned u32x4 __attribute__((ext_vector_type(4)));
typedef unsigned u32x2 __attribute__((ext_vector_type(2)));
typedef float f32x2_t __attribute__((ext_vector_type(2)));
typedef __bf16 bf16x2_t __attribute__((ext_vector_type(2)));
#define MFMA32(a, b, c) __builtin_amdgcn_mfma_f32_32x32x16_bf16((a), (b), (c), 0, 0, 0)
__device__ __forceinline__ unsigned cvtpk(float lo, float hi) { f32x2_t v = {lo, hi}; bf16x2_t b = __builtin_convertvector(v, bf16x2_t); return __builtin_bit_cast(unsigned, b); }
__device__ __forceinline__ float bflo(unsigned w) { return __uint_as_float(w << 16); }
__device__ __forceinline__ float bfhi(unsigned w) { return __uint_as_float(w & 0xffff0000u); }
__device__ __forceinline__ int crow(int i, int hh) { return (i & 3) + 8 * (i >> 2) + 4 * hh; }
__device__ __forceinline__ int pi32(int r) { return (r & ~12) | ((r & 4) << 1) | ((r & 8) >> 1); }
__device__ __forceinline__ bf16x8 packf(const f32x16& s, int half) {
    u32x4 w;
    if (half == 0) { w.x = cvtpk(s[0], s[1]); w.y = cvtpk(s[2], s[3]); w.z = cvtpk(s[4], s[5]); w.w = cvtpk(s[6], s[7]); }
    else { w.x = cvtpk(s[8], s[9]); w.y = cvtpk(s[10], s[11]); w.z = cvtpk(s[12], s[13]); w.w = cvtpk(s[14], s[15]); }
    return __builtin_bit_cast(bf16x8, w);
}
__device__ __forceinline__ float wave_sum(float v) { v = XSUM_SWZ(v, 1); v = XSUM_SWZ(v, 2); v = XSUM_SWZ(v, 4); v = XSUM_SWZ(v, 8); v = XSUM_SWZ(v, 16); return xsum32(v); }
__device__ __forceinline__ float wave_max(float v) { v = XMAX_SWZ(v, 1); v = XMAX_SWZ(v, 2); v = XMAX_SWZ(v, 4); v = XMAX_SWZ(v, 8); v = XMAX_SWZ(v, 16); return xmax32(v); }
__device__ __forceinline__ void glds16(const void* g, LAS unsigned char* l) { __builtin_amdgcn_global_load_lds((const unsigned*)g, (LAS unsigned*)l, 16, 0, 0); }

constexpr int NTOK = 16384, SEQ = 8192, DM = 1024, FFH = 2816, MEML = 256;
constexpr float EPS = 1e-6f;
constexpr float LOG2E = 1.4426950408889634f;
constexpr size_t MiB = 1u << 20;
constexpr size_t WS_SSQ1 = 0, WS_SSQ2 = 65536, WS_RSTD1 = 131072, WS_RSTDM = 196608;
constexpr size_t WS_CS = 1 * MiB;
constexpr size_t WS_WN = 3 * MiB;
constexpr size_t WS_WTR = 8 * MiB;
constexpr size_t WS_WOUT = 11 * MiB, WS_XQ = 13 * MiB, WS_XKV = 15 * MiB, WS_XO = 19 * MiB;
constexpr size_t WS_WGU = 21 * MiB;
constexpr size_t WS_WD = 32 * MiB;
constexpr size_t WS_XB = 38 * MiB;
constexpr size_t WS_PROJ = 70 * MiB;
constexpr size_t WS_TR = 150 * MiB;
constexpr size_t WS_MIX = 198 * MiB;
constexpr size_t WS_KVS = 230 * MiB;
constexpr size_t WS_K2 = 246 * MiB, WS_V2T = 247 * MiB, WS_MEMB = 248 * MiB, WS_PARTL = 249 * MiB;
constexpr size_t WS_BAR = 250 * MiB;
constexpr size_t WS_END = 256 * MiB;
constexpr int LDS_BYTES = 147456;

struct Params { const float* in[21]; float* out; unsigned char* ws; int use_cg; int pad; };

template <int NCH> __device__ __forceinline__ void otile_put(LAS unsigned char* stg, int r, int hh, int chunk, u32x2 w) { *(LAS u32x2*)(stg + r * (NCH * 16) + ((chunk ^ (r & (NCH - 1))) << 4) + hh * 8) = w; }
template <int NCH> __device__ __forceinline__ void otile_flush(const LAS unsigned char* stg, bf16* g, int ld, int lane_) {
    int lane = lane_; asm volatile("" : "+v"(lane));
#pragma unroll
    for (int i = 0; i < NCH / 2; ++i) { const int row = i * (64 / NCH) + lane / NCH, chunk = lane % NCH;
        const u32x4 v = *(const LAS u32x4*)(stg + row * (NCH * 16) + ((chunk ^ (row & (NCH - 1))) << 4));
        *(u32x4*)(g + (size_t)row * ld + chunk * 8) = v; }
}

__device__ __forceinline__ int rperm32(int c) { return 256 * (c >> 8) + 128 * ((c & 63) >> 5) + 32 * ((c & 255) >> 6); }
struct TrDesc { const float* W; const float* gain; bf16* D0; bf16* D1; int K, N, d0, d1, item; };
__device__ __forceinline__ void tr_load(const TrDesc& t, float (&wv)[32], int lane) {
    const int nblk = t.N / 32, kb = t.item / nblk, nb = t.item % nblk, k0 = 64 * kb, n0 = 32 * nb;
#pragma unroll
    for (int i = 0; i < 8; ++i) { const int kk = 8 * i + (lane >> 3);
        const f32x4 v = __builtin_nontemporal_load((const f32x4*)(t.W + (size_t)(k0 + kk) * t.N + n0 + 4 * (lane & 7)));
        wv[4 * i] = v[0]; wv[4 * i + 1] = v[1]; wv[4 * i + 2] = v[2]; wv[4 * i + 3] = v[3]; }
}
__device__ __forceinline__ void tr_store(const TrDesc& t, const float (&wv)[32], LAS float* scr, int lane) {
    const int nblk = t.N / 32, kb = t.item / nblk, k0 = 64 * kb;
#pragma unroll
    for (int i = 0; i < 8; ++i) { const int kk = 8 * i + (lane >> 3); const float g = t.gain ? t.gain[k0 + kk] : 1.0f; LAS float* d = scr + kk * 33 + 4 * (lane & 7);
        d[0] = wv[4 * i] * g; d[1] = wv[4 * i + 1] * g; d[2] = wv[4 * i + 2] * g; d[3] = wv[4 * i + 3] * g; }
    asm volatile("s_waitcnt lgkmcnt(0)" ::: "memory");
    const int c = lane & 7;
#pragma unroll
    for (int j = 0; j < 4; ++j) { const int n = (lane >> 3) + 8 * j; const LAS float* s = scr + (8 * c) * 33 + n;
        u32x4 o; o.x = cvtpk(s[0 * 33], s[1 * 33]); o.y = cvtpk(s[2 * 33], s[3 * 33]); o.z = cvtpk(s[4 * 33], s[5 * 33]); o.w = cvtpk(s[6 * 33], s[7 * 33]);
        if (t.D0) *(u32x4*)(t.D0 + (size_t)(t.d0 + n) * t.K + k0 + 8 * c) = o;
        if (t.D1) *(u32x4*)(t.D1 + (size_t)(t.d1 + n) * t.K + k0 + 8 * c) = o; }
    asm volatile("s_waitcnt lgkmcnt(0)" ::: "memory");
}
__device__ __forceinline__ TrDesc tr_decode(const Params& P, int it) {
    unsigned char* ws = P.ws; bf16* WN = (bf16*)(ws + WS_WN); bf16* WTR = (bf16*)(ws + WS_WTR);
    constexpr int I0 = 16 * 112, I1 = 512, I2 = 512, I3 = 16 * 64, I4 = 512, I5 = 16 * 88, I6 = 16 * 88;
    TrDesc t; t.D1 = nullptr; t.d1 = 0; t.K = 1024; int r = it;
    if (r < I0) { const int n0 = 32 * (r % 112), seg = n0 >> 9, wi = n0 & 511;
        t.W = P.in[3]; t.N = 3584; t.gain = P.in[2]; t.D0 = nullptr; t.d0 = 0; t.item = r;
        if (seg == 0) { t.D0 = WN; t.d0 = rperm32(wi); }
        else if (seg == 1) { t.D0 = WN; t.d0 = 512 + rperm32(wi); t.D1 = WTR; t.d1 = rperm32(wi); }
        else if (seg == 2) { t.D1 = WTR; t.d1 = 512 + wi; }
        else if (seg == 3) { t.D0 = WN; t.d0 = 1024 + wi; }
        else if (seg == 4) { t.D0 = WN; t.d0 = 1536 + rperm32(wi); }
        else if (seg == 5) { t.D0 = WN; t.d0 = 2048 + rperm32(wi); }
        else { t.D1 = WTR; t.d1 = 1024 + wi; }
        return t; }
    r -= I0;
    if (r < I1) { t.W = P.in[9]; t.N = 1024; t.gain = P.in[8]; t.D0 = (bf16*)(ws + WS_WOUT); t.d0 = 32 * (r % 32); t.item = r; return t; } r -= I1;
    if (r < I2) { t.W = P.in[12]; t.N = 1024; t.gain = P.in[10]; t.D0 = (bf16*)(ws + WS_XQ); t.d0 = 32 * (r % 32); t.item = r; return t; } r -= I2;
    if (r < I3) { t.W = P.in[13]; t.N = 2048; t.gain = P.in[11]; t.D0 = (bf16*)(ws + WS_XKV); t.d0 = 32 * (r % 64); t.item = r; return t; } r -= I3;
    if (r < I4) { t.W = P.in[16]; t.N = 1024; t.gain = nullptr; t.D0 = (bf16*)(ws + WS_XO); t.d0 = 32 * (r % 32); t.item = r; return t; } r -= I4;
    if (r < I5) { const int n0 = 32 * (r % 88); t.W = P.in[18]; t.N = 2816; t.gain = P.in[17]; t.D0 = (bf16*)(ws + WS_WGU); t.d0 = (n0 >> 7) * 256 + (n0 & 127); t.item = r; return t; } r -= I5;
    if (r < I6) { const int n0 = 32 * (r % 88); t.W = P.in[19]; t.N = 2816; t.gain = P.in[17]; t.D0 = (bf16*)(ws + WS_WGU); t.d0 = (n0 >> 7) * 256 + 128 + (n0 & 127); t.item = r; return t; } r -= I6;
    t.W = P.in[20]; t.K = 2816; t.N = 1024; t.gain = nullptr; t.D0 = (bf16*)(ws + WS_WD); t.d0 = 32 * (r % 32); t.item = r; return t;
}
template <int NR> __device__ __forceinline__ void rows_to_bf16(const float* x, bf16* o, float* rstd_out, int m0, int mstride, int lane) {
    f32x4 v[NR][4]; float s[NR];
#pragma unroll
    for (int q = 0; q < NR; ++q) { const f32x4* xr = (const f32x4*)(x + (size_t)(m0 + q * mstride) * DM) + lane;
#pragma unroll
        for (int j = 0; j < 4; ++j) v[q][j] = __builtin_nontemporal_load(xr + 64 * j); }
#pragma unroll
    for (int q = 0; q < NR; ++q) { float a = 0.f;
#pragma unroll
        for (int j = 0; j < 4; ++j) a += (v[q][j][0] * v[q][j][0] + v[q][j][1] * v[q][j][1]) + (v[q][j][2] * v[q][j][2] + v[q][j][3] * v[q][j][3]);
        s[q] = wave_sum(a); }
#pragma unroll
    for (int q = 0; q < NR; ++q) { u32x2* o8 = (u32x2*)(o + (size_t)(m0 + q * mstride) * DM) + lane;
#pragma unroll
        for (int j = 0; j < 4; ++j) { u32x2 w; w.x = cvtpk(v[q][j][0], v[q][j][1]); w.y = cvtpk(v[q][j][2], v[q][j][3]); o8[64 * j] = w; }
        if (lane == 0) rstd_out[m0 + q * mstride] = rsqrtf(s[q] * (1.0f / 1024.0f) + EPS); }
}
__device__ __forceinline__ void p0_prologue(const Params& P, LAS unsigned char* lds, int wid_s) {
    const int lane = lane_id_asm(), wid = wid_s, tid = wid * 64 + lane;
    const int gw = blockIdx.x * 8 + wid, NGW = gridDim.x * 8;
    unsigned char* ws = P.ws;
    LAS float* scr = (LAS float*)(lds + wid * 16384);
    constexpr int NIT = 16 * 112 + 512 + 512 + 16 * 64 + 512 + 16 * 88 + 16 * 88 + 44 * 32;
    if (gw < NIT) {
        int it = gw; TrDesc cur = tr_decode(P, it); float a[32]; tr_load(cur, a, lane);
        for (;;) {
            const int nx = it + NGW; const bool has = nx < NIT; TrDesc nxt = cur; float bnx[32];
            if (has) { nxt = tr_decode(P, nx); tr_load(nxt, bnx, lane); }
            tr_store(cur, a, scr, lane);
            if (!has) break;
            cur = nxt; it = nx;
#pragma unroll
            for (int i = 0; i < 32; ++i) a[i] = bnx[i];
        }
    }
    {   int m = gw;
        for (; m + 7 * NGW < NTOK; m += 8 * NGW) rows_to_bf16<8>(P.in[0], (bf16*)(ws + WS_XB), (float*)(ws + WS_RSTD1), m, NGW, lane);
        for (; m + 3 * NGW < NTOK; m += 4 * NGW) rows_to_bf16<4>(P.in[0], (bf16*)(ws + WS_XB), (float*)(ws + WS_RSTD1), m, NGW, lane);
        for (; m < NTOK; m += NGW) rows_to_bf16<1>(P.in[0], (bf16*)(ws + WS_XB), (float*)(ws + WS_RSTD1), m, NGW, lane); }
    for (int m = gw; m < 2 * MEML; m += NGW) rows_to_bf16<1>(P.in[1], (bf16*)(ws + WS_MEMB), (float*)(ws + WS_RSTDM), m, NGW, lane);
    const int gt = blockIdx.x * 512 + tid, NGT = gridDim.x * 512;
    for (int e = gt; e < SEQ * 32; e += NGT) {
        const int pos = e >> 5, i = e & 31;
        const float inv = 1.0f / exp2f((float)i * (1.0f / 31.0f) * 13.287712379549449f);
        const float ang = (float)pos * inv;
        double t = (double)ang * 0.15915494309189535; t -= floor(t);
        const float tf = (float)t;
        float2 v; v.x = __builtin_amdgcn_cosf(tf); v.y = __builtin_amdgcn_sinf(tf);
        ((float2*)(ws + WS_CS))[e] = v;
    }
    for (int e = gt; e < NTOK; e += NGT) { ((float*)(ws + WS_SSQ1))[e] = 0.f; ((float*)(ws + WS_SSQ2))[e] = 0.f; }
}

__device__ __forceinline__ float ret_l2g(int h) { return log1pf(-exp2f(-5.0f - (float)h)) * LOG2E; }
__device__ __forceinline__ void ret_kv_phase(const Params& P, int wid_s) {
    const int lane = lane_id_asm(), wid = wid_s, tid = wid * 64 + lane, r = lane & 31, hh = lane >> 5;
    const bf16* TR = (const bf16*)(P.ws + WS_TR); float* KVS = (float*)(P.ws + WS_KVS);
    for (int pair = blockIdx.x; pair < 512; pair += gridDim.x) {
        const int chunk = pair * 2 + (wid >> 2), j = wid & 3, bh = chunk >> 6, n = chunk & 63, b = bh >> 3, h = bh & 7, a = j >> 1, bb = j & 1;
        const size_t tok0 = (size_t)b * SEQ + n * 128;
        const bf16* vt = TR + (size_t)(512 + h * 64 + 32 * a + r) * NTOK + tok0 + 8 * hh;
        const bf16* kt = TR + (size_t)(h * 64 + 32 * bb + r) * NTOK + tok0 + 8 * hh;
        f32x16 acc = {};
#pragma unroll
        for (int s = 0; s < 8; ++s) acc = MFMA32(*(const bf16x8*)(vt + 16 * s), *(const bf16x8*)(kt + 16 * s), acc);
        float* dst = KVS + (size_t)chunk * 4096 + (32 * a) * 64 + 32 * bb + r;
#pragma unroll
        for (int i = 0; i < 16; ++i) dst[crow(i, hh) * 64] = acc[i];
    }
}
__device__ __forceinline__ void ret_scan_phase(const Params& P, int wid_s) {
    float* KVS = (float*)(P.ws + WS_KVS);
    if (wid_s >= 4) return;
    for (int e = blockIdx.x * 256 + wid_s * 64 + lane_id_asm(); e < 16 * 4096; e += gridDim.x * 256) {
        const int bh = e >> 12, el = e & 4095, h = bh & 7;
        const float gC = exp2f(128.0f * ret_l2g(h));
        unsigned idx = (unsigned)(bh * 64 * 4096 + el); float R = 0.f;
        for (int n0 = 0; n0 < 64; n0 += 16) { float t[16];
#pragma unroll
            for (int k = 0; k < 16; ++k) t[k] = __builtin_nontemporal_load(KVS + idx + (unsigned)(k * 4096));
#pragma unroll
            for (int k = 0; k < 16; ++k) { KVS[idx + (unsigned)(k * 4096)] = R; R = R * gC + t[k]; }
            idx += 16 * 4096; }
    }
}
template <int MODE = 0> __device__ __forceinline__ void ret_out_phase(const Params& P, LAS unsigned char* lds, int wid_s) {
    const int lane = lane_id_asm(), wid = wid_s, r = lane & 31, hh = lane >> 5;
    const bf16* PROJ = (const bf16*)(P.ws + WS_PROJ); const bf16* TR = (const bf16*)(P.ws + WS_TR); const float* KVS = (const float*)(P.ws + WS_KVS); bf16* MIX = (bf16*)(P.ws + WS_MIX);
    const int cg = wid >> 2, j = wid & 3, tl = j * 64 + lane;
    LAS unsigned char* base = lds + cg * 65536;
    for (int pair = blockIdx.x; pair < 512; pair += gridDim.x) {
        const int chunk = pair * 2 + cg, bh = chunk >> 6, n = chunk & 63, b = bh >> 3, h = bh & 7;
        const size_t tok0 = (size_t)b * SEQ + n * 128; const int c0 = 32 * j;
        const float l2g = ret_l2g(h);
        __syncthreads();
        {   u32x4 t0_[4], t1_[4], t2_[4], t3_[4];
#pragma unroll
            for (int k = 0; k < 4; ++k) { const int idx = tl + 256 * k, row = idx >> 3, piece = idx & 7; const bf16* src = PROJ + (tok0 + row) * 2560 + h * 64 + piece * 8;
                t0_[k] = __builtin_nontemporal_load((const u32x4*)(src)); t1_[k] = __builtin_nontemporal_load((const u32x4*)(src + 512)); t2_[k] = __builtin_nontemporal_load((const u32x4*)(src + 1024));
                const int vrow = idx >> 4, vpiece = idx & 15; t3_[k] = __builtin_nontemporal_load((const u32x4*)(TR + (size_t)(512 + h * 64 + vrow) * NTOK + tok0 + vpiece * 8)); }
#pragma unroll
            for (int k = 0; k < 4; ++k) { const int idx = tl + 256 * k, row = idx >> 3, piece = idx & 7; const int off = row * 128 + ((piece ^ ((row >> 1) & 7)) << 4);
                *(LAS u32x4*)(base + off) = t0_[k]; *(LAS u32x4*)(base + 16384 + off) = t1_[k]; *(LAS u32x4*)(base + 32768 + off) = t2_[k];
                const int vrow = idx >> 4, vpiece = idx & 15; *(LAS u32x4*)(base + 49152 + vrow * 256 + ((vpiece ^ (vrow & 15)) << 4)) = t3_[k]; }
        }
        __syncthreads();
        bf16x8 qf[4];
        { const int row = c0 + r;
#pragma unroll
          for (int d0 = 0; d0 < 4; ++d0) qf[d0] = *(const LAS bf16x8*)(base + row * 128 + (((2 * d0 + hh) ^ ((row >> 1) & 7)) << 4)); }
        f32x16 o[2]; o[0] = f32x16{}; o[1] = f32x16{};
        for (int jb = 0; jb <= j; ++jb) {
            const int krow = 32 * jb + pi32(r);
            f32x16 S = {};
#pragma unroll
            for (int d0 = 0; d0 < 4; ++d0) S = MFMA32(*(const LAS bf16x8*)(base + 16384 + krow * 128 + (((2 * d0 + hh) ^ ((krow >> 1) & 7)) << 4)), qf[d0], S);
#pragma unroll
            for (int i = 0; i < 16; ++i) { const int kvi = 32 * jb + 16 * (i >> 3) + 8 * hh + (i & 7); const int rel = (c0 + r) - kvi;
                S[i] = rel >= 0 ? S[i] * __builtin_amdgcn_exp2f(l2g * (float)rel) : 0.f; }
            const bf16x8 pk0 = packf(S, 0), pk1 = packf(S, 1);
#pragma unroll
            for (int a = 0; a < 2; ++a) { const int vrow = 32 * a + r;
                o[a] = MFMA32(*(const LAS bf16x8*)(base + 49152 + vrow * 256 + (((4 * jb + hh) ^ (vrow & 15)) << 4)), pk0, o[a]);
                o[a] = MFMA32(*(const LAS bf16x8*)(base + 49152 + vrow * 256 + (((4 * jb + 2 + hh) ^ (vrow & 15)) << 4)), pk1, o[a]); }
        }
        const float xi = exp2f(l2g * (float)(c0 + r + 1));
#pragma unroll
        for (int a = 0; a < 2; ++a) { f32x16 t = {}; const float* rp = KVS + (size_t)chunk * 4096 + (32 * a + r) * 64 + 8 * hh;
#pragma unroll
            for (int d0 = 0; d0 < 4; ++d0) { const f32x4 lo = __builtin_nontemporal_load((const f32x4*)(rp + 16 * d0)), hi4 = __builtin_nontemporal_load((const f32x4*)(rp + 16 * d0 + 4));
                u32x4 w; w.x = cvtpk(lo[0], lo[1]); w.y = cvtpk(lo[2], lo[3]); w.z = cvtpk(hi4[0], hi4[1]); w.w = cvtpk(hi4[2], hi4[3]);
                t = MFMA32(__builtin_bit_cast(bf16x8, w), qf[d0], t); }
#pragma unroll
            for (int i = 0; i < 16; ++i) o[a][i] += t[i] * xi; }
        float ss = 0.f;
#pragma unroll
        for (int a = 0; a < 2; ++a)
#pragma unroll
            for (int i = 0; i < 16; ++i) ss += o[a][i] * o[a][i];
        ss = xsum32(ss);
        const float rr = rsqrtf(ss * (1.0f / 64.0f) + EPS);
        LAS unsigned char* stg = base + c0 * 128;
        { const int row = c0 + r;
#pragma unroll
          for (int a = 0; a < 2; ++a)
#pragma unroll
              for (int g = 0; g < 4; ++g) {
                  const u32x2 gw = *(const LAS u32x2*)(base + 32768 + row * 128 + (((4 * a + g) ^ ((row >> 1) & 7)) << 4) + hh * 8);
                  u32x2 w; w.x = cvtpk(o[a][4 * g] * rr * bflo(gw.x), o[a][4 * g + 1] * rr * bfhi(gw.x)); w.y = cvtpk(o[a][4 * g + 2] * rr * bflo(gw.y), o[a][4 * g + 3] * rr * bfhi(gw.y));
                  otile_put<8>(stg, r, hh, 4 * a + g, w); } }
        otile_flush<8>(stg, MIX + (tok0 + c0) * 1024 + h * 64, 1024, lane);
    }
    __syncthreads();
}

struct DiffCtx { const bf16* PROJ; const bf16* TR; bf16* MIX; float* partO0; float* partO1; float* partL0; float* partL1; unsigned* flags; const float* subln; float lam; float shift; };
__device__ __forceinline__ void diff_epilogue(f32x16 (&o)[4], const DiffCtx& C, size_t tokw, int h, int lane, LAS unsigned char* stg) {
    const int r = lane & 31, hh = lane >> 5;
    float ss = 0.f;
#pragma unroll
    for (int db = 0; db < 4; ++db)
#pragma unroll
        for (int i = 0; i < 16; ++i) ss += o[db][i] * o[db][i];
    ss = xsum32(ss);
    const float rr = rsqrtf(ss * (1.0f / 128.0f) + EPS) * 0.8f;
#pragma unroll
    for (int db = 0; db < 4; ++db)
#pragma unroll
        for (int g = 0; g < 4; ++g) { const int d = 32 * db + 8 * g + 4 * hh; const f32x4 sg = *(const f32x4*)(C.subln + d);
            u32x2 w; w.x = cvtpk(o[db][4 * g] * rr * sg[0], o[db][4 * g + 1] * rr * sg[1]); w.y = cvtpk(o[db][4 * g + 2] * rr * sg[2], o[db][4 * g + 3] * rr * sg[3]);
            otile_put<16>(stg, r, hh, 4 * db + g, w); }
    otile_flush<16>(stg, C.MIX + tokw * 1024 + 512 + h * 128, 1024, lane);
}
template <bool SHIFT, int MODE = 0> __device__ __forceinline__ void diff_segment(const DiffCtx& C, LAS unsigned char* lds, int b, int h, int qb, int t0, int t1, int outmode, int unitidx, int wid_s) {
    const int lane = lane_id_asm(), wid = wid_s, r = lane & 31, hh = lane >> 5;
    const int q0 = 256 * qb + 32 * wid; const size_t tokbase = (size_t)b * SEQ;
    bf16x8 qf[2][4];
    { const bf16* qp = C.PROJ + (tokbase + q0 + r) * 2560 + 1536 + h * 128 + 8 * hh;
#pragma unroll
      for (int mp = 0; mp < 2; ++mp)
#pragma unroll
          for (int d0 = 0; d0 < 4; ++d0) qf[mp][d0] = *(const bf16x8*)(qp + mp * 64 + d0 * 16); }
    f32x16 o[2][4];
#pragma unroll
    for (int mp = 0; mp < 2; ++mp)
#pragma unroll
        for (int db = 0; db < 4; ++db) o[mp][db] = f32x16{};
    float l0 = 0.f, l1 = 0.f;
    unsigned kg[4], vg[4];
    const bf16* kbase = C.PROJ + tokbase * 2560 + 2048 + h * 128; const bf16* vbase = C.TR + (size_t)(1024 + h * 128) * NTOK + tokbase;
#pragma unroll
    for (int j = 0; j < 4; ++j) { const int c = wid * 4 + j, row = 4 * c + (lane >> 4), pc = (lane & 15) ^ (row & 15);
        kg[j] = (unsigned)(row * 2560 + pc * 8); vg[j] = (unsigned)(row * NTOK + pc * 8); }
#define DIFF_STAGE(t, buf) do { _Pragma("unroll") for (int j_ = 0; j_ < 4; ++j_) { \
        glds16(kbase + (size_t)(t) * 128 * 2560 + kg[j_], lds + (buf) * 65536 + (wid * 4 + j_) * 1024); \
        glds16(vbase + (size_t)(t) * 128 + vg[j_], lds + (buf) * 65536 + 32768 + (wid * 4 + j_) * 1024); } } while (0)
    DIFF_STAGE(t0, 0);
    for (int t = t0; t < t1; ++t) {
        const int buf = (t - t0) & 1;
        asm volatile("s_waitcnt vmcnt(0)" ::: "memory"); __syncthreads();
        if (t + 1 < t1) DIFF_STAGE(t + 1, buf ^ 1);
        const int k0 = 128 * t;
        if (k0 <= q0 + 31) {
            const LAS unsigned char* Kb = lds + buf * 65536; const LAS unsigned char* Vb = Kb + 32768;
            const bool needmask = (k0 + 127 > q0);
#pragma unroll
            for (int kb = 0; kb < 4; ++kb) {
                if (k0 + 32 * kb <= q0 + 31) {
                const int krow = 32 * kb + pi32(r);
                bf16x8 pk[2][2];
#pragma unroll
                for (int mp = 0; mp < 2; ++mp) {
                    f32x16 S = {};
#pragma unroll
                    for (int d0 = 0; d0 < 4; ++d0) { const int piece = mp * 8 + 2 * d0 + hh;
                        const bf16x8 kf = *(const LAS bf16x8*)(Kb + krow * 256 + ((piece ^ (krow & 15)) << 4));
                        S = MFMA32(kf, qf[mp][d0], S); }
                    float ls = 0.f;
#pragma unroll
                    for (int i = 0; i < 16; ++i) { float p = __builtin_amdgcn_exp2f(SHIFT ? S[i] - C.shift : S[i]);
                        if (needmask) { const int kv = k0 + 32 * kb + 16 * (i >> 3) + 8 * hh + (i & 7); if (kv > q0 + r) p = 0.f; }
                        S[i] = p; ls += p; }
                    if (mp == 0) l0 += ls; else l1 += ls;
                    pk[mp][0] = packf(S, 0); pk[mp][1] = packf(S, 1);
                }
#pragma unroll
                for (int db = 0; db < 4; ++db) { const int vrow = 32 * db + r;
#pragma unroll
                    for (int s2 = 0; s2 < 2; ++s2) { const int piece = 2 * (2 * kb + s2) + hh;
                        const bf16x8 vf = *(const LAS bf16x8*)(Vb + vrow * 256 + ((piece ^ (vrow & 15)) << 4));
                        o[0][db] = MFMA32(vf, pk[0][s2], o[0][db]); o[1][db] = MFMA32(vf, pk[1][s2], o[1][db]); } }
                }
            }
        }
    }
#undef DIFF_STAGE
    __syncthreads();
    l0 = xsum32(l0); l1 = xsum32(l1);
    if (outmode == 2) {
        if (wid == 0 && lane == 0) { unsigned sp = 0; while (__hip_atomic_load(C.flags + 64 * unitidx, __ATOMIC_RELAXED, __HIP_MEMORY_SCOPE_AGENT) == 0u && ++sp < (1u << 22)) __builtin_amdgcn_s_sleep(1);
            __builtin_amdgcn_fence(__ATOMIC_ACQUIRE, "agent"); asm volatile("s_waitcnt vmcnt(0)" ::: "memory"); }
        __syncthreads();
        const float* po = C.partO0 + (size_t)(unitidx * 8 + wid) * 8192 + lane;
#pragma unroll
        for (int mp = 0; mp < 2; ++mp)
#pragma unroll
            for (int db = 0; db < 4; ++db) { const float* pp = po + (mp * 4 + db) * 1024; asm volatile("" : "+v"(pp));
#pragma unroll
                for (int i = 0; i < 16; ++i) o[mp][db][i] += __builtin_nontemporal_load(pp + i * 64); }
        const float* pl = C.partL0 + (size_t)(unitidx * 8 + wid) * 128 + lane; l0 += pl[0]; l1 += pl[64];
    }
    if (outmode != 1) { const float i0 = 1.0f / l0, i1 = C.lam / l1;
#pragma unroll
        for (int db = 0; db < 4; ++db)
#pragma unroll
            for (int i = 0; i < 16; ++i) o[0][db][i] = o[0][db][i] * i0 - o[1][db][i] * i1;
        diff_epilogue(o[0], C, tokbase + q0, h, lane, lds + wid * 8192); }
    else {
        float* po = C.partO0 + (size_t)(unitidx * 8 + wid) * 8192 + lane;
#pragma unroll
        for (int mp = 0; mp < 2; ++mp)
#pragma unroll
            for (int db = 0; db < 4; ++db) { float* pp = po + (mp * 4 + db) * 1024; asm volatile("" : "+v"(pp));
#pragma unroll
                for (int i = 0; i < 16; ++i) __builtin_nontemporal_store(o[mp][db][i], pp + i * 64); }
        float* pl = C.partL0 + (size_t)(unitidx * 8 + wid) * 128 + lane; pl[0] = l0; pl[64] = l1;
    }
    asm volatile("s_waitcnt vmcnt(0)" ::: "memory");
    __syncthreads();
    if (outmode == 1 && wid == 0 && lane == 0) { __builtin_amdgcn_fence(__ATOMIC_RELEASE, "agent"); asm volatile("s_waitcnt vmcnt(0)" ::: "memory");
        (void)__hip_atomic_fetch_add(C.flags + 64 * unitidx, 1u, __ATOMIC_RELAXED, __HIP_MEMORY_SCOPE_AGENT); }
}
__device__ __forceinline__ DiffCtx diff_ctx(const Params& P) {
    const int lane = lane_id_asm();
    DiffCtx C; C.PROJ = (const bf16*)(P.ws + WS_PROJ); C.TR = (const bf16*)(P.ws + WS_TR); C.MIX = (bf16*)(P.ws + WS_MIX);
    C.partO0 = P.out; C.partO1 = (float*)(P.ws + WS_XB); C.partL0 = (float*)(P.ws + WS_PARTL); C.partL1 = (float*)(P.ws + WS_PARTL + 512 * 1024);
    C.subln = P.in[7]; C.flags = (unsigned*)(P.ws + WS_BAR + 16384);
    const float* lv = P.in[6];
    const float s01 = wave_sum(lv[lane] * lv[64 + lane]), s23 = wave_sum(lv[128 + lane] * lv[192 + lane]);
    C.lam = __uint_as_float(__builtin_amdgcn_readfirstlane(__float_as_uint(expf(s01) - expf(s23) + 0.2f)));
    const float mq = wave_max(fabsf(P.in[4][lane])), mk = wave_max(fabsf(P.in[5][lane]));
    C.shift = __uint_as_float(__builtin_amdgcn_readfirstlane(__float_as_uint(fmaxf(mq * mk * 64.0f * (0.125f * LOG2E) - 60.0f, 0.f))));
    return C;
}
__device__ __forceinline__ void diff_phase(const Params& P, LAS unsigned char* lds, int wid_s) {
    const DiffCtx C = diff_ctx(P);
    for (int pass = 0; pass < 2; ++pass)
    for (int v = blockIdx.x; v < 256; v += gridDim.x) {
        const int bh = v & 7, s = v >> 3, b = bh >> 2, h = bh & 3;
        if ((s < 16) != (pass == 0)) continue;
        const int q = s & 15, nseg = s < 16 ? 1 : 2;
        for (int sg = 0; sg < nseg; ++sg) {
            const bool small_ = (s >= 16) && sg == 0;
            const int a_qb = small_ ? q : 31 - q, a_t0 = small_ ? 0 : (s < 16 ? 0 : 33), a_t1 = small_ ? 2 * q + 2 : (s < 16 ? 33 : 64 - 2 * q), a_om = small_ ? 0 : (s < 16 ? 1 : 2), a_ui = bh * 16 + (15 - q);
            if (C.shift == 0.f) diff_segment<false>(C, lds, b, h, a_qb, a_t0, a_t1, a_om, a_ui, wid_s);
            else diff_segment<true>(C, lds, b, h, a_qb, a_t0, a_t1, a_om, a_ui, wid_s);
        }
    }
}
template <int MODE> __device__ __forceinline__ void diff_probe_phase(const Params& P, LAS unsigned char* lds, int wid_s) {
    const DiffCtx C = diff_ctx(P);
    for (int v = blockIdx.x; v < 256; v += gridDim.x) {
        const int bh = v & 7, s = v >> 3, b = bh >> 2, h = bh & 3;
        const int q = s & 15, nseg = s < 16 ? 1 : 2;
        for (int sg = 0; sg < nseg; ++sg) {
            const bool small_ = sg == 1;
            const int a_qb = small_ ? q : 31 - q, a_t0 = small_ ? 0 : (s < 16 ? 0 : 33), a_t1 = small_ ? 2 * q + 2 : (s < 16 ? 33 : 64 - 2 * q), a_om = small_ ? 0 : (s < 16 ? 1 : 2), a_ui = bh * 16 + (15 - q);
            diff_segment<false, MODE>(C, lds, b, h, a_qb, a_t0, a_t1, a_om, a_ui, wid_s);
        }
    }
}
__device__ __forceinline__ void diff_combine_phase(const Params& P, LAS unsigned char* lds, int wid_s) {
    const DiffCtx C = diff_ctx(P);
    const int lane = lane_id_asm(), wid = wid_s, tid = wid * 64 + lane, r = lane & 31, hh = lane >> 5;
    const float* A = C.partO0; const float* B = C.partO1;
    for (int it = blockIdx.x * 8 + wid; it < 1024; it += gridDim.x * 8) {
        const int unitidx = it >> 3, w = it & 7, bh = unitidx >> 4, qb = 16 + (unitidx & 15), b = bh >> 2, h = bh & 3;
        const unsigned base = (unsigned)it * 8192u + (unsigned)lane;
        const float l0 = C.partL0[it * 128 + lane] + C.partL1[it * 128 + lane], l1 = C.partL0[it * 128 + 64 + lane] + C.partL1[it * 128 + 64 + lane];
        const float i0 = 1.0f / l0, i1 = C.lam / l1;
        float ss = 0.f;
#pragma unroll
        for (int db = 0; db < 4; ++db) { unsigned o0 = base + db * 1024, o1 = base + 4096 + db * 1024; asm volatile("" : "+v"(o0), "+v"(o1));
#pragma unroll
            for (int i = 0; i < 16; ++i) { const float v = (A[o0 + i * 64] + B[o0 + i * 64]) * i0 - (A[o1 + i * 64] + B[o1 + i * 64]) * i1; ss += v * v; } }
        ss = xsum32(ss);
        const float rr = rsqrtf(ss * (1.0f / 128.0f) + EPS) * 0.8f;
        LAS unsigned char* stg = lds + wid * 8192;
#pragma unroll
        for (int db = 0; db < 4; ++db) { unsigned o0 = base + db * 1024, o1 = base + 4096 + db * 1024; asm volatile("" : "+v"(o0), "+v"(o1));
#pragma unroll
            for (int g = 0; g < 4; ++g) { const int d = 32 * db + 8 * g + 4 * hh; const f32x4 sg = *(const f32x4*)(C.subln + d); float v[4];
#pragma unroll
                for (int e = 0; e < 4; ++e) { const int i = 4 * g + e; v[e] = ((A[o0 + i * 64] + B[o0 + i * 64]) * i0 - (A[o1 + i * 64] + B[o1 + i * 64]) * i1) * rr * sg[e]; }
                u32x2 wv; wv.x = cvtpk(v[0], v[1]); wv.y = cvtpk(v[2], v[3]); otile_put<16>(stg, r, hh, 4 * db + g, wv); } }
        otile_flush<16>(stg, C.MIX + ((size_t)b * SEQ + 256 * qb + 32 * w) * 1024 + 512 + h * 128, 1024, lane);
    }
    __syncthreads();
}

__device__ __forceinline__ void kv2_phase(const Params& P, int wid_s) {
    const int lane = lane_id_asm(), r = lane & 31, hh = lane >> 5;
    const bf16* MEMB = (const bf16*)(P.ws + WS_MEMB); const bf16* XKV = (const bf16*)(P.ws + WS_XKV); const float* RSTDM = (const float*)(P.ws + WS_RSTDM);
    bf16* K2 = (bf16*)(P.ws + WS_K2); bf16* V2T = (bf16*)(P.ws + WS_V2T);
    if (wid_s < 4) return;
    for (int blk = (wid_s - 4) * gridDim.x + blockIdx.x; blk < 1024; blk += gridDim.x * 4) {
        const bool isv = blk >= 512; const int bb = blk & 511;
        const int rb = isv ? (bb >> 4) : (bb >> 5), cb = isv ? (bb & 15) : (bb & 31);
        const bf16* ap = (isv ? XKV + (size_t)(1024 + 32 * rb + r) * 1024 : MEMB + (size_t)(32 * rb + r) * 1024) + 8 * hh;
        const bf16* bp = (isv ? MEMB + (size_t)(32 * cb + r) * 1024 : XKV + (size_t)(32 * cb + r) * 1024) + 8 * hh;
        f32x16 acc = {};
#pragma unroll 16
        for (int s = 0; s < 64; ++s) acc = MFMA32(*(const bf16x8*)(ap + 16 * s), *(const bf16x8*)(bp + 16 * s), acc);
        if (!isv) {
#pragma unroll
            for (int i = 0; i < 16; ++i) { const int m = 32 * rb + crow(i, hh); const unsigned w = cvtpk(acc[i] * RSTDM[m], 0.f);
                *(unsigned short*)(K2 + (size_t)m * 1024 + 32 * cb + r) = (unsigned short)w; }
        } else { const float rs = RSTDM[32 * cb + r];
#pragma unroll
            for (int i = 0; i < 16; ++i) { const int n = 32 * rb + crow(i, hh); const unsigned w = cvtpk(acc[i] * rs, 0.f);
                *(unsigned short*)(V2T + (size_t)n * 512 + 32 * cb + r) = (unsigned short)w; }
        }
    }
}

__device__ __forceinline__ void knorm_phase(const Params& P, int wid_s) {
    const int lane = lane_id_asm(); bf16* K2 = (bf16*)(P.ws + WS_K2); const float* gk = P.in[15];
    for (int t = blockIdx.x * 8 + wid_s; t < 2 * MEML * 4; t += gridDim.x * 8) {
        bf16* p = K2 + (size_t)(t >> 2) * 1024 + (t & 3) * 256 + 4 * lane;
        const u32x2 raw = *(const u32x2*)p; const f32x4 g = *(const f32x4*)(gk + 4 * lane);
        const float a0 = bflo(raw.x), a1 = bfhi(raw.x), a2 = bflo(raw.y), a3 = bfhi(raw.y);
        const float ss = wave_sum((a0 * a0 + a1 * a1) + (a2 * a2 + a3 * a3));
        const float rk = rsqrtf(ss * (1.0f / 256.0f) + EPS) * (0.0625f * LOG2E);
        u32x2 w; w.x = cvtpk(a0 * rk * g[0], a1 * rk * g[1]); w.y = cvtpk(a2 * rk * g[2], a3 * rk * g[3]);
        *(u32x2*)p = w;
    }
}

template <int MODE = 0> __device__ __forceinline__ void xattn_phase(const Params& P, LAS unsigned char* lds, int wid_s) {
    const int lane = lane_id_asm(), wid = wid_s, tid = wid * 64 + lane, r = lane & 31, hh = lane >> 5;
    const bf16* Q2 = (const bf16*)(P.ws + WS_PROJ); const bf16* K2 = (const bf16*)(P.ws + WS_K2); const bf16* V2T = (const bf16*)(P.ws + WS_V2T); bf16* O2 = (bf16*)(P.ws + WS_PROJ + 32 * MiB);
    const float* gq = P.in[14]; const float* gk = P.in[15];
    float mq = 0.f, mk = 0.f;
#pragma unroll
    for (int j = 0; j < 4; ++j) { mq = fmaxf(mq, fabsf(gq[lane + 64 * j])); mk = fmaxf(mk, fabsf(gk[lane + 64 * j])); }
    mq = wave_max(mq); mk = wave_max(mk);
    const float M2 = __uint_as_float(__builtin_amdgcn_readfirstlane(__float_as_uint(fmaxf(mq * mk * 256.0f * (0.0625f * LOG2E) - 60.0f, 0.f))));
    LAS unsigned char* Kb = lds; LAS unsigned char* Vb = lds + 32768; LAS unsigned char* Qb = lds + 65536;
    const int dh = wid >> 2;
    for (int item = blockIdx.x; item < 512; item += gridDim.x) {
        const int bhd = item >> 6, qblk = item & 63, b = bhd >> 2, head = bhd & 3;
        const size_t tokb = (size_t)b * SEQ + 128 * qblk; const size_t tok = tokb + 32 * (wid & 3) + r;
        __syncthreads();
        {
            const int sub = tid & 7; u32x4 raw[2][4];
#pragma unroll
            for (int p = 0; p < 2; ++p) { const bf16* qp = Q2 + (tokb + 64 * p + (tid >> 3)) * 1024 + head * 256 + 8 * sub;
#pragma unroll
                for (int k = 0; k < 4; ++k) raw[p][k] = __builtin_nontemporal_load((const u32x4*)(qp + 64 * k)); }
#pragma unroll
            for (int p = 0; p < 2; ++p) { const int row = 64 * p + (tid >> 3); float ss = 0.f;
#pragma unroll
                for (int k = 0; k < 4; ++k)
#pragma unroll
                    for (int e = 0; e < 4; ++e) { const float a = bflo(raw[p][k][e]), c = bfhi(raw[p][k][e]); ss += a * a + c * c; }
                ss = XSUM_SWZ(ss, 1); ss = XSUM_SWZ(ss, 2); ss = XSUM_SWZ(ss, 4);
                const float rq = rsqrtf(ss * (1.0f / 256.0f) + EPS);
                LAS unsigned char* qdst = Qb + (row >> 5) * 16384 + (row & 31) * 512;
#pragma unroll
                for (int k = 0; k < 4; ++k) { const int piece = sub + 8 * k; const f32x4 g0 = *(const f32x4*)(gq + 8 * piece), g1 = *(const f32x4*)(gq + 8 * piece + 4); u32x4 w;
                    w.x = cvtpk(bflo(raw[p][k].x) * rq * g0[0], bfhi(raw[p][k].x) * rq * g0[1]); w.y = cvtpk(bflo(raw[p][k].y) * rq * g0[2], bfhi(raw[p][k].y) * rq * g0[3]);
                    w.z = cvtpk(bflo(raw[p][k].z) * rq * g1[0], bfhi(raw[p][k].z) * rq * g1[1]); w.w = cvtpk(bflo(raw[p][k].w) * rq * g1[2], bfhi(raw[p][k].w) * rq * g1[3]);
                    *(LAS u32x4*)(qdst + ((piece ^ (row & 15)) << 4)) = w; } }
        }
        const LAS unsigned char* Qg = Qb + (wid & 3) * 16384 + r * 512;
        f32x16 o[8];
#pragma unroll
        for (int db = 0; db < 8; ++db) o[db] = f32x16{};
        float l = 0.f;
        const int krow_ = tid >> 3, ksub_ = tid & 7;
        const bf16* kp_ = K2 + (size_t)(b * MEML + krow_) * 1024 + head * 256 + 8 * ksub_;
        const bf16* vp_ = V2T + (size_t)(head * 256 + (tid >> 3)) * 512 + b * MEML + 8 * (tid & 7);
        for (int mt = 0; mt < 4; ++mt) {
            if (mt > 0) __syncthreads();
            if (MODE != 2) {   u32x4 kraw[4], vraw[4];
#pragma unroll
                for (int k = 0; k < 4; ++k) { kraw[k] = *(const u32x4*)(kp_ + (size_t)(64 * mt) * 1024 + 64 * k); vraw[k] = *(const u32x4*)(vp_ + (size_t)(64 * k) * 512 + 64 * mt); }
#pragma unroll
                for (int k = 0; k < 4; ++k) { const int piece = ksub_ + 8 * k; *(LAS u32x4*)(Kb + krow_ * 512 + ((piece ^ (krow_ & 15)) << 4)) = kraw[k]; }
#pragma unroll
                for (int k = 0; k < 4; ++k) { const int row = (tid >> 3) + 64 * k, piece = tid & 7;
                    *(LAS u32x4*)(Vb + row * 128 + ((piece ^ ((row >> 1) & 7)) << 4)) = vraw[k]; }
            }
            __syncthreads();
            if (MODE == 1) continue;
            bf16x8 pk[2];
            {   const int krow = 32 * dh + pi32(r); f32x16 S = {};
#pragma unroll 4
                for (int d0 = 0; d0 < 16; ++d0) { const int piece = 2 * d0 + hh;
                    const bf16x8 kf = *(const LAS bf16x8*)(Kb + krow * 512 + ((piece ^ (krow & 15)) << 4));
                    const bf16x8 qfr = *(const LAS bf16x8*)(Qg + ((piece ^ (r & 15)) << 4));
                    S = MFMA32(kf, qfr, S); }
#pragma unroll
                for (int i = 0; i < 16; ++i) { const float p = __builtin_amdgcn_exp2f(S[i] - M2); S[i] = p; l += p; }
                pk[0] = packf(S, 0); pk[1] = packf(S, 1); }
#pragma unroll
            for (int db = 0; db < 8; ++db) { const int vrow = 32 * db + r;
#pragma unroll
                for (int s2 = 0; s2 < 2; ++s2) { const int piece = 2 * (2 * dh + s2) + hh;
                    const bf16x8 vf = *(const LAS bf16x8*)(Vb + vrow * 128 + ((piece ^ ((vrow >> 1) & 7)) << 4));
                    o[db] = MFMA32(vf, pk[s2], o[db]); }
                if (db & 1) asm volatile("" ::: "memory"); }
        }
        l = xsum32(l);
        if (MODE != 0) { if (l + o[0][0] + o[7][7] == 123.456f) O2[0] = 0; continue; }
        __syncthreads();
        LAS float* xch = (LAS float*)(lds + (wid & 3) * 32768) + lane;
        if (dh == 1) {
#pragma unroll
            for (int db = 0; db < 8; ++db) {
#pragma unroll
                for (int i = 0; i < 16; ++i) xch[(db * 16 + i) * 64] = o[db][i];
                asm volatile("" ::: "memory"); }
            ((LAS float*)(lds + 131072))[(wid & 3) * 64 + lane] = l;
        }
        __syncthreads();
        if (dh == 0) {
            const float inv = 1.0f / (l + ((LAS float*)(lds + 131072))[(wid & 3) * 64 + lane]);
#pragma unroll
            for (int db = 0; db < 8; ++db) {
#pragma unroll
                for (int i = 0; i < 16; ++i) o[db][i] = (o[db][i] + xch[(db * 16 + i) * 64]) * inv;
                asm volatile("" ::: "memory"); }
            LAS unsigned char* stg = lds + (wid & 3) * 32768;
#pragma unroll
            for (int db = 0; db < 8; ++db)
#pragma unroll
                for (int g = 0; g < 4; ++g) {
                    u32x2 w; w.x = cvtpk(o[db][4 * g], o[db][4 * g + 1]); w.y = cvtpk(o[db][4 * g + 2], o[db][4 * g + 3]);
                    otile_put<32>(stg, r, hh, 4 * db + g, w); }
            otile_flush<32>(stg, O2 + (tokb + 32 * (wid & 3)) * 1024 + head * 256, 1024, lane);
        }
    }
    __syncthreads();
}

#define XB_TMO      128
#define XB_XCNT(j)  (256  + 64 * (j))
#define XB_XSUB(j)  (1280 + 64 * (j))
#define XB_XGEN(j)  (2304 + 64 * (j))
#define XB_TOP      3328
#define XB_TOPGEN   3392
#define XCD_BAR_WORDS 3456
#define XB_SPIN_CAP (1u << 18)

__device__ __forceinline__ unsigned xb_ld(unsigned* p)              { return __hip_atomic_load(p, __ATOMIC_RELAXED, __HIP_MEMORY_SCOPE_AGENT); }
__device__ __forceinline__ unsigned xb_add(unsigned* p, unsigned v) { return __hip_atomic_fetch_add(p, v, __ATOMIC_RELAXED, __HIP_MEMORY_SCOPE_AGENT); }
__device__ __forceinline__ unsigned xb_xcc_id() { return (unsigned)__builtin_amdgcn_s_getreg((3 << 11) | 20) & 0xFu; }
#define XB_SPIN(cond, bar) do { unsigned _sp = 0; while (cond) { __builtin_amdgcn_s_sleep(1); \
    if ((++_sp & 255u) == 0u) { if (xb_ld(&(bar)[XB_TMO])) break; if (_sp > XB_SPIN_CAP) { atomicAdd(&(bar)[XB_TMO], 1u); break; } } } } while (0)

struct XcdBarrier {
    unsigned* bar; unsigned x;
    volatile LAS unsigned* st;
};

__device__ __forceinline__ XcdBarrier xcd_barrier_post(unsigned* bar, volatile LAS unsigned* st, int wid_s) {
    XcdBarrier b; b.bar = bar; b.x = xb_xcc_id(); b.st = st;
    if (wid_s == 0 && lane_id_asm() == 0) (void)xb_add(&bar[XB_XCNT(b.x)], 1u);
    return b;
}
__device__ __forceinline__ void xcd_barrier_complete(unsigned* bar, unsigned x, unsigned& nloc, unsigned& nx) {
    const unsigned G = gridDim.x * gridDim.y * gridDim.z;
    unsigned sum, cnt, mine, sp = 0u;
    for (;;) {
        sum = 0u; cnt = 0u; mine = 0u;
#pragma unroll
        for (unsigned j = 0; j < 16; ++j) { const unsigned c = xb_ld(&bar[XB_XCNT(j)]); sum += c; cnt += (c > 0u) ? 1u : 0u; mine = (j == x) ? c : mine; }
        if (sum == G) break;
        __builtin_amdgcn_s_sleep(1);
        if ((++sp & 255u) == 0u) { if (xb_ld(&bar[XB_TMO])) break; if (sp > XB_SPIN_CAP) { atomicAdd(&bar[XB_TMO], 1u); break; } }
    }
    nloc = mine > 0u ? mine : 1u; nx = cnt > 0u ? cnt : 1u;
}

__device__ __forceinline__ void xcd_barrier(const XcdBarrier& b, int wid_s) {
    asm volatile("s_waitcnt vmcnt(0)" ::: "memory");
    __syncthreads();
    if (wid_s == 0 && lane_id_asm() == 0) {
        unsigned* bar = b.bar;
        __builtin_amdgcn_s_waitcnt(0);
        unsigned nloc = b.st[0], nx = b.st[1];
        if (nloc == 0u) { xcd_barrier_complete(bar, b.x, nloc, nx); b.st[0] = nloc; b.st[1] = nx; }
        const unsigned old = xb_add(&bar[XB_XSUB(b.x)], 1u);
        const unsigned gen = old / nloc;
        if (old + 1u == (gen + 1u) * nloc) {
            __builtin_amdgcn_fence(__ATOMIC_RELEASE, "agent");
            asm volatile("s_waitcnt vmcnt(0)" ::: "memory");
            const unsigned og = xb_add(&bar[XB_TOP], 1u);
            const unsigned tg = og / nx;
            if (og + 1u == (tg + 1u) * nx) xb_add(&bar[XB_TOPGEN], 1u);
            else XB_SPIN(xb_ld(&bar[XB_TOPGEN]) == tg, bar);
            __builtin_amdgcn_fence(__ATOMIC_ACQUIRE, "agent");
            xb_add(&bar[XB_XGEN(b.x)], 1u);
            asm volatile("s_waitcnt vmcnt(0)" ::: "memory");
        } else {
            XB_SPIN(xb_ld(&bar[XB_XGEN(b.x)]) == gen, bar);
            __builtin_amdgcn_fence(__ATOMIC_ACQUIRE, "agent");
            asm volatile("s_waitcnt vmcnt(0)" ::: "memory");
        }
    }
    __syncthreads();
}

__global__ void __launch_bounds__(512) hymba_fwd(Params P) {
    extern __shared__ __attribute__((aligned(16))) unsigned char lds_raw[];
    LAS unsigned char* lds = (LAS unsigned char*)lds_raw;
    cg::grid_group grid = cg::this_grid();
    unsigned char* ws = P.ws;
    const int G = gridDim.x, c = blockIdx.x;
    float* SSQ1 = (float*)(ws + WS_SSQ1); float* SSQ2 = (float*)(ws + WS_SSQ2); const float* RSTD1 = (const float*)(ws + WS_RSTD1); const float* RSTDM = (const float*)(ws + WS_RSTDM);
    bf16* XB = (bf16*)(ws + WS_XB); bf16* PROJ = (bf16*)(ws + WS_PROJ); bf16* TR = (bf16*)(ws + WS_TR); bf16* MIX = (bf16*)(ws + WS_MIX);
    bf16* Q2 = (bf16*)(ws + WS_PROJ); bf16* O2 = (bf16*)(ws + WS_PROJ + 32 * MiB); bf16* ACT = (bf16*)(ws + WS_TR);

    volatile LAS unsigned* st = (volatile LAS unsigned*)(lds + 135168);
    unsigned* barw = (unsigned*)(ws + WS_BAR);
    const int wid_s = __builtin_amdgcn_readfirstlane(threadIdx.x >> 6);
    if (wid_s == 0 && lane_id_asm() < 2) st[lane_id_asm()] = 0u;
    __syncthreads();
    const XcdBarrier xb = xcd_barrier_post(barw, st, wid_s);
#ifndef NO_P0
    p0_prologue(P, lds, wid_s);
#endif
#ifdef REP_P0
    p0_prologue(P, lds, wid_s);
#endif
    if (P.use_cg) grid.sync();
    xcd_barrier(xb, wid_s);
#ifdef REP_G1
    for (int rep_ = 0; rep_ < 2; ++rep_) {
#else
    {
#endif
    {   pg8::Gemm g{XB, (const bf16*)(ws + WS_WN), NTOK, 2560, DM}; pg8::StaticOrder S; S.init(NTOK, 2560, G, c);
        pg8::EpiG1 E{PROJ, RSTD1, (const float*)(ws + WS_CS), P.in[4], P.in[5], 0.125f * LOG2E};
        pg8::gemm_phase<pg8::EpiG1, pg8::StaticOrder, true, true>(lds, g, S, E, wid_s); }
    {   pg8::Gemm g{(const bf16*)(ws + WS_WTR), XB, 1536, NTOK, DM}; pg8::StaticOrder S; S.init(1536, NTOK, G, (c + G / 2) % G);
        pg8::EpiTR E{TR, RSTD1, (const float*)(ws + WS_CS)};
        pg8::gemm_phase<pg8::EpiTR, pg8::StaticOrder, true, true>(lds, g, S, E, wid_s); }
    }
    xcd_barrier(xb, wid_s);
#ifndef NO_RETKV
    ret_kv_phase(P, wid_s);
#endif
#ifdef REP_RETKV
    ret_kv_phase(P, wid_s);
#endif
#ifndef NO_DIFF
    diff_phase(P, lds, wid_s);
#endif
#ifdef REP_DIFF
    diff_phase(P, lds, wid_s);
#endif
#ifdef REP_DIFF_SKEL
    diff_probe_phase<1>(P, lds, wid_s);
#endif
#ifdef REP_DIFF_COMP
    diff_probe_phase<2>(P, lds, wid_s);
#endif
    xcd_barrier(xb, wid_s);
    ret_scan_phase(P, wid_s);

    kv2_phase(P, wid_s);
    xcd_barrier(xb, wid_s);
#ifdef REP_SYNC
    for (int rep_ = 0; rep_ < 20; ++rep_) xcd_barrier(xb, wid_s);
#endif
#ifndef NO_RETOUT
    ret_out_phase(P, lds, wid_s);
#endif
    knorm_phase(P, wid_s);
#ifdef REP_RETOUT
    ret_out_phase(P, lds, wid_s);
#endif
#ifdef REP_RETOUT_NOST
    ret_out_phase<1>(P, lds, wid_s);
#endif
    xcd_barrier(xb, wid_s);
    {   pg8::Gemm g{MIX, (const bf16*)(ws + WS_WOUT), NTOK, DM, DM}; pg8::StaticOrder S; S.init(NTOK, DM, G, c);
        pg8::EpiResid<true> E{P.in[0], P.out, XB, SSQ1};
        pg8::gemm_phase<pg8::EpiResid<true>, pg8::StaticOrder, true, true>(lds, g, S, E, wid_s); }
#ifdef REP_G2
    {   pg8::Gemm g{MIX, (const bf16*)(ws + WS_WOUT), NTOK, DM, DM}; pg8::StaticOrder S; S.init(NTOK, DM, G, c);
        pg8::EpiResid<false> E{P.in[0], (float*)(ws + WS_PROJ), nullptr, nullptr};
        pg8::gemm_phase<pg8::EpiResid<false>, pg8::StaticOrder, true, true>(lds, g, S, E, wid_s); }
#endif
    xcd_barrier(xb, wid_s);
#ifdef REP_G3
    for (int rep_ = 0; rep_ < 2; ++rep_) {
#else
    {
#endif
    {   pg8::Gemm g{XB, (const bf16*)(ws + WS_XQ), NTOK, DM, DM}; pg8::StaticOrder S; S.init(NTOK, DM, G, c);
        pg8::EpiRowScale<true> E{Q2, 1024, SSQ1};
        pg8::gemm_phase<pg8::EpiRowScale<true>, pg8::StaticOrder, true, true>(lds, g, S, E, wid_s); }
    }
    xcd_barrier(xb, wid_s);
#ifndef NO_XATTN
    xattn_phase(P, lds, wid_s);
#endif
#ifdef REP_XATTN
    xattn_phase(P, lds, wid_s);
#endif
#ifdef REP_XATTN_SKEL
    xattn_phase<1>(P, lds, wid_s);
#endif
#ifdef REP_XATTN_COMP
    xattn_phase<2>(P, lds, wid_s);
#endif
    xcd_barrier(xb, wid_s);
    {   pg8::Gemm g{O2, (const bf16*)(ws + WS_XO), NTOK, DM, DM}; pg8::StaticOrder S; S.init(NTOK, DM, G, c);
#ifdef REP_G4
    {   pg8::Gemm g2{O2, (const bf16*)(ws + WS_XO), NTOK, DM, DM}; pg8::StaticOrder S2; S2.init(NTOK, DM, G, c);
        pg8::EpiResid<false> E2{P.out, (float*)(ws + WS_TR), nullptr, nullptr};
        pg8::gemm_phase<pg8::EpiResid<false>, pg8::StaticOrder, true, true>(lds, g2, S2, E2, wid_s); }
#endif
        pg8::EpiResid<true> E{P.out, P.out, XB, SSQ2};
        pg8::gemm_phase<pg8::EpiResid<true>, pg8::StaticOrder, true, true>(lds, g, S, E, wid_s); }
    xcd_barrier(xb, wid_s);
#ifdef REP_G5
    for (int rep_ = 0; rep_ < 2; ++rep_) {
#else
    {
#endif
    {   pg8::Gemm g{XB, (const bf16*)(ws + WS_WGU), NTOK, 2 * FFH, DM}; pg8::StaticOrder S; S.init(NTOK, 2 * FFH, G, c);
        pg8::EpiSwiglu E{ACT, SSQ2};
        pg8::gemm_phase<pg8::EpiSwiglu, pg8::StaticOrder, true, true>(lds, g, S, E, wid_s); }
    }
    xcd_barrier(xb, wid_s);
    {   pg8::Gemm g{ACT, (const bf16*)(ws + WS_WD), NTOK, DM, FFH}; pg8::StaticOrder S; S.init(NTOK, DM, G, c);
#ifdef REP_G6
    {   pg8::Gemm g2{ACT, (const bf16*)(ws + WS_WD), NTOK, DM, FFH}; pg8::StaticOrder S2; S2.init(NTOK, DM, G, c);
        pg8::EpiResid<false> E2{P.out, (float*)(ws + WS_PROJ), nullptr, nullptr};
        pg8::gemm_phase<pg8::EpiResid<false>, pg8::StaticOrder, true, true>(lds, g2, S2, E2, wid_s); }
#endif
        pg8::EpiResidF E{P.out, P.out};
        pg8::gemm_phase<pg8::EpiResidF, pg8::StaticOrder, true, true>(lds, g, S, E, wid_s); }
}

extern "C" void kernel_launch(void* const* d_in, const int* in_sizes, int n_in, void* d_out, int out_size, void* d_ws, size_t ws_size, hipStream_t stream) {
    static int grid = 0;
    if (grid == 0) {
        if (n_in != 21 || out_size != NTOK * DM || ws_size < WS_END) { fprintf(stderr, "kernel_launch: unexpected shapes (n_in %d, out %d, ws %zu)\n", n_in, out_size, ws_size); grid = -1; return; }
        int dev = 0, cus = 0, per_cu = 0;
        (void)hipGetDevice(&dev); (void)hipDeviceGetAttribute(&cus, hipDeviceAttributeMultiprocessorCount, dev);
        if (hipFuncSetAttribute((const void*)hymba_fwd, hipFuncAttributeMaxDynamicSharedMemorySize, LDS_BYTES) != hipSuccess) { fprintf(stderr, "kernel_launch: hipFuncSetAttribute failed\n"); grid = -1; return; }
        if (hipOccupancyMaxActiveBlocksPerMultiprocessor(&per_cu, (const void*)hymba_fwd, 512, LDS_BYTES) != hipSuccess || per_cu < 1) { fprintf(stderr, "kernel_launch: occupancy query failed (%d)\n", per_cu); (void)hipGetLastError(); per_cu = 1; }
        grid = cus * (per_cu > 1 ? 1 : per_cu);
        if (grid > 256) grid = 256;
    }
    if (grid < 0) return;
    if (hipMemsetAsync((char*)d_ws + WS_BAR, 0, 65536, stream) != hipSuccess) { fprintf(stderr, "kernel_launch: memset of the barrier words failed\n"); return; }
    Params p{};
    for (int i = 0; i < 21; ++i) p.in[i] = (const float*)d_in[i];
    p.out = (float*)d_out; p.ws = (unsigned char*)d_ws;
    void* args[] = {&p};
    hipError_t e = hipLaunchCooperativeKernel((const void*)hymba_fwd, dim3(grid), dim3(512), args, LDS_BYTES, stream);
    if (e != hipSuccess) fprintf(stderr, "cooperative launch failed: %s (grid %d)\n", hipGetErrorString(e), grid);
}
```
